# Optimizing an MI355X kernel written in HIP

```python
import jax, jax.numpy as jnp
from jax import lax
import numpy as np

D_MODEL = 1024
BATCH = 4
SEQ = 4096
DEPTH = 1

PLE_DIM = 256
RW_HEADS = 8
RW_HEAD = 64
RW_DIM = RW_HEADS * RW_HEAD
RW_DECAY_LORA = 64
RW_A_LORA = 64
RW_GATE_LORA = 128
RW_GN_EPS = 64e-5
HG_HEADS = 4
HG_EXPAND = 128
HG_HEAD_V = 128
HG_KDIM = HG_HEADS * HG_EXPAND
HG_VDIM = HG_HEADS * HG_HEAD_V
HG_CHUNK = 64
N_BRANCH = 2
C_R = 0
C_K = C_R + RW_DIM
C_V = C_K + RW_DIM
C_WD = C_V + RW_DIM
C_AD = C_WD + RW_DECAY_LORA
C_GD = C_AD + RW_A_LORA
C_RW_END = C_GD + RW_GATE_LORA
C_Q = C_RW_END
C_F = C_Q + HG_KDIM
C_I = C_F + HG_KDIM
C_OG = C_I + HG_VDIM
C_GATE = C_OG + HG_VDIM
N_IN = C_GATE + N_BRANCH * D_MODEL
RW_COLS = C_RW_END
N_GROUPS = 4
EXPERTS_PER_GROUP = 8
N_EXPERTS = N_GROUPS * EXPERTS_PER_GROUP
TOP_K = 2
D_EXPERT = 512
MOE_BLOCK = 128
LN_EPS = 1e-5
RMS_EPS = 1e-6
DEEPNORM_ALPHA = (2 * DEPTH) ** 0.25
DEEPNORM_BETA = (8 * DEPTH) ** -0.25

kernel_name = 'hybrid_rwkv7_hgrn2_hmoe_deepnorm'


def layer_norm(x, g, b):
    xf = x.astype(jnp.float32)
    mu = jnp.mean(xf, -1, keepdims=True)
    var = jnp.mean(jnp.square(xf - mu), -1, keepdims=True)
    return ((xf - mu) * lax.rsqrt(var + LN_EPS) * g + b).astype(x.dtype)


def token_shift(u):
    return jnp.pad(u, ((0, 0), (1, 0), (0, 0)))[:, :-1]


def rwkv7_scan(r, w, k, v, a_vec, b_vec):
    B, T, H, N = r.shape

    def step(S, inp):
        r_t, w_t, k_t, v_t, a_t, b_t = inp
        sa = jnp.einsum('bhij,bhj->bhi', S, a_t)
        S = S * w_t[:, :, None, :] + sa[..., None] * b_t[:, :, None, :] + v_t[..., None] * k_t[:, :, None, :]
        return S, jnp.einsum('bhij,bhj->bhi', S, r_t)

    seqs = tuple(jnp.moveaxis(t, 1, 0) for t in (r, w, k, v, a_vec, b_vec))
    _, y = lax.scan(step, jnp.zeros((B, H, N, N), jnp.float32), seqs)
    return jnp.moveaxis(y, 0, 1)


def rwkv7_branch(u, mu, w0, w_up, a0, a_up, g_up, k_k, k_a, r_k, gn_w, gn_b):
    B, T, _ = u.shape
    dt = u.dtype
    u = u + (token_shift(u) - u) * mu
    r = u[..., C_R:C_K]
    k = u[..., C_K:C_V]
    v = u[..., C_V:C_WD]
    xw = u[..., C_WD:C_AD]
    xa = u[..., C_AD:C_GD]
    xg = u[..., C_GD:C_RW_END]
    w_log = -jax.nn.softplus(-(w0 + jnp.tanh(xw) @ w_up)) - 0.5
    decay = jnp.exp(-jnp.exp(w_log.astype(jnp.float32)))
    a = jax.nn.sigmoid(a0 + xa @ a_up)
    g = jax.nn.sigmoid(xg) @ g_up
    hs = lambda t: t.astype(jnp.float32).reshape(B, T, RW_HEADS, RW_HEAD)
    kk = hs(k * k_k)
    kk = kk / jnp.maximum(jnp.sqrt(jnp.sum(kk * kk, -1, keepdims=True)), 1e-12)
    k = k * (1.0 + (a - 1.0) * k_a)
    rh, kh, vh, ah = hs(r), hs(k), hs(v), hs(a)
    y = rwkv7_scan(rh, decay.reshape(B, T, RW_HEADS, RW_HEAD), kh, vh, -kk, kk * ah)
    m = jnp.mean(y, -1, keepdims=True)
    var = jnp.mean(jnp.square(y - m), -1, keepdims=True)
    y = ((y - m) * lax.rsqrt(var + RW_GN_EPS)).reshape(B, T, RW_DIM) * gn_w + gn_b
    bonus = jnp.sum(rh * kh * r_k, -1, keepdims=True) * vh
    y = (y + bonus.reshape(B, T, RW_DIM)) * g
    return y.astype(dt)


def hgrn2_branch(u, lb, norm_w):
    B, T, _ = u.shape
    dt = u.dtype
    z = u[..., HG_KDIM:2 * HG_KDIM].astype(jnp.float32)
    f = lb + (1.0 - lb) * jax.nn.sigmoid(z)
    k = (1.0 - lb) * jax.nn.sigmoid(-z)
    logf = jnp.log(f)
    q = jax.nn.silu(u[..., :HG_KDIM].astype(jnp.float32))
    vin = u[..., 2 * HG_KDIM:2 * HG_KDIM + HG_VDIM].astype(jnp.float32)
    og = u[..., 2 * HG_KDIM + HG_VDIM:].astype(jnp.float32)
    nc = T // HG_CHUNK

    def chunks(t, d):
        return t.reshape(B, nc, HG_CHUNK, HG_HEADS, d).transpose(1, 0, 3, 2, 4)

    qc, kc = chunks(q, HG_EXPAND), chunks(k, HG_EXPAND)
    bc = jnp.cumsum(chunks(logf, HG_EXPAND), axis=3)
    vc = chunks(vin, HG_HEAD_V)
    mask = jnp.tril(jnp.ones((HG_CHUNK, HG_CHUNK), bool))[:, :, None]

    def step(S, inp):
        q_c, k_c, b_c, v_c = inp
        diff = b_c[:, :, :, None, :] - b_c[:, :, None, :, :]
        dec = jnp.exp(jnp.where(mask, diff, -jnp.inf))
        att = jnp.einsum('bhte,bhse,bhtse->bhts', q_c, k_c, dec)
        o = att @ v_c + jnp.einsum('bhte,bhev->bhtv', q_c * jnp.exp(b_c), S)
        b_last = b_c[:, :, -1:, :]
        S = jnp.exp(b_last[:, :, 0, :])[..., None] * S + jnp.einsum('bhse,bhsv->bhev', k_c * jnp.exp(b_last - b_c), v_c)
        return S, o

    S0 = jnp.zeros((B, HG_HEADS, HG_EXPAND, HG_HEAD_V), jnp.float32)
    _, o = lax.scan(step, S0, (qc, kc, bc, vc))
    o = o.transpose(1, 0, 3, 2, 4).reshape(B, T, HG_HEADS, HG_HEAD_V)
    o = o * lax.rsqrt(jnp.mean(o * o, -1, keepdims=True) + RMS_EPS)
    o = o.reshape(B, T, HG_VDIM) * norm_w * jax.nn.sigmoid(og)
    return o.astype(dt)


def hier_route(xf, wg, bg, we, be):
    pg = jax.nn.softmax((xf @ wg).astype(jnp.float32) + bg, axis=-1)
    pg_sel, gidx = lax.top_k(pg, 1)
    le = ((xf @ we).astype(jnp.float32) + be).reshape(-1, N_GROUPS, EXPERTS_PER_GROUP)
    le_sel = jnp.take_along_axis(le, gidx[:, :, None], axis=1)[:, 0]
    pe = jax.nn.softmax(le_sel, axis=-1)
    pv, eidx = lax.top_k(pe, TOP_K)
    pv = pv / jnp.sum(pv, -1, keepdims=True)
    return gidx * EXPERTS_PER_GROUP + eidx, pg_sel * pv


def moe_experts(xf, eid, ew, w1, w3, w2):
    N, D = xf.shape
    NA = N * TOP_K
    eid_f = eid.reshape(-1)
    ew_f = ew.reshape(-1)
    tok = jnp.repeat(jnp.arange(N, dtype=jnp.int32), TOP_K)
    order = jnp.argsort(eid_f)
    se = eid_f[order]
    counts = jnp.zeros((N_EXPERTS,), jnp.int32).at[eid_f].add(1)
    start = jnp.cumsum(counts) - counts
    padded = (counts + MOE_BLOCK - 1) // MOE_BLOCK * MOE_BLOCK
    pad_end = jnp.cumsum(padded)
    pad_start = pad_end - padded
    dest = pad_start[se] + (jnp.arange(NA, dtype=jnp.int32) - start[se])
    P = (NA + MOE_BLOCK - 1) // MOE_BLOCK * MOE_BLOCK + N_EXPERTS * MOE_BLOCK
    nblk = P // MOE_BLOCK
    tokbuf = jnp.full((P,), N, jnp.int32).at[dest].set(tok[order])
    wbuf = jnp.zeros((P,), jnp.float32).at[dest].set(ew_f[order])
    blk_e = jnp.minimum(jnp.searchsorted(pad_end, jnp.arange(nblk, dtype=jnp.int32) * MOE_BLOCK, side='right'), N_EXPERTS - 1)
    xpad = jnp.concatenate([xf, jnp.zeros((1, D), xf.dtype)], axis=0)
    xbuf = xpad[tokbuf].reshape(nblk, MOE_BLOCK, D)

    def block(args):
        xb, e = args
        h = jax.nn.silu(xb @ w1[e]) * (xb @ w3[e])
        return h @ w2[e]

    ybuf = lax.map(block, (xbuf, blk_e)).reshape(P, D) * wbuf[:, None].astype(xf.dtype)
    return jnp.zeros((N + 1, D), xf.dtype).at[tokbuf].add(ybuf)[:N]


def setup_inputs(seed: int = 0) -> dict:
    key = jax.random.key(seed)
    ks = jax.random.split(key, 40)
    f32 = jnp.float32
    nrm = lambda k, shape, s: jax.random.normal(k, shape, f32) * s
    D = D_MODEL
    return {
        'x': nrm(ks[0], (BATCH, SEQ, D), 1.0),
        'p': nrm(ks[1], (DEPTH, BATCH, SEQ, PLE_DIM), 1.0),
        'w_in': nrm(ks[2], (DEPTH, D, N_IN), D ** -0.5),
        'rw_mu': jax.random.uniform(ks[3], (DEPTH, RW_COLS), f32, 0.1, 0.9),
        'rw_w0': jax.random.uniform(ks[4], (DEPTH, RW_DIM), f32, -6.5, -1.5),
        'rw_w_up': nrm(ks[5], (DEPTH, RW_DECAY_LORA, RW_DIM), 0.1),
        'rw_a0': nrm(ks[6], (DEPTH, RW_DIM), 0.1),
        'rw_a_up': nrm(ks[7], (DEPTH, RW_A_LORA, RW_DIM), RW_A_LORA ** -0.5),
        'rw_g_up': nrm(ks[8], (DEPTH, RW_GATE_LORA, RW_DIM), RW_GATE_LORA ** -0.5),
        'rw_k_k': 0.85 + nrm(ks[9], (DEPTH, RW_DIM), 0.02),
        'rw_k_a': 1.0 + nrm(ks[10], (DEPTH, RW_DIM), 0.02),
        'rw_r_k': nrm(ks[11], (DEPTH, RW_HEADS, RW_HEAD), 0.1),
        'rw_gn_w': 1.0 + nrm(ks[12], (DEPTH, RW_DIM), 0.02),
        'rw_gn_b': nrm(ks[13], (DEPTH, RW_DIM), 0.02),
        'w_a_out': nrm(ks[14], (DEPTH, RW_DIM, D), RW_DIM ** -0.5),
        'hg_lb_logits': nrm(ks[15], (DEPTH + 1, HG_KDIM), 0.1),
        'hg_norm_w': 1.0 + nrm(ks[16], (DEPTH, HG_VDIM), 0.02),
        'w_b_out': nrm(ks[17], (DEPTH, HG_VDIM, D), HG_VDIM ** -0.5),
        'w_o': nrm(ks[18], (DEPTH, D, D), D ** -0.5 * DEEPNORM_BETA),
        'ln1_g': 1.0 + nrm(ks[19], (DEPTH, D), 0.02),
        'ln1_b': nrm(ks[20], (DEPTH, D), 0.02),
        'router_g_w': nrm(ks[21], (DEPTH, D, N_GROUPS), D ** -0.5),
        'router_g_b': nrm(ks[22], (DEPTH, N_GROUPS), 0.01),
        'router_e_w': nrm(ks[23], (DEPTH, D, N_EXPERTS), D ** -0.5),
        'router_e_b': nrm(ks[24], (DEPTH, N_EXPERTS), 0.01),
        'w1': nrm(ks[25], (DEPTH, N_EXPERTS, D, D_EXPERT), D ** -0.5),
        'w3': nrm(ks[26], (DEPTH, N_EXPERTS, D, D_EXPERT), D ** -0.5),
        'w2': nrm(ks[27], (DEPTH, N_EXPERTS, D_EXPERT, D), D_EXPERT ** -0.5 * DEEPNORM_BETA),
        'ln2_g': 1.0 + nrm(ks[28], (DEPTH, D), 0.02),
        'ln2_b': nrm(ks[29], (DEPTH, D), 0.02),
        'w_pe': nrm(ks[30], (DEPTH, PLE_DIM, D), PLE_DIM ** -0.5),
        'w_pg': nrm(ks[31], (DEPTH, D, D), D ** -0.5),
    }


def reference(x, p, w_in, rw_mu, rw_w0, rw_w_up, rw_a0, rw_a_up, rw_g_up, rw_k_k, rw_k_a, rw_r_k,
              rw_gn_w, rw_gn_b, w_a_out, hg_lb_logits, hg_norm_w, w_b_out, w_o, ln1_g, ln1_b,
              router_g_w, router_g_b, router_e_w, router_e_b, w1, w3, w2, ln2_g, ln2_b, w_pe, w_pg):
    B, T, D = x.shape
    lb_all = jnp.cumsum(jax.nn.softmax(hg_lb_logits.astype(jnp.float32), axis=0), axis=0)
    for i in range(DEPTH):
        proj = x @ w_in[i]
        y_a = rwkv7_branch(proj[..., :C_RW_END], rw_mu[i], rw_w0[i], rw_w_up[i], rw_a0[i], rw_a_up[i],
                           rw_g_up[i], rw_k_k[i], rw_k_a[i], rw_r_k[i], rw_gn_w[i], rw_gn_b[i])
        y_b = hgrn2_branch(proj[..., C_Q:C_GATE], lb_all[i].astype(x.dtype) if False else lb_all[i], hg_norm_w[i])
        gates = jax.nn.sigmoid(proj[..., C_GATE:])
        merged = gates[..., :D] * (y_a @ w_a_out[i]) + gates[..., D:] * (y_b @ w_b_out[i])
        x = layer_norm(DEEPNORM_ALPHA * x + merged @ w_o[i], ln1_g[i], ln1_b[i])
        xf = x.reshape(B * T, D)
        eid, ew = hier_route(xf, router_g_w[i], router_g_b[i], router_e_w[i], router_e_b[i])
        ffn = moe_experts(xf, eid, ew, w1[i], w3[i], w2[i]).reshape(B, T, D)
        x = layer_norm(DEEPNORM_ALPHA * x + ffn, ln2_g[i], ln2_b[i])
        x = x + jax.nn.sigmoid(x @ w_pg[i]) * (p[i] @ w_pe[i])
    return x
```

```cpp
#include <hip/hip_runtime.h>
#include <hip/hip_cooperative_groups.h>
#include <cstdio>
#include <cstdint>
namespace cg = cooperative_groups;

#ifndef MODE
#define MODE 0
#endif

typedef unsigned short bf16_t;
typedef short bf16x8 __attribute__((ext_vector_type(8)));
typedef float f32x4 __attribute__((ext_vector_type(4)));
typedef unsigned u32x4 __attribute__((ext_vector_type(4)));
typedef unsigned u32x2 __attribute__((ext_vector_type(2)));
#define DEVI __device__ __forceinline__

constexpr int NT = 512;
constexpr int NTOK = 16384, DM = 1024, SEQ = 4096, NIN = 5888, PLE = 256;
constexpr int C_K = 512, C_V = 1024, C_WD = 1536, C_Q = 1792, C_F = 2304, C_I = 2816, C_OG = 3328, C_GATE = 3840;
constexpr int NEXP = 32;
constexpr float ALPHA = 1.189207115002721f;
constexpr float LN_EPS = 1e-5f, RMS_EPS = 1e-6f, GN_EPS = 64e-5f;
constexpr int LDS_BYTES = 65536;

constexpr size_t MiB = 1048576;
constexpr size_t WS_WAT = 0, WS_WBT = 1 * MiB, WS_WOT = 2 * MiB, WS_WPGT = 4 * MiB, WS_WPET = 6 * MiB;
constexpr size_t WS_CNT = 6 * MiB + 512 * 1024;
constexpr size_t WS_SLOT = WS_CNT + 4096;
constexpr size_t WS_TW = WS_SLOT + (size_t)NTOK * 2 * 4;
constexpr size_t WS_LIST = WS_TW + (size_t)NTOK * 2 * 4;
constexpr size_t WS_PB = 12 * MiB;
constexpr size_t WS_PROJ = 20 * MiB;
constexpr size_t WS_W1T = 20 * MiB, WS_W3T = 52 * MiB, WS_W2T = 84 * MiB;
constexpr size_t WS_Y = 116 * MiB;
constexpr size_t WS_XB = 204 * MiB;
constexpr size_t WS_YA = 204 * MiB, WS_YB = 220 * MiB;
constexpr size_t WS_X1B = 204 * MiB;
constexpr size_t WS_WINT = 236 * MiB;
constexpr size_t WS_PREP = 236 * MiB;
constexpr size_t WS_MERGED = 236 * MiB;
constexpr size_t WS_X1 = 236 * MiB;
constexpr size_t WS_END = 300 * MiB;
constexpr int YROWS = 40960;

struct Params { const float* in[32]; float* out; unsigned char* ws; };

DEVI float bf2f(bf16_t h) { return __uint_as_float(((unsigned)h) << 16); }
DEVI bf16_t f2bf(float f) { unsigned u = __float_as_uint(f); u += 0x7fffu + ((u >> 16) & 1u); return (bf16_t)(u >> 16); }
DEVI unsigned pack2(float a, float b) { return (unsigned)f2bf(a) | ((unsigned)f2bf(b) << 16); }
DEVI float sigm(float x) { return 1.f / (1.f + __expf(-x)); }
DEVI float wave_sum(float v) {
#pragma unroll
    for (int o = 32; o > 0; o >>= 1) v += __shfl_xor(v, o, 64);
    return v;
}
DEVI f32x4 ld_bf4(const bf16_t* p) { u32x2 u = *(const u32x2*)p; f32x4 r; r[0] = __uint_as_float(u[0] << 16); r[1] = __uint_as_float(u[0] & 0xffff0000u); r[2] = __uint_as_float(u[1] << 16); r[3] = __uint_as_float(u[1] & 0xffff0000u); return r; }
DEVI void st_bf4(bf16_t* p, f32x4 v) { u32x2 o; o[0] = pack2(v[0], v[1]); o[1] = pack2(v[2], v[3]); *(u32x2*)p = o; }

DEVI void cvt_tile(const float* __restrict__ src, bf16_t* __restrict__ dst, int tile) {
    const size_t base = (size_t)tile * 4096 + threadIdx.x * 8;
    const f32x4 a = *(const f32x4*)(src + base), b = *(const f32x4*)(src + base + 4);
    u32x4 o; o[0] = pack2(a[0], a[1]); o[1] = pack2(a[2], a[3]); o[2] = pack2(b[0], b[1]); o[3] = pack2(b[2], b[3]);
    *(u32x4*)(dst + base) = o;
}
DEVI void transpose_tile(const float* __restrict__ src, bf16_t* __restrict__ dst, int R, int C, int tr, int tc, float* sm) {
    const int tid = threadIdx.x;
    __syncthreads();
#pragma unroll
    for (int i = 0; i < 2; ++i) {
        const int r = (tid >> 4) + 32 * i, c4 = (tid & 15) * 4;
        const f32x4 v = *(const f32x4*)(src + (size_t)(tr * 64 + r) * C + tc * 64 + c4);
        float* d = sm + r * 65 + c4; d[0] = v[0]; d[1] = v[1]; d[2] = v[2]; d[3] = v[3];
    }
    __syncthreads();
    const int c = tid >> 3, r8 = (tid & 7) * 8;
    float v[8];
#pragma unroll
    for (int k = 0; k < 8; ++k) v[k] = sm[(r8 + k) * 65 + c];
    u32x4 o; o[0] = pack2(v[0], v[1]); o[1] = pack2(v[2], v[3]); o[2] = pack2(v[4], v[5]); o[3] = pack2(v[6], v[7]);
    *(u32x4*)(dst + (size_t)(tc * 64 + c) * R + tr * 64 + r8) = o;
}

constexpr int GLD = 72;
struct IdRows { int base; DEVI int operator()(int r) const { return base + r; } };
struct GatherRows { const int* list; int n; DEVI int operator()(int r) const { return r < n ? list[r] : 0; } };

template <int MF, class RowMap>
DEVI void gemm_accum(f32x4 (&acc)[MF][4], const bf16_t* __restrict__ A, int lda, RowMap rowmap,
                     const bf16_t* __restrict__ Bt, int ldb, int K, bf16_t* sm) {
    bf16_t* sA = sm; bf16_t* sB = sm + MF * 64 * GLD;
    const int tid = threadIdx.x, lane = tid & 63, wid = tid >> 6, wr = wid >> 1, wc = wid & 1, fr = lane & 15, fq = lane >> 4;
    const int lrow = tid >> 3, kc = tid & 7;
    const bf16_t* ap[MF]; const bf16_t* bp[2];
#pragma unroll
    for (int i = 0; i < MF; ++i) ap[i] = A + (size_t)rowmap(lrow + 64 * i) * lda + kc * 8;
#pragma unroll
    for (int i = 0; i < 2; ++i) bp[i] = Bt + (size_t)(lrow + 64 * i) * ldb + kc * 8;
    u32x4 ra[MF], rb[2];
#pragma unroll
    for (int i = 0; i < MF; ++i) ra[i] = *(const u32x4*)(ap[i]);
#pragma unroll
    for (int i = 0; i < 2; ++i) rb[i] = *(const u32x4*)(bp[i]);
    const int nk = K >> 6;
    for (int kt = 0; kt < nk; ++kt) {
        __syncthreads();
#pragma unroll
        for (int i = 0; i < MF; ++i) *(u32x4*)(sA + (lrow + 64 * i) * GLD + kc * 8) = ra[i];
#pragma unroll
        for (int i = 0; i < 2; ++i) *(u32x4*)(sB + (lrow + 64 * i) * GLD + kc * 8) = rb[i];
        __syncthreads();
        if (kt + 1 < nk) {
#pragma unroll
            for (int i = 0; i < MF; ++i) ra[i] = *(const u32x4*)(ap[i] + (kt + 1) * 64);
#pragma unroll
            for (int i = 0; i < 2; ++i) rb[i] = *(const u32x4*)(bp[i] + (kt + 1) * 64);
        }
#pragma unroll
        for (int kk = 0; kk < 2; ++kk) {
            bf16x8 af[MF], bfr[4];
#pragma unroll
            for (int m = 0; m < MF; ++m) af[m] = *(const bf16x8*)(sA + (wr * (MF * 16) + m * 16 + fr) * GLD + kk * 32 + fq * 8);
#pragma unroll
            for (int n = 0; n < 4; ++n) bfr[n] = *(const bf16x8*)(sB + (wc * 64 + n * 16 + fr) * GLD + kk * 32 + fq * 8);
#pragma unroll
            for (int m = 0; m < MF; ++m)
#pragma unroll
                for (int n = 0; n < 4; ++n) acc[m][n] = __builtin_amdgcn_mfma_f32_16x16x32_bf16(bfr[n], af[m], acc[m][n], 0, 0, 0);
        }
    }
}
template <int MF> DEVI void acc_zero(f32x4 (&acc)[MF][4]) {
#pragma unroll
    for (int m = 0; m < MF; ++m)
#pragma unroll
        for (int n = 0; n < 4; ++n) acc[m][n] = (f32x4){0.f, 0.f, 0.f, 0.f};
}
template <int MF, class F> DEVI void epi1(const f32x4 (&acc)[MF][4], F f) {
    const int lane = threadIdx.x & 63, wid = threadIdx.x >> 6, wr = wid >> 1, wc = wid & 1, fr = lane & 15, fq = lane >> 4;
#pragma unroll
    for (int m = 0; m < MF; ++m)
#pragma unroll
        for (int n = 0; n < 4; ++n) f(wr * (MF * 16) + m * 16 + fr, wc * 64 + n * 16 + fq * 4, acc[m][n]);
}
template <int MF, class F> DEVI void epi2(const f32x4 (&a1)[MF][4], const f32x4 (&a2)[MF][4], F f) {
    const int lane = threadIdx.x & 63, wid = threadIdx.x >> 6, wr = wid >> 1, wc = wid & 1, fr = lane & 15, fq = lane >> 4;
#pragma unroll
    for (int m = 0; m < MF; ++m)
#pragma unroll
        for (int n = 0; n < 4; ++n) f(wr * (MF * 16) + m * 16 + fr, wc * 64 + n * 16 + fq * 4, a1[m][n], a2[m][n]);
}

DEVI void phase_prep(const Params& p, unsigned char* smem) {
    float* sm = (float*)smem;
    bf16_t* xb = (bf16_t*)(p.ws + WS_XB); bf16_t* pb = (bf16_t*)(p.ws + WS_PB);
    constexpr int T_X = 4096, T_P = 1024, T_WIN = 16 * 92, T_WA = 8 * 16, T_WB = 8 * 16, T_WO = 16 * 16, T_WPE = 4 * 16, T_WPG = 16 * 16;
    constexpr int TOTAL = T_X + T_P + T_WIN + T_WA + T_WB + T_WO + T_WPE + T_WPG;
    for (int t = blockIdx.x; t < TOTAL; t += gridDim.x) {
        int u = t;
        if (u < T_X) { cvt_tile(p.in[0], xb, u); continue; } u -= T_X;
        if (u < T_P) { cvt_tile(p.in[1], pb, u); continue; } u -= T_P;
        if (u < T_WIN) { transpose_tile(p.in[2], (bf16_t*)(p.ws + WS_WINT), 1024, NIN, u / 92, u % 92, sm); continue; } u -= T_WIN;
        if (u < T_WA) { transpose_tile(p.in[14], (bf16_t*)(p.ws + WS_WAT), 512, 1024, u / 16, u % 16, sm); continue; } u -= T_WA;
        if (u < T_WB) { transpose_tile(p.in[17], (bf16_t*)(p.ws + WS_WBT), 512, 1024, u / 16, u % 16, sm); continue; } u -= T_WB;
        if (u < T_WO) { transpose_tile(p.in[18], (bf16_t*)(p.ws + WS_WOT), 1024, 1024, u / 16, u % 16, sm); continue; } u -= T_WO;
        if (u < T_WPE) { transpose_tile(p.in[30], (bf16_t*)(p.ws + WS_WPET), 256, 1024, u / 16, u % 16, sm); continue; } u -= T_WPE;
        transpose_tile(p.in[31], (bf16_t*)(p.ws + WS_WPGT), 1024, 1024, u / 16, u % 16, sm);
    }
    if (blockIdx.x == 0 && threadIdx.x < 32) ((int*)(p.ws + WS_CNT))[threadIdx.x] = 0;
}

DEVI void phase_inproj(const Params& p, unsigned char* smem) {
    const bf16_t* xb = (const bf16_t*)(p.ws + WS_XB); const bf16_t* WinT = (const bf16_t*)(p.ws + WS_WINT);
    bf16_t* proj = (bf16_t*)(p.ws + WS_PROJ);
    for (int t = blockIdx.x; t < 64 * 46; t += gridDim.x) {
        const int tm = t / 46, tn = t % 46;
        f32x4 acc[4][4]; acc_zero(acc);
        gemm_accum(acc, xb, 1024, IdRows{tm * 256}, WinT + (size_t)tn * 128 * 1024, 1024, 1024, (bf16_t*)smem);
        epi1(acc, [&](int r, int c, f32x4 v) { st_bf4(proj + (size_t)(tm * 256 + r) * NIN + tn * 128 + c, v); });
    }
}

DEVI bf16_t* prep_arr(const Params& p, int i) { return i < 4 ? (bf16_t*)(p.ws + WS_PREP + (size_t)i * 16 * MiB) : (bf16_t*)((unsigned char*)p.out + (size_t)(i - 4) * 16 * MiB); }
DEVI void phase_rwkv_prep(const Params& p, unsigned char* smem) {
    float* lin = (float*)smem;
    const bf16_t* proj = (const bf16_t*)(p.ws + WS_PROJ);
    const float* mu = p.in[3]; const float* w_up = p.in[5]; const float* a_up = p.in[7]; const float* g_up = p.in[8];
    const int tid = threadIdx.x, c = tid;
    const float mu_r = mu[c], mu_k = mu[C_K + c], mu_v = mu[C_V + c];
    const float w0 = p.in[4][c], a0 = p.in[6][c], kkc = p.in[9][c], kac = p.in[10][c];
    bf16_t* oR = prep_arr(p, 0); bf16_t* oK = prep_arr(p, 1); bf16_t* oV = prep_arr(p, 2); bf16_t* oW = prep_arr(p, 3);
    bf16_t* oKK = prep_arr(p, 4); bf16_t* oA = prep_arr(p, 5); bf16_t* oG = prep_arr(p, 6);
    for (int grp = blockIdx.x; grp < NTOK / 16; grp += gridDim.x) {
        const int t0 = grp * 16;
        __syncthreads();
#pragma unroll
        for (int i = 0; i < 8; ++i) {
            const int idx = tid + 512 * i, tt = idx >> 8, l = idx & 255, t = t0 + tt, col = C_WD + l;
            const float cur = bf2f(proj[(size_t)t * NIN + col]);
            const float prev = (t % SEQ == 0) ? 0.f : bf2f(proj[(size_t)(t - 1) * NIN + col]);
            const float u = cur + (prev - cur) * mu[col];
            lin[tt * 256 + l] = l < 64 ? tanhf(u) : (l < 128 ? u : sigm(u));
        }
        __syncthreads();
        float aw[16], aa[16], ag[16];
#pragma unroll
        for (int tt = 0; tt < 16; ++tt) { aw[tt] = 0.f; aa[tt] = 0.f; ag[tt] = 0.f; }
        for (int l = 0; l < 64; ++l) {
            const float w = w_up[l * 512 + c], a = a_up[l * 512 + c];
#pragma unroll
            for (int tt = 0; tt < 16; ++tt) { aw[tt] += lin[tt * 256 + l] * w; aa[tt] += lin[tt * 256 + 64 + l] * a; }
        }
        for (int l = 0; l < 128; ++l) {
            const float g = g_up[l * 512 + c];
#pragma unroll
            for (int tt = 0; tt < 16; ++tt) ag[tt] += lin[tt * 256 + 128 + l] * g;
        }
#pragma unroll
        for (int tt = 0; tt < 16; ++tt) {
            const int t = t0 + tt; const bool first = (t % SEQ == 0);
            const bf16_t* row = proj + (size_t)t * NIN; const bf16_t* prow = row - NIN;
            float r = bf2f(row[c]), k = bf2f(row[C_K + c]), v = bf2f(row[C_V + c]);
            const float pr = first ? 0.f : bf2f(prow[c]), pk = first ? 0.f : bf2f(prow[C_K + c]), pv = first ? 0.f : bf2f(prow[C_V + c]);
            r += (pr - r) * mu_r; k += (pk - k) * mu_k; v += (pv - v) * mu_v;
            const float z = -(w0 + aw[tt]);
            const float sp = z > 20.f ? z : log1pf(__expf(z));
            const float wl = -sp - 0.5f;
            const float logw = -__expf(wl);
            const float a = sigm(a0 + aa[tt]);
            const float kkv = k * kkc;
            const float ss = wave_sum(kkv * kkv);
            const float kkn = kkv / fmaxf(sqrtf(ss), 1e-12f);
            const float kp = k * (1.f + (a - 1.f) * kac);
            const size_t o = (size_t)t * 512 + c;
            oR[o] = f2bf(r); oK[o] = f2bf(kp); oV[o] = f2bf(v); oW[o] = f2bf(logw); oKK[o] = f2bf(kkn); oA[o] = f2bf(a); oG[o] = f2bf(ag[tt]);
        }
    }
}

DEVI void scan_rwkv_naive(const Params& p, unsigned char* smem, int blk) {
    const int tid = threadIdx.x, lane = tid & 63, wid = tid >> 6;
    const int unit = blk * 8 + wid, b = unit >> 3, h = unit & 7, c = h * 64 + lane;
    float* sw = (float*)smem + wid * (4 * 7 * 64);
    float* srk = (float*)smem + 8 * (4 * 7 * 64) + wid * 64;
    const bf16_t* iR = prep_arr(p, 0); const bf16_t* iK = prep_arr(p, 1); const bf16_t* iV = prep_arr(p, 2); const bf16_t* iW = prep_arr(p, 3);
    const bf16_t* iKK = prep_arr(p, 4); const bf16_t* iA = prep_arr(p, 5); const bf16_t* iG = prep_arr(p, 6);
    bf16_t* ya = (bf16_t*)(p.ws + WS_YA);
    srk[lane] = p.in[11][c];
    const float gnw = p.in[12][c], gnb = p.in[13][c];
    float S[64];
#pragma unroll
    for (int j = 0; j < 64; ++j) S[j] = 0.f;
    for (int t0 = 0; t0 < SEQ; t0 += 4) {
        __syncthreads();
#pragma unroll
        for (int s = 0; s < 4; ++s) {
            const size_t o = (size_t)(b * SEQ + t0 + s) * 512 + c;
            const float r = bf2f(iR[o]), k = bf2f(iK[o]), w = __expf(bf2f(iW[o])), kk = bf2f(iKK[o]), a = bf2f(iA[o]);
            float* d = sw + s * 7 * 64 + lane;
            d[0] = r; d[64] = k; d[128] = w; d[192] = -kk; d[256] = kk * a; d[320] = bf2f(iV[o]); d[384] = bf2f(iG[o]);
        }
        __syncthreads();
#pragma unroll 1
        for (int s = 0; s < 4; ++s) {
            const f32x4* vr = (const f32x4*)(sw + s * 7 * 64);
            const f32x4* vk = vr + 16; const f32x4* vw = vr + 32; const f32x4* va = vr + 48; const f32x4* vb = vr + 64;
            const float v = sw[s * 7 * 64 + 320 + lane], g = sw[s * 7 * 64 + 384 + lane];
            float sa = 0.f;
#pragma unroll
            for (int j4 = 0; j4 < 16; ++j4) { const f32x4 a4 = va[j4];
#pragma unroll
                for (int q = 0; q < 4; ++q) sa += S[j4 * 4 + q] * a4[q]; }
            float y = 0.f, bon = 0.f;
#pragma unroll
            for (int j4 = 0; j4 < 16; ++j4) {
                const f32x4 w4 = vw[j4], b4 = vb[j4], k4 = vk[j4], r4 = vr[j4], rk4 = ((const f32x4*)srk)[j4];
#pragma unroll
                for (int q = 0; q < 4; ++q) {
                    const float sn = S[j4 * 4 + q] * w4[q] + sa * b4[q] + v * k4[q];
                    S[j4 * 4 + q] = sn; y += sn * r4[q]; bon += r4[q] * k4[q] * rk4[q];
                }
            }
            const float mean = wave_sum(y) * (1.f / 64.f);
            const float d = y - mean;
            const float var = wave_sum(d * d) * (1.f / 64.f);
            const float outv = (d * rsqrtf(var + GN_EPS) * gnw + gnb + bon * v) * g;
            ya[(size_t)(b * SEQ + t0 + s) * 512 + c] = f2bf(outv);
        }
    }
}
DEVI void scan_hgrn_naive(const Params& p, unsigned char* smem, int blk) {
    const int tid = threadIdx.x, lane = tid & 63, ul = tid >> 7, v = tid & 127, wiu = (tid >> 6) & 1;
    const int unit = blk * 4 + ul, b = unit >> 2, h = unit & 3, c = h * 128 + v;
    float* su = (float*)smem + ul * (4 * 5 * 128);
    float* spart = (float*)smem + 4 * (4 * 5 * 128) + ul * 8;
    const bf16_t* proj = (const bf16_t*)(p.ws + WS_PROJ);
    bf16_t* yb = (bf16_t*)(p.ws + WS_YB);
    const float l0 = p.in[15][c], l1 = p.in[15][512 + c];
    const float lb = 1.f / (1.f + __expf(l1 - l0));
    const float nw = p.in[16][c];
    float S[128];
#pragma unroll
    for (int e = 0; e < 128; ++e) S[e] = 0.f;
    for (int t0 = 0; t0 < SEQ; t0 += 4) {
        __syncthreads();
#pragma unroll
        for (int s = 0; s < 4; ++s) {
            const bf16_t* row = proj + (size_t)(b * SEQ + t0 + s) * NIN;
            const float z = bf2f(row[C_F + c]), qr = bf2f(row[C_Q + c]);
            const float sg = sigm(z);
            float* d = su + s * 5 * 128 + v;
            d[0] = lb + (1.f - lb) * sg; d[128] = (1.f - lb) * (1.f - sg); d[256] = qr * sigm(qr); d[384] = bf2f(row[C_I + c]); d[512] = bf2f(row[C_OG + c]);
        }
        __syncthreads();
        float os[4];
#pragma unroll
        for (int s = 0; s < 4; ++s) {
            const f32x4* vf = (const f32x4*)(su + s * 5 * 128); const f32x4* vk = vf + 32; const f32x4* vq = vf + 64;
            const float vin = su[s * 5 * 128 + 384 + v];
            float o = 0.f;
#pragma unroll
            for (int e4 = 0; e4 < 32; ++e4) {
                const f32x4 f4 = vf[e4], k4 = vk[e4], q4 = vq[e4];
#pragma unroll
                for (int q = 0; q < 4; ++q) { const float sn = f4[q] * S[e4 * 4 + q] + k4[q] * vin; S[e4 * 4 + q] = sn; o += q4[q] * sn; }
            }
            os[s] = o;
            const float ss = wave_sum(o * o);
            if (lane == 0) spart[s * 2 + wiu] = ss;
        }
        __syncthreads();
#pragma unroll
        for (int s = 0; s < 4; ++s) {
            const float tot = spart[s * 2] + spart[s * 2 + 1];
            const float og = su[s * 5 * 128 + 512 + v];
            yb[(size_t)(b * SEQ + t0 + s) * 512 + c] = f2bf(os[s] * rsqrtf(tot * (1.f / 128.f) + RMS_EPS) * nw * sigm(og));
        }
    }
}
DEVI void phase_scans_naive(const Params& p, unsigned char* smem) {
    if (blockIdx.x < 4) scan_rwkv_naive(p, smem, blockIdx.x);
    else if (blockIdx.x < 8) scan_hgrn_naive(p, smem, blockIdx.x - 4);
}

DEVI void phase_merge(const Params& p, unsigned char* smem) {
    const bf16_t* ya = (const bf16_t*)(p.ws + WS_YA); const bf16_t* yb = (const bf16_t*)(p.ws + WS_YB);
    const bf16_t* WaT = (const bf16_t*)(p.ws + WS_WAT); const bf16_t* WbT = (const bf16_t*)(p.ws + WS_WBT);
    const bf16_t* proj = (const bf16_t*)(p.ws + WS_PROJ);
    bf16_t* merged = (bf16_t*)(p.ws + WS_MERGED);
    for (int t = blockIdx.x; t < 128 * 8; t += gridDim.x) {
        const int tm = t >> 3, tn = t & 7;
        f32x4 a1[2][4], a2[2][4]; acc_zero(a1); acc_zero(a2);
        gemm_accum(a1, ya, 512, IdRows{tm * 128}, WaT + (size_t)tn * 128 * 512, 512, 512, (bf16_t*)smem);
        gemm_accum(a2, yb, 512, IdRows{tm * 128}, WbT + (size_t)tn * 128 * 512, 512, 512, (bf16_t*)smem);
        epi2(a1, a2, [&](int r, int c, f32x4 v1, f32x4 v2) {
            const size_t row = tm * 128 + r; const int col = tn * 128 + c;
            const f32x4 ga = ld_bf4(proj + row * NIN + C_GATE + col), gb = ld_bf4(proj + row * NIN + C_GATE + 1024 + col);
            f32x4 o;
#pragma unroll
            for (int q = 0; q < 4; ++q) o[q] = sigm(ga[q]) * v1[q] + sigm(gb[q]) * v2[q];
            st_bf4(merged + row * 1024 + col, o);
        });
    }
}

DEVI void phase_wo(const Params& p, unsigned char* smem) {
    const bf16_t* merged = (const bf16_t*)(p.ws + WS_MERGED); const bf16_t* WoT = (const bf16_t*)(p.ws + WS_WOT);
    const float* x = p.in[0]; float* x1pre = p.out;
    constexpr int T_G = 64 * 8, T_W = 4096;
    for (int t = blockIdx.x; t < T_G + 3 * T_W; t += gridDim.x) {
        if (t < T_G) {
            const int tm = t >> 3, tn = t & 7;
            f32x4 acc[4][4]; acc_zero(acc);
            gemm_accum(acc, merged, 1024, IdRows{tm * 256}, WoT + (size_t)tn * 128 * 1024, 1024, 1024, (bf16_t*)smem);
            epi1(acc, [&](int r, int c, f32x4 v) {
                const size_t o = (size_t)(tm * 256 + r) * 1024 + tn * 128 + c;
                const f32x4 xv = *(const f32x4*)(x + o);
                *(f32x4*)(x1pre + o) = xv * ALPHA + v;
            });
        } else {
            int u = t - T_G; const int which = u / T_W; u -= which * T_W;
            const int e = u >> 7, tt = u & 127;
            if (which == 0) transpose_tile(p.in[25] + (size_t)e * 1024 * 512, (bf16_t*)(p.ws + WS_W1T) + (size_t)e * 512 * 1024, 1024, 512, tt >> 3, tt & 7, (float*)smem);
            else if (which == 1) transpose_tile(p.in[26] + (size_t)e * 1024 * 512, (bf16_t*)(p.ws + WS_W3T) + (size_t)e * 512 * 1024, 1024, 512, tt >> 3, tt & 7, (float*)smem);
            else transpose_tile(p.in[27] + (size_t)e * 512 * 1024, (bf16_t*)(p.ws + WS_W2T) + (size_t)e * 1024 * 512, 512, 1024, tt >> 4, tt & 15, (float*)smem);
        }
    }
}

DEVI void phase_ln1_route(const Params& p, unsigned char* smem) {
    const float* x1pre = p.out; float* x1 = (float*)(p.ws + WS_X1); bf16_t* x1b = (bf16_t*)(p.ws + WS_X1B);
    const float* g = p.in[19]; const float* bta = p.in[20];
    const float* wg = p.in[21]; const float* bg = p.in[22]; const float* we = p.in[23]; const float* be = p.in[24];
    int* cnt = (int*)(p.ws + WS_CNT); int* slot = (int*)(p.ws + WS_SLOT); float* tw = (float*)(p.ws + WS_TW); int* list = (int*)(p.ws + WS_LIST);
    const int lane = threadIdx.x & 63, wid = threadIdx.x >> 6;
    for (int tk = blockIdx.x * 8 + wid; tk < NTOK; tk += gridDim.x * 8) {
        f32x4 xv[4]; float s = 0.f;
#pragma unroll
        for (int i = 0; i < 4; ++i) { xv[i] = *(const f32x4*)(x1pre + (size_t)tk * 1024 + i * 256 + lane * 4); s += xv[i][0] + xv[i][1] + xv[i][2] + xv[i][3]; }
        const float mean = wave_sum(s) * (1.f / 1024.f);
        float s2 = 0.f;
#pragma unroll
        for (int i = 0; i < 4; ++i)
#pragma unroll
            for (int q = 0; q < 4; ++q) { const float d = xv[i][q] - mean; s2 += d * d; }
        const float rstd = rsqrtf(wave_sum(s2) * (1.f / 1024.f) + LN_EPS);
        float lg[36];
#pragma unroll
        for (int o = 0; o < 36; ++o) lg[o] = 0.f;
        float* sy = (float*)smem + wid * 1024;
#pragma unroll
        for (int i = 0; i < 4; ++i) {
            const int col = i * 256 + lane * 4;
            const f32x4 g4 = *(const f32x4*)(g + col), b4 = *(const f32x4*)(bta + col);
            f32x4 y;
#pragma unroll
            for (int q = 0; q < 4; ++q) { y[q] = (xv[i][q] - mean) * rstd * g4[q] + b4[q]; sy[(i * 4 + q) * 64 + lane] = y[q]; }
            *(f32x4*)(x1 + (size_t)tk * 1024 + col) = y;
            st_bf4(x1b + (size_t)tk * 1024 + col, y);
        }
#pragma unroll 1
        for (int cc = 0; cc < 16; ++cc) {
            const float yv = sy[cc * 64 + lane];
            const int col = (cc >> 2) * 256 + lane * 4 + (cc & 3);
            const f32x4 w4 = *(const f32x4*)(wg + (size_t)col * 4);
#pragma unroll
            for (int o = 0; o < 4; ++o) lg[o] += yv * w4[o];
#pragma unroll
            for (int u = 0; u < 8; ++u) {
                const f32x4 e4 = *(const f32x4*)(we + (size_t)col * 32 + u * 4);
#pragma unroll
                for (int o = 0; o < 4; ++o) lg[4 + u * 4 + o] += yv * e4[o];
            }
        }
#pragma unroll
        for (int o = 0; o < 36; ++o) lg[o] = wave_sum(lg[o]);
        float gl[4];
#pragma unroll
        for (int q = 0; q < 4; ++q) gl[q] = lg[q] + bg[q];
        int gs = 0; float gm = gl[0];
#pragma unroll
        for (int q = 1; q < 4; ++q) if (gl[q] > gm) { gm = gl[q]; gs = q; }
        float gden = 0.f;
#pragma unroll
        for (int q = 0; q < 4; ++q) gden += __expf(gl[q] - gm);
        const float pg = 1.f / gden;
        float el[8];
#pragma unroll
        for (int j = 0; j < 8; ++j) {
            const float v0 = lg[4 + j] + be[j], v1 = lg[12 + j] + be[8 + j], v2 = lg[20 + j] + be[16 + j], v3 = lg[28 + j] + be[24 + j];
            el[j] = gs == 0 ? v0 : (gs == 1 ? v1 : (gs == 2 ? v2 : v3));
        }
        int i1 = 0; float m1 = el[0];
#pragma unroll
        for (int j = 1; j < 8; ++j) if (el[j] > m1) { m1 = el[j]; i1 = j; }
        int i2 = -1; float m2 = -3.0e38f;
#pragma unroll
        for (int j = 0; j < 8; ++j) if (j != i1 && el[j] > m2) { m2 = el[j]; i2 = j; }
        const float ex = __expf(m2 - m1);
        const float p1 = 1.f / (1.f + ex), p2 = ex / (1.f + ex);
        if (lane == 0) {
            const int e1 = gs * 8 + i1, e2 = gs * 8 + i2;
            const int pos1 = atomicAdd(cnt + e1, 1), pos2 = atomicAdd(cnt + e2, 1);
            list[(size_t)e1 * NTOK + pos1] = tk; list[(size_t)e2 * NTOK + pos2] = tk;
            slot[tk * 2] = (e1 << 16) | pos1; slot[tk * 2 + 1] = (e2 << 16) | pos2;
            tw[tk * 2] = pg * p1; tw[tk * 2 + 1] = pg * p2;
        }
    }
}

DEVI void moe_find(const int* cnt, int rti, int& e, int& rt, int& rowbase, int& nrows) {
    int rt0 = 0; rowbase = 0; e = 0;
    for (; e < NEXP - 1; ++e) { const int nt = (cnt[e] + 255) >> 8; if (rti < rt0 + nt) break; rt0 += nt; rowbase += nt * 256; }
    rt = rti - rt0; nrows = cnt[e] - rt * 256; nrows = nrows > 256 ? 256 : nrows;
}
DEVI int moe_total_rt(const int* cnt) { int s = 0; for (int e = 0; e < NEXP; ++e) s += (cnt[e] + 255) >> 8; return s; }
DEVI void phase_moe1(const Params& p, unsigned char* smem) {
    const int* cnt = (const int*)(p.ws + WS_CNT); const int* list = (const int*)(p.ws + WS_LIST);
    const bf16_t* x1b = (const bf16_t*)(p.ws + WS_X1B);
    const bf16_t* W1T = (const bf16_t*)(p.ws + WS_W1T); const bf16_t* W3T = (const bf16_t*)(p.ws + WS_W3T);
    bf16_t* hbuf = (bf16_t*)p.out;
    const int total = moe_total_rt(cnt) * 8;
    for (int t = blockIdx.x; t < total; t += gridDim.x) {
        const int rti = t >> 3, ct = t & 3, half = (t >> 2) & 1; int e, rt, rowbase, nrows; moe_find(cnt, rti, e, rt, rowbase, nrows);
        nrows -= half * 128; if (nrows <= 0) continue;
        rowbase += half * 128;
        f32x4 a1[2][4], a2[2][4]; acc_zero(a1); acc_zero(a2);
        const GatherRows gr{list + (size_t)e * NTOK + rt * 256 + half * 128, nrows > 128 ? 128 : nrows};
        gemm_accum(a1, x1b, 1024, gr, W1T + ((size_t)e * 512 + ct * 128) * 1024, 1024, 1024, (bf16_t*)smem);
        gemm_accum(a2, x1b, 1024, gr, W3T + ((size_t)e * 512 + ct * 128) * 1024, 1024, 1024, (bf16_t*)smem);
        epi2(a1, a2, [&](int r, int c, f32x4 v1, f32x4 v2) {
            f32x4 o;
#pragma unroll
            for (int q = 0; q < 4; ++q) o[q] = v1[q] * sigm(v1[q]) * v2[q];
            st_bf4(hbuf + (size_t)(rowbase + rt * 256 + r) * 512 + ct * 128 + c, o);
        });
    }
}
DEVI void phase_moe2(const Params& p, unsigned char* smem) {
    const int* cnt = (const int*)(p.ws + WS_CNT);
    const bf16_t* hbuf = (const bf16_t*)p.out; const bf16_t* W2T = (const bf16_t*)(p.ws + WS_W2T);
    bf16_t* y = (bf16_t*)(p.ws + WS_Y);
    const int total = moe_total_rt(cnt) * 8;
    for (int t = blockIdx.x; t < total; t += gridDim.x) {
        const int rti = t >> 3, ct = t & 7; int e, rt, rowbase, nrows; moe_find(cnt, rti, e, rt, rowbase, nrows);
        f32x4 acc[4][4]; acc_zero(acc);
        gemm_accum(acc, hbuf, 512, IdRows{rowbase + rt * 256}, W2T + ((size_t)e * 1024 + ct * 128) * 512, 512, 512, (bf16_t*)smem);
        epi1(acc, [&](int r, int c, f32x4 v) { st_bf4(y + (size_t)(rowbase + rt * 256 + r) * 1024 + ct * 128 + c, v); });
    }
}

DEVI void phase_ln2(const Params& p, unsigned char* smem) {
    float* x1 = (float*)(p.ws + WS_X1); bf16_t* x2b = (bf16_t*)(p.ws + WS_X1B);
    const bf16_t* y = (const bf16_t*)(p.ws + WS_Y);
    const int* cnt = (const int*)(p.ws + WS_CNT); const int* slot = (const int*)(p.ws + WS_SLOT); const float* tw = (const float*)(p.ws + WS_TW);
    const float* g = p.in[28]; const float* bta = p.in[29];
    const int lane = threadIdx.x & 63, wid = threadIdx.x >> 6;
    for (int tk = blockIdx.x * 8 + wid; tk < NTOK; tk += gridDim.x * 8) {
        const int s0 = slot[tk * 2], s1 = slot[tk * 2 + 1]; const float w0 = tw[tk * 2], w1 = tw[tk * 2 + 1];
        const int e0 = s0 >> 16, e1 = s1 >> 16;
        int rb0 = 0, rb1 = 0;
        for (int e = 0; e < NEXP; ++e) { const int pd = ((cnt[e] + 255) >> 8) << 8; if (e < e0) rb0 += pd; if (e < e1) rb1 += pd; }
        const size_t r0 = (size_t)(rb0 + (s0 & 0xffff)), r1 = (size_t)(rb1 + (s1 & 0xffff));
        f32x4 xv[4]; float s = 0.f;
#pragma unroll
        for (int i = 0; i < 4; ++i) {
            const int col = i * 256 + lane * 4;
            const f32x4 a = *(const f32x4*)(x1 + (size_t)tk * 1024 + col);
            const f32x4 y0 = ld_bf4(y + r0 * 1024 + col), y1 = ld_bf4(y + r1 * 1024 + col);
            xv[i] = a * ALPHA + y0 * w0 + y1 * w1;
            s += xv[i][0] + xv[i][1] + xv[i][2] + xv[i][3];
        }
        const float mean = wave_sum(s) * (1.f / 1024.f);
        float s2 = 0.f;
#pragma unroll
        for (int i = 0; i < 4; ++i)
#pragma unroll
            for (int q = 0; q < 4; ++q) { const float d = xv[i][q] - mean; s2 += d * d; }
        const float rstd = rsqrtf(wave_sum(s2) * (1.f / 1024.f) + LN_EPS);
#pragma unroll
        for (int i = 0; i < 4; ++i) {
            const int col = i * 256 + lane * 4;
            const f32x4 g4 = *(const f32x4*)(g + col), b4 = *(const f32x4*)(bta + col);
            f32x4 o;
#pragma unroll
            for (int q = 0; q < 4; ++q) o[q] = (xv[i][q] - mean) * rstd * g4[q] + b4[q];
            *(f32x4*)(x1 + (size_t)tk * 1024 + col) = o;
            st_bf4(x2b + (size_t)tk * 1024 + col, o);
        }
    }
}

DEVI void phase_final(const Params& p, unsigned char* smem) {
    const float* x2 = (const float*)(p.ws + WS_X1); const bf16_t* x2b = (const bf16_t*)(p.ws + WS_X1B); const bf16_t* pb = (const bf16_t*)(p.ws + WS_PB);
    const bf16_t* WpgT = (const bf16_t*)(p.ws + WS_WPGT); const bf16_t* WpeT = (const bf16_t*)(p.ws + WS_WPET);
    float* out = p.out;
    for (int t = blockIdx.x; t < 128 * 8; t += gridDim.x) {
        const int tm = t >> 3, tn = t & 7;
        f32x4 a1[2][4], a2[2][4]; acc_zero(a1); acc_zero(a2);
        gemm_accum(a1, x2b, 1024, IdRows{tm * 128}, WpgT + (size_t)tn * 128 * 1024, 1024, 1024, (bf16_t*)smem);
        gemm_accum(a2, pb, 256, IdRows{tm * 128}, WpeT + (size_t)tn * 128 * 256, 256, 256, (bf16_t*)smem);
        epi2(a1, a2, [&](int r, int c, f32x4 v1, f32x4 v2) {
            const size_t o = (size_t)(tm * 128 + r) * 1024 + tn * 128 + c;
            const f32x4 xv = *(const f32x4*)(x2 + o);
            f32x4 res;
#pragma unroll
            for (int q = 0; q < 4; ++q) res[q] = xv[q] + sigm(v1[q]) * v2[q];
            *(f32x4*)(out + o) = res;
        });
    }
}

extern __shared__ __attribute__((aligned(16))) unsigned char dyn_smem[];
#define PHASE_KERNEL(name, fn) __global__ void __launch_bounds__(NT) name(Params p) { fn(p, dyn_smem); }
PHASE_KERNEL(k_prep, phase_prep)
PHASE_KERNEL(k_inproj, phase_inproj)
PHASE_KERNEL(k_rwkv_prep, phase_rwkv_prep)
PHASE_KERNEL(k_scans, phase_scans_naive)
PHASE_KERNEL(k_merge, phase_merge)
PHASE_KERNEL(k_wo, phase_wo)
PHASE_KERNEL(k_ln1, phase_ln1_route)
PHASE_KERNEL(k_moe1, phase_moe1)
PHASE_KERNEL(k_moe2, phase_moe2)
PHASE_KERNEL(k_ln2, phase_ln2)
PHASE_KERNEL(k_final, phase_final)

__global__ void __launch_bounds__(NT) k_mega(Params p) {
    cg::grid_group grid = cg::this_grid();
    phase_prep(p, dyn_smem); grid.sync();
    phase_inproj(p, dyn_smem); grid.sync();
    phase_rwkv_prep(p, dyn_smem); grid.sync();
    phase_scans_naive(p, dyn_smem); grid.sync();
    phase_merge(p, dyn_smem); grid.sync();
    phase_wo(p, dyn_smem); grid.sync();
    phase_ln1_route(p, dyn_smem); grid.sync();
    phase_moe1(p, dyn_smem); grid.sync();
    phase_moe2(p, dyn_smem); grid.sync();
    phase_ln2(p, dyn_smem); grid.sync();
    phase_final(p, dyn_smem);
}

extern "C" void kernel_launch(void* const* d_in, const int* in_sizes, int n_in, void* d_out, int out_size, void* d_ws, size_t ws_size, hipStream_t stream) {
    static int grid = 0;
    if (grid == 0) {
        if (n_in != 32 || out_size != NTOK * DM || ws_size < WS_END) { fprintf(stderr, "kernel_launch: unexpected shapes (n_in %d out %d ws %zu, need %zu)\n", n_in, out_size, ws_size, (size_t)WS_END); grid = -1; return; }
        int dev = 0, cus = 0, per_cu = 0;
        hipGetDevice(&dev); hipDeviceGetAttribute(&cus, hipDeviceAttributeMultiprocessorCount, dev);
#if MODE == 0
        const void* ks[] = {(const void*)k_prep, (const void*)k_inproj, (const void*)k_rwkv_prep, (const void*)k_scans, (const void*)k_merge, (const void*)k_wo,
                            (const void*)k_ln1, (const void*)k_moe1, (const void*)k_moe2, (const void*)k_ln2, (const void*)k_final};
        for (auto k : ks) hipFuncSetAttribute(k, hipFuncAttributeMaxDynamicSharedMemorySize, LDS_BYTES);
        grid = cus > 0 ? cus : 256;
#else
        hipFuncSetAttribute((const void*)k_mega, hipFuncAttributeMaxDynamicSharedMemorySize, LDS_BYTES);
        hipOccupancyMaxActiveBlocksPerMultiprocessor(&per_cu, (const void*)k_mega, NT, LDS_BYTES);
        if (per_cu < 1) { fprintf(stderr, "kernel_launch: occupancy query says %d blocks per CU\n", per_cu); grid = -1; return; }
        grid = cus;
#endif
        (void)hipGetLastError();
    }
    if (grid < 0) return;
    Params p{};
    for (int i = 0; i < 32; ++i) p.in[i] = (const float*)d_in[i];
    p.out = (float*)d_out; p.ws = (unsigned char*)d_ws;
#if MODE == 0
    k_prep<<<grid, NT, LDS_BYTES, stream>>>(p);
    k_inproj<<<grid, NT, LDS_BYTES, stream>>>(p);
    k_rwkv_prep<<<grid, NT, LDS_BYTES, stream>>>(p);
    k_scans<<<8, NT, LDS_BYTES, stream>>>(p);
    k_merge<<<grid, NT, LDS_BYTES, stream>>>(p);
    k_wo<<<grid, NT, LDS_BYTES, stream>>>(p);
    k_ln1<<<grid, NT, LDS_BYTES, stream>>>(p);
    k_moe1<<<grid, NT, LDS_BYTES, stream>>>(p);
    k_moe2<<<grid, NT, LDS_BYTES, stream>>>(p);
    k_ln2<<<grid, NT, LDS_BYTES, stream>>>(p);
    k_final<<<grid, NT, LDS_BYTES, stream>>>(p);
#else
    void* args[] = {&p};
    hipError_t e = hipLaunchCooperativeKernel((const void*)k_mega, dim3(grid), dim3(NT), args, LDS_BYTES, stream);
    if (e != hipSuccess) fprintf(stderr, "cooperative launch failed: %s (grid %d)\n", hipGetErrorString(e), grid);
#endif
}
```

```cpp
#include <hip/hip_runtime.h>
#include <hip/hip_cooperative_groups.h>
#include <cstdio>
#include <cstdint>
namespace cg = cooperative_groups;

#ifndef MODE
#define MODE 1
#endif

typedef unsigned short bf16_t;
typedef short bf16x8 __attribute__((ext_vector_type(8)));
typedef float f32x4 __attribute__((ext_vector_type(4)));
typedef unsigned u32x4 __attribute__((ext_vector_type(4)));
typedef unsigned u32x2 __attribute__((ext_vector_type(2)));
#define DEVI __device__ __forceinline__

constexpr int NT = 512;
constexpr int NTOK = 16384, DM = 1024, SEQ = 4096, NIN = 5888, PLE = 256;
constexpr int C_K = 512, C_V = 1024, C_WD = 1536, C_Q = 1792, C_F = 2304, C_I = 2816, C_OG = 3328, C_GATE = 3840;
constexpr int NEXP = 32;
constexpr float ALPHA = 1.189207115002721f;
constexpr float LN_EPS = 1e-5f, RMS_EPS = 1e-6f, GN_EPS = 64e-5f;
constexpr int LDS_BYTES = 65536;

constexpr size_t MiB = 1048576;
constexpr size_t WS_WAT = 0, WS_WBT = 1 * MiB, WS_WOT = 2 * MiB, WS_WPGT = 4 * MiB, WS_WPET = 6 * MiB;
constexpr size_t WS_CNT = 6 * MiB + 512 * 1024;
constexpr size_t WS_SLOT = WS_CNT + 4096;
constexpr size_t WS_TW = WS_SLOT + (size_t)NTOK * 2 * 4;
constexpr size_t WS_LIST = WS_TW + (size_t)NTOK * 2 * 4;
constexpr size_t WS_PB = 12 * MiB;
constexpr size_t WS_PROJ = 20 * MiB;
constexpr size_t WS_W1T = 20 * MiB, WS_W3T = 52 * MiB, WS_W2T = 84 * MiB;
constexpr size_t WS_Y = 116 * MiB;
constexpr size_t WS_XB = 204 * MiB;
constexpr size_t WS_YA = 204 * MiB, WS_YB = 220 * MiB;
constexpr size_t WS_X1B = 204 * MiB;
constexpr size_t WS_WINT = 236 * MiB;
constexpr size_t WS_PREP = 236 * MiB;
constexpr size_t WS_MERGED = 236 * MiB;
constexpr size_t WS_X1 = 236 * MiB;
constexpr size_t WS_END = 300 * MiB;
constexpr int YROWS = 40960;

struct Params { const float* in[32]; float* out; unsigned char* ws; };

DEVI float bf2f(bf16_t h) { return __uint_as_float(((unsigned)h) << 16); }
DEVI bf16_t f2bf(float f) { unsigned u = __float_as_uint(f); u += 0x7fffu + ((u >> 16) & 1u); return (bf16_t)(u >> 16); }
DEVI unsigned pack2(float a, float b) { return (unsigned)f2bf(a) | ((unsigned)f2bf(b) << 16); }
DEVI float sigm(float x) { return 1.f / (1.f + __expf(-x)); }
DEVI float wave_sum(float v) {
#pragma unroll
    for (int o = 32; o > 0; o >>= 1) v += __shfl_xor(v, o, 64);
    return v;
}
DEVI f32x4 ld_bf4(const bf16_t* p) { u32x2 u = *(const u32x2*)p; f32x4 r; r[0] = __uint_as_float(u[0] << 16); r[1] = __uint_as_float(u[0] & 0xffff0000u); r[2] = __uint_as_float(u[1] << 16); r[3] = __uint_as_float(u[1] & 0xffff0000u); return r; }
DEVI void st_bf4(bf16_t* p, f32x4 v) { u32x2 o; o[0] = pack2(v[0], v[1]); o[1] = pack2(v[2], v[3]); *(u32x2*)p = o; }

DEVI void cvt_tile(const float* __restrict__ src, bf16_t* __restrict__ dst, int tile) {
    const size_t base = (size_t)tile * 4096 + threadIdx.x * 8;
    const f32x4 a = *(const f32x4*)(src + base), b = *(const f32x4*)(src + base + 4);
    u32x4 o; o[0] = pack2(a[0], a[1]); o[1] = pack2(a[2], a[3]); o[2] = pack2(b[0], b[1]); o[3] = pack2(b[2], b[3]);
    *(u32x4*)(dst + base) = o;
}
DEVI void transpose_tile(const float* __restrict__ src, bf16_t* __restrict__ dst, int R, int C, int tr, int tc, float* sm) {
    const int tid = threadIdx.x;
    __syncthreads();
#pragma unroll
    for (int i = 0; i < 2; ++i) {
        const int r = (tid >> 4) + 32 * i, c4 = (tid & 15) * 4;
        const f32x4 v = *(const f32x4*)(src + (size_t)(tr * 64 + r) * C + tc * 64 + c4);
        float* d = sm + r * 65 + c4; d[0] = v[0]; d[1] = v[1]; d[2] = v[2]; d[3] = v[3];
    }
    __syncthreads();
    const int c = tid >> 3, r8 = (tid & 7) * 8;
    float v[8];
#pragma unroll
    for (int k = 0; k < 8; ++k) v[k] = sm[(r8 + k) * 65 + c];
    u32x4 o; o[0] = pack2(v[0], v[1]); o[1] = pack2(v[2], v[3]); o[2] = pack2(v[4], v[5]); o[3] = pack2(v[6], v[7]);
    *(u32x4*)(dst + (size_t)(tc * 64 + c) * R + tr * 64 + r8) = o;
}

constexpr int GLD = 72;
struct IdRows { int base; DEVI int operator()(int r) const { return base + r; } };
struct GatherRows { const int* list; int n; DEVI int operator()(int r) const { return r < n ? list[r] : 0; } };

template <int MF, class RowMap>
DEVI void gemm_accum(f32x4 (&acc)[MF][4], const bf16_t* __restrict__ A, int lda, RowMap rowmap,
                     const bf16_t* __restrict__ Bt, int ldb, int K, bf16_t* sm) {
    bf16_t* sA = sm; bf16_t* sB = sm + MF * 64 * GLD;
    const int tid = threadIdx.x, lane = tid & 63, wid = tid >> 6, wr = wid >> 1, wc = wid & 1, fr = lane & 15, fq = lane >> 4;
    const int lrow = tid >> 3, kc = tid & 7;
    const bf16_t* ap[MF]; const bf16_t* bp[2];
#pragma unroll
    for (int i = 0; i < MF; ++i) ap[i] = A + (size_t)rowmap(lrow + 64 * i) * lda + kc * 8;
#pragma unroll
    for (int i = 0; i < 2; ++i) bp[i] = Bt + (size_t)(lrow + 64 * i) * ldb + kc * 8;
    u32x4 ra[MF], rb[2];
#pragma unroll
    for (int i = 0; i < MF; ++i) ra[i] = *(const u32x4*)(ap[i]);
#pragma unroll
    for (int i = 0; i < 2; ++i) rb[i] = *(const u32x4*)(bp[i]);
    const int nk = K >> 6;
    for (int kt = 0; kt < nk; ++kt) {
        __syncthreads();
#pragma unroll
        for (int i = 0; i < MF; ++i) *(u32x4*)(sA + (lrow + 64 * i) * GLD + kc * 8) = ra[i];
#pragma unroll
        for (int i = 0; i < 2; ++i) *(u32x4*)(sB + (lrow + 64 * i) * GLD + kc * 8) = rb[i];
        __syncthreads();
        if (kt + 1 < nk) {
#pragma unroll
            for (int i = 0; i < MF; ++i) ra[i] = *(const u32x4*)(ap[i] + (kt + 1) * 64);
#pragma unroll
            for (int i = 0; i < 2; ++i) rb[i] = *(const u32x4*)(bp[i] + (kt + 1) * 64);
        }
#pragma unroll
        for (int kk = 0; kk < 2; ++kk) {
            bf16x8 af[MF], bfr[4];
#pragma unroll
            for (int m = 0; m < MF; ++m) af[m] = *(const bf16x8*)(sA + (wr * (MF * 16) + m * 16 + fr) * GLD + kk * 32 + fq * 8);
#pragma unroll
            for (int n = 0; n < 4; ++n) bfr[n] = *(const bf16x8*)(sB + (wc * 64 + n * 16 + fr) * GLD + kk * 32 + fq * 8);
#pragma unroll
            for (int m = 0; m < MF; ++m)
#pragma unroll
                for (int n = 0; n < 4; ++n) acc[m][n] = __builtin_amdgcn_mfma_f32_16x16x32_bf16(bfr[n], af[m], acc[m][n], 0, 0, 0);
        }
    }
}
template <int MF> DEVI void acc_zero(f32x4 (&acc)[MF][4]) {
#pragma unroll
    for (int m = 0; m < MF; ++m)
#pragma unroll
        for (int n = 0; n < 4; ++n) acc[m][n] = (f32x4){0.f, 0.f, 0.f, 0.f};
}
template <int MF, class F> DEVI void epi1(const f32x4 (&acc)[MF][4], F f) {
    const int lane = threadIdx.x & 63, wid = threadIdx.x >> 6, wr = wid >> 1, wc = wid & 1, fr = lane & 15, fq = lane >> 4;
#pragma unroll
    for (int m = 0; m < MF; ++m)
#pragma unroll
        for (int n = 0; n < 4; ++n) f(wr * (MF * 16) + m * 16 + fr, wc * 64 + n * 16 + fq * 4, acc[m][n]);
}
template <int MF, class F> DEVI void epi2(const f32x4 (&a1)[MF][4], const f32x4 (&a2)[MF][4], F f) {
    const int lane = threadIdx.x & 63, wid = threadIdx.x >> 6, wr = wid >> 1, wc = wid & 1, fr = lane & 15, fq = lane >> 4;
#pragma unroll
    for (int m = 0; m < MF; ++m)
#pragma unroll
        for (int n = 0; n < 4; ++n) f(wr * (MF * 16) + m * 16 + fr, wc * 64 + n * 16 + fq * 4, a1[m][n], a2[m][n]);
}

DEVI void phase_prep(const Params& p, unsigned char* smem) {
    float* sm = (float*)smem;
    bf16_t* xb = (bf16_t*)(p.ws + WS_XB); bf16_t* pb = (bf16_t*)(p.ws + WS_PB);
    constexpr int T_X = 4096, T_P = 1024, T_WIN = 16 * 92, T_WA = 8 * 16, T_WB = 8 * 16, T_WO = 16 * 16, T_WPE = 4 * 16, T_WPG = 16 * 16;
    constexpr int TOTAL = T_X + T_P + T_WIN + T_WA + T_WB + T_WO + T_WPE + T_WPG;
    for (int t = blockIdx.x; t < TOTAL; t += gridDim.x) {
        int u = t;
        if (u < T_X) { cvt_tile(p.in[0], xb, u); continue; } u -= T_X;
        if (u < T_P) { cvt_tile(p.in[1], pb, u); continue; } u -= T_P;
        if (u < T_WIN) { transpose_tile(p.in[2], (bf16_t*)(p.ws + WS_WINT), 1024, NIN, u / 92, u % 92, sm); continue; } u -= T_WIN;
        if (u < T_WA) { transpose_tile(p.in[14], (bf16_t*)(p.ws + WS_WAT), 512, 1024, u / 16, u % 16, sm); continue; } u -= T_WA;
        if (u < T_WB) { transpose_tile(p.in[17], (bf16_t*)(p.ws + WS_WBT), 512, 1024, u / 16, u % 16, sm); continue; } u -= T_WB;
        if (u < T_WO) { transpose_tile(p.in[18], (bf16_t*)(p.ws + WS_WOT), 1024, 1024, u / 16, u % 16, sm); continue; } u -= T_WO;
        if (u < T_WPE) { transpose_tile(p.in[30], (bf16_t*)(p.ws + WS_WPET), 256, 1024, u / 16, u % 16, sm); continue; } u -= T_WPE;
        transpose_tile(p.in[31], (bf16_t*)(p.ws + WS_WPGT), 1024, 1024, u / 16, u % 16, sm);
    }
    if (blockIdx.x == 0 && threadIdx.x < 32) ((int*)(p.ws + WS_CNT))[threadIdx.x] = 0;
}

DEVI void phase_inproj(const Params& p, unsigned char* smem) {
    const bf16_t* xb = (const bf16_t*)(p.ws + WS_XB); const bf16_t* WinT = (const bf16_t*)(p.ws + WS_WINT);
    bf16_t* proj = (bf16_t*)(p.ws + WS_PROJ);
    for (int t = blockIdx.x; t < 64 * 46; t += gridDim.x) {
        const int tm = t / 46, tn = t % 46;
        f32x4 acc[4][4]; acc_zero(acc);
        gemm_accum(acc, xb, 1024, IdRows{tm * 256}, WinT + (size_t)tn * 128 * 1024, 1024, 1024, (bf16_t*)smem);
        epi1(acc, [&](int r, int c, f32x4 v) { st_bf4(proj + (size_t)(tm * 256 + r) * NIN + tn * 128 + c, v); });
    }
}

DEVI bf16_t* prep_arr(const Params& p, int i) { return i < 4 ? (bf16_t*)(p.ws + WS_PREP + (size_t)i * 16 * MiB) : (bf16_t*)((unsigned char*)p.out + (size_t)(i - 4) * 16 * MiB); }
DEVI void phase_rwkv_prep(const Params& p, unsigned char* smem) {
    float* lin = (float*)smem;
    const bf16_t* proj = (const bf16_t*)(p.ws + WS_PROJ);
    const float* mu = p.in[3]; const float* w_up = p.in[5]; const float* a_up = p.in[7]; const float* g_up = p.in[8];
    const int tid = threadIdx.x, c = tid;
    const float mu_r = mu[c], mu_k = mu[C_K + c], mu_v = mu[C_V + c];
    const float w0 = p.in[4][c], a0 = p.in[6][c], kkc = p.in[9][c], kac = p.in[10][c];
    bf16_t* oR = prep_arr(p, 0); bf16_t* oK = prep_arr(p, 1); bf16_t* oV = prep_arr(p, 2); bf16_t* oW = prep_arr(p, 3);
    bf16_t* oKK = prep_arr(p, 4); bf16_t* oA = prep_arr(p, 5); bf16_t* oG = prep_arr(p, 6);
    for (int grp = blockIdx.x; grp < NTOK / 16; grp += gridDim.x) {
        const int t0 = grp * 16;
        __syncthreads();
#pragma unroll
        for (int i = 0; i < 8; ++i) {
            const int idx = tid + 512 * i, tt = idx >> 8, l = idx & 255, t = t0 + tt, col = C_WD + l;
            const float cur = bf2f(proj[(size_t)t * NIN + col]);
            const float prev = (t % SEQ == 0) ? 0.f : bf2f(proj[(size_t)(t - 1) * NIN + col]);
            const float u = cur + (prev - cur) * mu[col];
            lin[tt * 256 + l] = l < 64 ? tanhf(u) : (l < 128 ? u : sigm(u));
        }
        __syncthreads();
        float aw[16], aa[16], ag[16];
#pragma unroll
        for (int tt = 0; tt < 16; ++tt) { aw[tt] = 0.f; aa[tt] = 0.f; ag[tt] = 0.f; }
        for (int l = 0; l < 64; ++l) {
            const float w = w_up[l * 512 + c], a = a_up[l * 512 + c];
#pragma unroll
            for (int tt = 0; tt < 16; ++tt) { aw[tt] += lin[tt * 256 + l] * w; aa[tt] += lin[tt * 256 + 64 + l] * a; }
        }
        for (int l = 0; l < 128; ++l) {
            const float g = g_up[l * 512 + c];
#pragma unroll
            for (int tt = 0; tt < 16; ++tt) ag[tt] += lin[tt * 256 + 128 + l] * g;
        }
#pragma unroll
        for (int tt = 0; tt < 16; ++tt) {
            const int t = t0 + tt; const bool first = (t % SEQ == 0);
            const bf16_t* row = proj + (size_t)t * NIN; const bf16_t* prow = row - NIN;
            float r = bf2f(row[c]), k = bf2f(row[C_K + c]), v = bf2f(row[C_V + c]);
            const float pr = first ? 0.f : bf2f(prow[c]), pk = first ? 0.f : bf2f(prow[C_K + c]), pv = first ? 0.f : bf2f(prow[C_V + c]);
            r += (pr - r) * mu_r; k += (pk - k) * mu_k; v += (pv - v) * mu_v;
            const float z = -(w0 + aw[tt]);
            const float sp = z > 20.f ? z : log1pf(__expf(z));
            const float wl = -sp - 0.5f;
            const float logw = -__expf(wl);
            const float a = sigm(a0 + aa[tt]);
            const float kkv = k * kkc;
            const float ss = wave_sum(kkv * kkv);
            const float kkn = kkv / fmaxf(sqrtf(ss), 1e-12f);
            const float kp = k * (1.f + (a - 1.f) * kac);
            const size_t o = (size_t)t * 512 + c;
            oR[o] = f2bf(r); oK[o] = f2bf(kp); oV[o] = f2bf(v); oW[o] = f2bf(logw); oKK[o] = f2bf(kkn); oA[o] = f2bf(a); oG[o] = f2bf(ag[tt]);
        }
    }
}

DEVI void scan_rwkv_naive(const Params& p, unsigned char* smem, int blk) {
    const int tid = threadIdx.x, lane = tid & 63, wid = tid >> 6;
    const int unit = blk * 8 + wid, b = unit >> 3, h = unit & 7, c = h * 64 + lane;
    float* sw = (float*)smem + wid * (4 * 7 * 64);
    float* srk = (float*)smem + 8 * (4 * 7 * 64) + wid * 64;
    const bf16_t* iR = prep_arr(p, 0); const bf16_t* iK = prep_arr(p, 1); const bf16_t* iV = prep_arr(p, 2); const bf16_t* iW = prep_arr(p, 3);
    const bf16_t* iKK = prep_arr(p, 4); const bf16_t* iA = prep_arr(p, 5); const bf16_t* iG = prep_arr(p, 6);
    bf16_t* ya = (bf16_t*)(p.ws + WS_YA);
    srk[lane] = p.in[11][c];
    const float gnw = p.in[12][c], gnb = p.in[13][c];
    float S[64];
#pragma unroll
    for (int j = 0; j < 64; ++j) S[j] = 0.f;
    for (int t0 = 0; t0 < SEQ; t0 += 4) {
        __syncthreads();
#pragma unroll
        for (int s = 0; s < 4; ++s) {
            const size_t o = (size_t)(b * SEQ + t0 + s) * 512 + c;
            const float r = bf2f(iR[o]), k = bf2f(iK[o]), w = __expf(bf2f(iW[o])), kk = bf2f(iKK[o]), a = bf2f(iA[o]);
            float* d = sw + s * 7 * 64 + lane;
            d[0] = r; d[64] = k; d[128] = w; d[192] = -kk; d[256] = kk * a; d[320] = bf2f(iV[o]); d[384] = bf2f(iG[o]);
        }
        __syncthreads();
#pragma unroll 1
        for (int s = 0; s < 4; ++s) {
            const f32x4* vr = (const f32x4*)(sw + s * 7 * 64);
            const f32x4* vk = vr + 16; const f32x4* vw = vr + 32; const f32x4* va = vr + 48; const f32x4* vb = vr + 64;
            const float v = sw[s * 7 * 64 + 320 + lane], g = sw[s * 7 * 64 + 384 + lane];
            float sa = 0.f;
#pragma unroll
            for (int j4 = 0; j4 < 16; ++j4) { const f32x4 a4 = va[j4];
#pragma unroll
                for (int q = 0; q < 4; ++q) sa += S[j4 * 4 + q] * a4[q]; }
            float y = 0.f, bon = 0.f;
#pragma unroll
            for (int j4 = 0; j4 < 16; ++j4) {
                const f32x4 w4 = vw[j4], b4 = vb[j4], k4 = vk[j4], r4 = vr[j4], rk4 = ((const f32x4*)srk)[j4];
#pragma unroll
                for (int q = 0; q < 4; ++q) {
                    const float sn = S[j4 * 4 + q] * w4[q] + sa * b4[q] + v * k4[q];
                    S[j4 * 4 + q] = sn; y += sn * r4[q]; bon += r4[q] * k4[q] * rk4[q];
                }
            }
            const float mean = wave_sum(y) * (1.f / 64.f);
            const float d = y - mean;
            const float var = wave_sum(d * d) * (1.f / 64.f);
            const float outv = (d * rsqrtf(var + GN_EPS) * gnw + gnb + bon * v) * g;
            ya[(size_t)(b * SEQ + t0 + s) * 512 + c] = f2bf(outv);
        }
    }
}
DEVI void scan_hgrn_naive(const Params& p, unsigned char* smem, int blk) {
    const int tid = threadIdx.x, lane = tid & 63, ul = tid >> 7, v = tid & 127, wiu = (tid >> 6) & 1;
    const int unit = blk * 4 + ul, b = unit >> 2, h = unit & 3, c = h * 128 + v;
    float* su = (float*)smem + ul * (4 * 5 * 128);
    float* spart = (float*)smem + 4 * (4 * 5 * 128) + ul * 8;
    const bf16_t* proj = (const bf16_t*)(p.ws + WS_PROJ);
    bf16_t* yb = (bf16_t*)(p.ws + WS_YB);
    const float l0 = p.in[15][c], l1 = p.in[15][512 + c];
    const float lb = 1.f / (1.f + __expf(l1 - l0));
    const float nw = p.in[16][c];
    float S[128];
#pragma unroll
    for (int e = 0; e < 128; ++e) S[e] = 0.f;
    for (int t0 = 0; t0 < SEQ; t0 += 4) {
        __syncthreads();
#pragma unroll
        for (int s = 0; s < 4; ++s) {
            const bf16_t* row = proj + (size_t)(b * SEQ + t0 + s) * NIN;
            const float z = bf2f(row[C_F + c]), qr = bf2f(row[C_Q + c]);
            const float sg = sigm(z);
            float* d = su + s * 5 * 128 + v;
            d[0] = lb + (1.f - lb) * sg; d[128] = (1.f - lb) * (1.f - sg); d[256] = qr * sigm(qr); d[384] = bf2f(row[C_I + c]); d[512] = bf2f(row[C_OG + c]);
        }
        __syncthreads();
        float os[4];
#pragma unroll
        for (int s = 0; s < 4; ++s) {
            const f32x4* vf = (const f32x4*)(su + s * 5 * 128); const f32x4* vk = vf + 32; const f32x4* vq = vf + 64;
            const float vin = su[s * 5 * 128 + 384 + v];
            float o = 0.f;
#pragma unroll
            for (int e4 = 0; e4 < 32; ++e4) {
                const f32x4 f4 = vf[e4], k4 = vk[e4], q4 = vq[e4];
#pragma unroll
                for (int q = 0; q < 4; ++q) { const float sn = f4[q] * S[e4 * 4 + q] + k4[q] * vin; S[e4 * 4 + q] = sn; o += q4[q] * sn; }
            }
            os[s] = o;
            const float ss = wave_sum(o * o);
            if (lane == 0) spart[s * 2 + wiu] = ss;
        }
        __syncthreads();
#pragma unroll
        for (int s = 0; s < 4; ++s) {
            const float tot = spart[s * 2] + spart[s * 2 + 1];
            const float og = su[s * 5 * 128 + 512 + v];
            yb[(size_t)(b * SEQ + t0 + s) * 512 + c] = f2bf(os[s] * rsqrtf(tot * (1.f / 128.f) + RMS_EPS) * nw * sigm(og));
        }
    }
}
DEVI void phase_scans_naive(const Params& p, unsigned char* smem) {
    if (blockIdx.x < 4) scan_rwkv_naive(p, smem, blockIdx.x);
    else if (blockIdx.x < 8) scan_hgrn_naive(p, smem, blockIdx.x - 4);
}

DEVI void phase_merge(const Params& p, unsigned char* smem) {
    const bf16_t* ya = (const bf16_t*)(p.ws + WS_YA); const bf16_t* yb = (const bf16_t*)(p.ws + WS_YB);
    const bf16_t* WaT = (const bf16_t*)(p.ws + WS_WAT); const bf16_t* WbT = (const bf16_t*)(p.ws + WS_WBT);
    const bf16_t* proj = (const bf16_t*)(p.ws + WS_PROJ);
    bf16_t* merged = (bf16_t*)(p.ws + WS_MERGED);
    for (int t = blockIdx.x; t < 128 * 8; t += gridDim.x) {
        const int tm = t >> 3, tn = t & 7;
        f32x4 a1[2][4], a2[2][4]; acc_zero(a1); acc_zero(a2);
        gemm_accum(a1, ya, 512, IdRows{tm * 128}, WaT + (size_t)tn * 128 * 512, 512, 512, (bf16_t*)smem);
        gemm_accum(a2, yb, 512, IdRows{tm * 128}, WbT + (size_t)tn * 128 * 512, 512, 512, (bf16_t*)smem);
        epi2(a1, a2, [&](int r, int c, f32x4 v1, f32x4 v2) {
            const size_t row = tm * 128 + r; const int col = tn * 128 + c;
            const f32x4 ga = ld_bf4(proj + row * NIN + C_GATE + col), gb = ld_bf4(proj + row * NIN + C_GATE + 1024 + col);
            f32x4 o;
#pragma unroll
            for (int q = 0; q < 4; ++q) o[q] = sigm(ga[q]) * v1[q] + sigm(gb[q]) * v2[q];
            st_bf4(merged + row * 1024 + col, o);
        });
    }
}

DEVI void phase_wo(const Params& p, unsigned char* smem) {
    const bf16_t* merged = (const bf16_t*)(p.ws + WS_MERGED); const bf16_t* WoT = (const bf16_t*)(p.ws + WS_WOT);
    const float* x = p.in[0]; float* x1pre = p.out;
    constexpr int T_G = 64 * 8, T_W = 4096;
    for (int t = blockIdx.x; t < T_G + 3 * T_W; t += gridDim.x) {
        if (t < T_G) {
            const int tm = t >> 3, tn = t & 7;
            f32x4 acc[4][4]; acc_zero(acc);
            gemm_accum(acc, merged, 1024, IdRows{tm * 256}, WoT + (size_t)tn * 128 * 1024, 1024, 1024, (bf16_t*)smem);
            epi1(acc, [&](int r, int c, f32x4 v) {
                const size_t o = (size_t)(tm * 256 + r) * 1024 + tn * 128 + c;
                const f32x4 xv = *(const f32x4*)(x + o);
                *(f32x4*)(x1pre + o) = xv * ALPHA + v;
            });
        } else {
            int u = t - T_G; const int which = u / T_W; u -= which * T_W;
            const int e = u >> 7, tt = u & 127;
            if (which == 0) transpose_tile(p.in[25] + (size_t)e * 1024 * 512, (bf16_t*)(p.ws + WS_W1T) + (size_t)e * 512 * 1024, 1024, 512, tt >> 3, tt & 7, (float*)smem);
            else if (which == 1) transpose_tile(p.in[26] + (size_t)e * 1024 * 512, (bf16_t*)(p.ws + WS_W3T) + (size_t)e * 512 * 1024, 1024, 512, tt >> 3, tt & 7, (float*)smem);
            else transpose_tile(p.in[27] + (size_t)e * 512 * 1024, (bf16_t*)(p.ws + WS_W2T) + (size_t)e * 1024 * 512, 512, 1024, tt >> 4, tt & 15, (float*)smem);
        }
    }
}

DEVI void phase_ln1_route(const Params& p, unsigned char* smem) {
    const float* x1pre = p.out; float* x1 = (float*)(p.ws + WS_X1); bf16_t* x1b = (bf16_t*)(p.ws + WS_X1B);
    const float* g = p.in[19]; const float* bta = p.in[20];
    const float* wg = p.in[21]; const float* bg = p.in[22]; const float* we = p.in[23]; const float* be = p.in[24];
    int* cnt = (int*)(p.ws + WS_CNT); int* slot = (int*)(p.ws + WS_SLOT); float* tw = (float*)(p.ws + WS_TW); int* list = (int*)(p.ws + WS_LIST);
    const int lane = threadIdx.x & 63, wid = threadIdx.x >> 6;
    for (int tk = blockIdx.x * 8 + wid; tk < NTOK; tk += gridDim.x * 8) {
        f32x4 xv[4]; float s = 0.f;
#pragma unroll
        for (int i = 0; i < 4; ++i) { xv[i] = *(const f32x4*)(x1pre + (size_t)tk * 1024 + i * 256 + lane * 4); s += xv[i][0] + xv[i][1] + xv[i][2] + xv[i][3]; }
        const float mean = wave_sum(s) * (1.f / 1024.f);
        float s2 = 0.f;
#pragma unroll
        for (int i = 0; i < 4; ++i)
#pragma unroll
            for (int q = 0; q < 4; ++q) { const float d = xv[i][q] - mean; s2 += d * d; }
        const float rstd = rsqrtf(wave_sum(s2) * (1.f / 1024.f) + LN_EPS);
        float lg[36];
#pragma unroll
        for (int o = 0; o < 36; ++o) lg[o] = 0.f;
        float* sy = (float*)smem + wid * 1024;
#pragma unroll
        for (int i = 0; i < 4; ++i) {
            const int col = i * 256 + lane * 4;
            const f32x4 g4 = *(const f32x4*)(g + col), b4 = *(const f32x4*)(bta + col);
            f32x4 y;
#pragma unroll
            for (int q = 0; q < 4; ++q) { y[q] = (xv[i][q] - mean) * rstd * g4[q] + b4[q]; sy[(i * 4 + q) * 64 + lane] = y[q]; }
            *(f32x4*)(x1 + (size_t)tk * 1024 + col) = y;
            st_bf4(x1b + (size_t)tk * 1024 + col, y);
        }
#pragma unroll 1
        for (int cc = 0; cc < 16; ++cc) {
            const float yv = sy[cc * 64 + lane];
            const int col = (cc >> 2) * 256 + lane * 4 + (cc & 3);
            const f32x4 w4 = *(const f32x4*)(wg + (size_t)col * 4);
#pragma unroll
            for (int o = 0; o < 4; ++o) lg[o] += yv * w4[o];
#pragma unroll
            for (int u = 0; u < 8; ++u) {
                const f32x4 e4 = *(const f32x4*)(we + (size_t)col * 32 + u * 4);
#pragma unroll
                for (int o = 0; o < 4; ++o) lg[4 + u * 4 + o] += yv * e4[o];
            }
        }
#pragma unroll
        for (int o = 0; o < 36; ++o) lg[o] = wave_sum(lg[o]);
        float gl[4];
#pragma unroll
        for (int q = 0; q < 4; ++q) gl[q] = lg[q] + bg[q];
        int gs = 0; float gm = gl[0];
#pragma unroll
        for (int q = 1; q < 4; ++q) if (gl[q] > gm) { gm = gl[q]; gs = q; }
        float gden = 0.f;
#pragma unroll
        for (int q = 0; q < 4; ++q) gden += __expf(gl[q] - gm);
        const float pg = 1.f / gden;
        float el[8];
#pragma unroll
        for (int j = 0; j < 8; ++j) {
            const float v0 = lg[4 + j] + be[j], v1 = lg[12 + j] + be[8 + j], v2 = lg[20 + j] + be[16 + j], v3 = lg[28 + j] + be[24 + j];
            el[j] = gs == 0 ? v0 : (gs == 1 ? v1 : (gs == 2 ? v2 : v3));
        }
        int i1 = 0; float m1 = el[0];
#pragma unroll
        for (int j = 1; j < 8; ++j) if (el[j] > m1) { m1 = el[j]; i1 = j; }
        int i2 = -1; float m2 = -3.0e38f;
#pragma unroll
        for (int j = 0; j < 8; ++j) if (j != i1 && el[j] > m2) { m2 = el[j]; i2 = j; }
        const float ex = __expf(m2 - m1);
        const float p1 = 1.f / (1.f + ex), p2 = ex / (1.f + ex);
        if (lane == 0) {
            const int e1 = gs * 8 + i1, e2 = gs * 8 + i2;
            const int pos1 = atomicAdd(cnt + e1, 1), pos2 = atomicAdd(cnt + e2, 1);
            list[(size_t)e1 * NTOK + pos1] = tk; list[(size_t)e2 * NTOK + pos2] = tk;
            slot[tk * 2] = (e1 << 16) | pos1; slot[tk * 2 + 1] = (e2 << 16) | pos2;
            tw[tk * 2] = pg * p1; tw[tk * 2 + 1] = pg * p2;
        }
    }
}

DEVI void moe_find(const int* cnt, int rti, int& e, int& rt, int& rowbase, int& nrows) {
    int rt0 = 0; rowbase = 0; e = 0;
    for (; e < NEXP - 1; ++e) { const int nt = (cnt[e] + 255) >> 8; if (rti < rt0 + nt) break; rt0 += nt; rowbase += nt * 256; }
    rt = rti - rt0; nrows = cnt[e] - rt * 256; nrows = nrows > 256 ? 256 : nrows;
}
DEVI int moe_total_rt(const int* cnt) { int s = 0; for (int e = 0; e < NEXP; ++e) s += (cnt[e] + 255) >> 8; return s; }
DEVI void phase_moe1(const Params& p, unsigned char* smem) {
    const int* cnt = (const int*)(p.ws + WS_CNT); const int* list = (const int*)(p.ws + WS_LIST);
    const bf16_t* x1b = (const bf16_t*)(p.ws + WS_X1B);
    const bf16_t* W1T = (const bf16_t*)(p.ws + WS_W1T); const bf16_t* W3T = (const bf16_t*)(p.ws + WS_W3T);
    bf16_t* hbuf = (bf16_t*)p.out;
    const int total = moe_total_rt(cnt) * 8;
    for (int t = blockIdx.x; t < total; t += gridDim.x) {
        const int rti = t >> 3, ct = t & 3, half = (t >> 2) & 1; int e, rt, rowbase, nrows; moe_find(cnt, rti, e, rt, rowbase, nrows);
        nrows -= half * 128; if (nrows <= 0) continue;
        rowbase += half * 128;
        f32x4 a1[2][4], a2[2][4]; acc_zero(a1); acc_zero(a2);
        const GatherRows gr{list + (size_t)e * NTOK + rt * 256 + half * 128, nrows > 128 ? 128 : nrows};
        gemm_accum(a1, x1b, 1024, gr, W1T + ((size_t)e * 512 + ct * 128) * 1024, 1024, 1024, (bf16_t*)smem);
        gemm_accum(a2, x1b, 1024, gr, W3T + ((size_t)e * 512 + ct * 128) * 1024, 1024, 1024, (bf16_t*)smem);
        epi2(a1, a2, [&](int r, int c, f32x4 v1, f32x4 v2) {
            f32x4 o;
#pragma unroll
            for (int q = 0; q < 4; ++q) o[q] = v1[q] * sigm(v1[q]) * v2[q];
            st_bf4(hbuf + (size_t)(rowbase + rt * 256 + r) * 512 + ct * 128 + c, o);
        });
    }
}
DEVI void phase_moe2(const Params& p, unsigned char* smem) {
    const int* cnt = (const int*)(p.ws + WS_CNT);
    const bf16_t* hbuf = (const bf16_t*)p.out; const bf16_t* W2T = (const bf16_t*)(p.ws + WS_W2T);
    bf16_t* y = (bf16_t*)(p.ws + WS_Y);
    const int total = moe_total_rt(cnt) * 8;
    for (int t = blockIdx.x; t < total; t += gridDim.x) {
        const int rti = t >> 3, ct = t & 7; int e, rt, rowbase, nrows; moe_find(cnt, rti, e, rt, rowbase, nrows);
        f32x4 acc[4][4]; acc_zero(acc);
        gemm_accum(acc, hbuf, 512, IdRows{rowbase + rt * 256}, W2T + ((size_t)e * 1024 + ct * 128) * 512, 512, 512, (bf16_t*)smem);
        epi1(acc, [&](int r, int c, f32x4 v) { st_bf4(y + (size_t)(rowbase + rt * 256 + r) * 1024 + ct * 128 + c, v); });
    }
}

DEVI void phase_ln2(const Params& p, unsigned char* smem) {
    float* x1 = (float*)(p.ws + WS_X1); bf16_t* x2b = (bf16_t*)(p.ws + WS_X1B);
    const bf16_t* y = (const bf16_t*)(p.ws + WS_Y);
    const int* cnt = (const int*)(p.ws + WS_CNT); const int* slot = (const int*)(p.ws + WS_SLOT); const float* tw = (const float*)(p.ws + WS_TW);
    const float* g = p.in[28]; const float* bta = p.in[29];
    const int lane = threadIdx.x & 63, wid = threadIdx.x >> 6;
    for (int tk = blockIdx.x * 8 + wid; tk < NTOK; tk += gridDim.x * 8) {
        const int s0 = slot[tk * 2], s1 = slot[tk * 2 + 1]; const float w0 = tw[tk * 2], w1 = tw[tk * 2 + 1];
        const int e0 = s0 >> 16, e1 = s1 >> 16;
        int rb0 = 0, rb1 = 0;
        for (int e = 0; e < NEXP; ++e) { const int pd = ((cnt[e] + 255) >> 8) << 8; if (e < e0) rb0 += pd; if (e < e1) rb1 += pd; }
        const size_t r0 = (size_t)(rb0 + (s0 & 0xffff)), r1 = (size_t)(rb1 + (s1 & 0xffff));
        f32x4 xv[4]; float s = 0.f;
#pragma unroll
        for (int i = 0; i < 4; ++i) {
            const int col = i * 256 + lane * 4;
            const f32x4 a = *(const f32x4*)(x1 + (size_t)tk * 1024 + col);
            const f32x4 y0 = ld_bf4(y + r0 * 1024 + col), y1 = ld_bf4(y + r1 * 1024 + col);
            xv[i] = a * ALPHA + y0 * w0 + y1 * w1;
            s += xv[i][0] + xv[i][1] + xv[i][2] + xv[i][3];
        }
        const float mean = wave_sum(s) * (1.f / 1024.f);
        float s2 = 0.f;
#pragma unroll
        for (int i = 0; i < 4; ++i)
#pragma unroll
            for (int q = 0; q < 4; ++q) { const float d = xv[i][q] - mean; s2 += d * d; }
        const float rstd = rsqrtf(wave_sum(s2) * (1.f / 1024.f) + LN_EPS);
#pragma unroll
        for (int i = 0; i < 4; ++i) {
            const int col = i * 256 + lane * 4;
            const f32x4 g4 = *(const f32x4*)(g + col), b4 = *(const f32x4*)(bta + col);
            f32x4 o;
#pragma unroll
            for (int q = 0; q < 4; ++q) o[q] = (xv[i][q] - mean) * rstd * g4[q] + b4[q];
            *(f32x4*)(x1 + (size_t)tk * 1024 + col) = o;
            st_bf4(x2b + (size_t)tk * 1024 + col, o);
        }
    }
}

DEVI void phase_final(const Params& p, unsigned char* smem) {
    const float* x2 = (const float*)(p.ws + WS_X1); const bf16_t* x2b = (const bf16_t*)(p.ws + WS_X1B); const bf16_t* pb = (const bf16_t*)(p.ws + WS_PB);
    const bf16_t* WpgT = (const bf16_t*)(p.ws + WS_WPGT); const bf16_t* WpeT = (const bf16_t*)(p.ws + WS_WPET);
    float* out = p.out;
    for (int t = blockIdx.x; t < 128 * 8; t += gridDim.x) {
        const int tm = t >> 3, tn = t & 7;
        f32x4 a1[2][4], a2[2][4]; acc_zero(a1); acc_zero(a2);
        gemm_accum(a1, x2b, 1024, IdRows{tm * 128}, WpgT + (size_t)tn * 128 * 1024, 1024, 1024, (bf16_t*)smem);
        gemm_accum(a2, pb, 256, IdRows{tm * 128}, WpeT + (size_t)tn * 128 * 256, 256, 256, (bf16_t*)smem);
        epi2(a1, a2, [&](int r, int c, f32x4 v1, f32x4 v2) {
            const size_t o = (size_t)(tm * 128 + r) * 1024 + tn * 128 + c;
            const f32x4 xv = *(const f32x4*)(x2 + o);
            f32x4 res;
#pragma unroll
            for (int q = 0; q < 4; ++q) res[q] = xv[q] + sigm(v1[q]) * v2[q];
            *(f32x4*)(out + o) = res;
        });
    }
}

extern __shared__ __attribute__((aligned(16))) unsigned char dyn_smem[];
#define PHASE_KERNEL(name, fn) __global__ void __launch_bounds__(NT) name(Params p) { fn(p, dyn_smem); }
PHASE_KERNEL(k_prep, phase_prep)
PHASE_KERNEL(k_inproj, phase_inproj)
PHASE_KERNEL(k_rwkv_prep, phase_rwkv_prep)
PHASE_KERNEL(k_scans, phase_scans_naive)
PHASE_KERNEL(k_merge, phase_merge)
PHASE_KERNEL(k_wo, phase_wo)
PHASE_KERNEL(k_ln1, phase_ln1_route)
PHASE_KERNEL(k_moe1, phase_moe1)
PHASE_KERNEL(k_moe2, phase_moe2)
PHASE_KERNEL(k_ln2, phase_ln2)
PHASE_KERNEL(k_final, phase_final)

__global__ void __launch_bounds__(NT) k_mega(Params p) {
    cg::grid_group grid = cg::this_grid();
    phase_prep(p, dyn_smem); grid.sync();
    phase_inproj(p, dyn_smem); grid.sync();
    phase_rwkv_prep(p, dyn_smem); grid.sync();
    phase_scans_naive(p, dyn_smem); grid.sync();
    phase_merge(p, dyn_smem); grid.sync();
    phase_wo(p, dyn_smem); grid.sync();
    phase_ln1_route(p, dyn_smem); grid.sync();
    phase_moe1(p, dyn_smem); grid.sync();
    phase_moe2(p, dyn_smem); grid.sync();
    phase_ln2(p, dyn_smem); grid.sync();
    phase_final(p, dyn_smem);
}

extern "C" void kernel_launch(void* const* d_in, const int* in_sizes, int n_in, void* d_out, int out_size, void* d_ws, size_t ws_size, hipStream_t stream) {
    static int grid = 0;
    if (grid == 0) {
        if (n_in != 32 || out_size != NTOK * DM || ws_size < WS_END) { fprintf(stderr, "kernel_launch: unexpected shapes (n_in %d out %d ws %zu, need %zu)\n", n_in, out_size, ws_size, (size_t)WS_END); grid = -1; return; }
        int dev = 0, cus = 0, per_cu = 0;
        hipGetDevice(&dev); hipDeviceGetAttribute(&cus, hipDeviceAttributeMultiprocessorCount, dev);
#if MODE == 0
        const void* ks[] = {(const void*)k_prep, (const void*)k_inproj, (const void*)k_rwkv_prep, (const void*)k_scans, (const void*)k_merge, (const void*)k_wo,
                            (const void*)k_ln1, (const void*)k_moe1, (const void*)k_moe2, (const void*)k_ln2, (const void*)k_final};
        for (auto k : ks) hipFuncSetAttribute(k, hipFuncAttributeMaxDynamicSharedMemorySize, LDS_BYTES);
        grid = cus > 0 ? cus : 256;
#else
        hipFuncSetAttribute((const void*)k_mega, hipFuncAttributeMaxDynamicSharedMemorySize, LDS_BYTES);
        hipOccupancyMaxActiveBlocksPerMultiprocessor(&per_cu, (const void*)k_mega, NT, LDS_BYTES);
        if (per_cu < 1) { fprintf(stderr, "kernel_launch: occupancy query says %d blocks per CU\n", per_cu); grid = -1; return; }
        grid = cus;
#endif
        (void)hipGetLastError();
    }
    if (grid < 0) return;
    Params p{};
    for (int i = 0; i < 32; ++i) p.in[i] = (const float*)d_in[i];
    p.out = (float*)d_out; p.ws = (unsigned char*)d_ws;
#if MODE == 0
    k_prep<<<grid, NT, LDS_BYTES, stream>>>(p);
    k_inproj<<<grid, NT, LDS_BYTES, stream>>>(p);
    k_rwkv_prep<<<grid, NT, LDS_BYTES, stream>>>(p);
    k_scans<<<8, NT, LDS_BYTES, stream>>>(p);
    k_merge<<<grid, NT, LDS_BYTES, stream>>>(p);
    k_wo<<<grid, NT, LDS_BYTES, stream>>>(p);
    k_ln1<<<grid, NT, LDS_BYTES, stream>>>(p);
    k_moe1<<<grid, NT, LDS_BYTES, stream>>>(p);
    k_moe2<<<grid, NT, LDS_BYTES, stream>>>(p);
    k_ln2<<<grid, NT, LDS_BYTES, stream>>>(p);
    k_final<<<grid, NT, LDS_BYTES, stream>>>(p);
#else
    void* args[] = {&p};
    hipError_t e = hipLaunchCooperativeKernel((const void*)k_mega, dim3(grid), dim3(NT), args, LDS_BYTES, stream);
    if (e != hipSuccess) fprintf(stderr, "cooperative launch failed: %s (grid %d)\n", hipGetErrorString(e), grid);
#endif
}
```

```cpp
#include <hip/hip_runtime.h>
#include <hip/hip_cooperative_groups.h>
#include <cstdio>
#include <cstdint>
namespace cg = cooperative_groups;

#ifndef MODE
#define MODE 1
#endif

typedef unsigned short bf16_t;
typedef short bf16x8 __attribute__((ext_vector_type(8)));
typedef float f32x4 __attribute__((ext_vector_type(4)));
typedef unsigned u32x4 __attribute__((ext_vector_type(4)));
typedef unsigned u32x2 __attribute__((ext_vector_type(2)));
typedef float f32x2 __attribute__((ext_vector_type(2)));
#define DEVI __device__ __forceinline__

constexpr int NT = 512;
constexpr int NTOK = 16384, DM = 1024, SEQ = 4096, NIN = 5888, PLE = 256;
constexpr int C_K = 512, C_V = 1024, C_WD = 1536, NRW = 1792, NHG = 2048;
constexpr int H_Q = 0, H_F = 512, H_I = 1024, H_OG = 1536;
constexpr int NEXP = 32;
constexpr float ALPHA = 1.189207115002721f;
constexpr float LN_EPS = 1e-5f, RMS_EPS = 1e-6f, GN_EPS = 64e-5f;
constexpr int LDS_BYTES = 131072;

constexpr size_t MiB = 1048576;
constexpr size_t WS_WAT = 0, WS_WBT = 1 * MiB, WS_WOT = 2 * MiB, WS_WPGT = 4 * MiB, WS_WPET = 6 * MiB;
constexpr size_t WS_CNT = 6 * MiB + 512 * 1024;
constexpr size_t WS_SLOT = WS_CNT + 4096;
constexpr size_t WS_TW = WS_SLOT + (size_t)NTOK * 2 * 4;
constexpr size_t WS_LIST = WS_TW + (size_t)NTOK * 2 * 4;
constexpr size_t WS_GBUF = 9 * MiB;
constexpr size_t WS_PB = 12 * MiB;
constexpr size_t WS_PRW = 20 * MiB;
constexpr size_t WS_PHG = 76 * MiB;
constexpr size_t WS_PGT = 140 * MiB;
constexpr size_t WS_W1T = 20 * MiB, WS_W3T = 52 * MiB, WS_W2T = 84 * MiB;
constexpr size_t WS_Y = 116 * MiB;
constexpr size_t WS_XB = 204 * MiB;
constexpr size_t WS_YA = 204 * MiB, WS_YB = 220 * MiB;
constexpr size_t WS_X1B = 204 * MiB;
constexpr size_t WS_WINT = 236 * MiB;
constexpr size_t WS_PREP = 236 * MiB;
constexpr size_t WS_MERGED = 236 * MiB;
constexpr size_t WS_X1 = 236 * MiB;
constexpr size_t WS_END = 300 * MiB;
constexpr int YROWS = 40960;

struct Params { const float* in[32]; float* out; unsigned char* ws; };

DEVI float bf2f(bf16_t h) { return __uint_as_float(((unsigned)h) << 16); }
DEVI bf16_t f2bf(float f) { unsigned u = __float_as_uint(f); u += 0x7fffu + ((u >> 16) & 1u); return (bf16_t)(u >> 16); }
DEVI unsigned pack2(float a, float b) { return (unsigned)f2bf(a) | ((unsigned)f2bf(b) << 16); }
DEVI float sigm(float x) { return 1.f / (1.f + __expf(-x)); }
DEVI float wave_sum(float v) {
#pragma unroll
    for (int o = 32; o > 0; o >>= 1) v += __shfl_xor(v, o, 64);
    return v;
}
DEVI f32x4 ld_bf4(const bf16_t* p) { u32x2 u = *(const u32x2*)p; f32x4 r; r[0] = __uint_as_float(u[0] << 16); r[1] = __uint_as_float(u[0] & 0xffff0000u); r[2] = __uint_as_float(u[1] << 16); r[3] = __uint_as_float(u[1] & 0xffff0000u); return r; }
DEVI void st_bf4(bf16_t* p, f32x4 v) { u32x2 o; o[0] = pack2(v[0], v[1]); o[1] = pack2(v[2], v[3]); *(u32x2*)p = o; }

DEVI void cvt_tile(const float* __restrict__ src, bf16_t* __restrict__ dst, int tile) {
    const size_t base = (size_t)tile * 4096 + threadIdx.x * 8;
    const f32x4 a = *(const f32x4*)(src + base), b = *(const f32x4*)(src + base + 4);
    u32x4 o; o[0] = pack2(a[0], a[1]); o[1] = pack2(a[2], a[3]); o[2] = pack2(b[0], b[1]); o[3] = pack2(b[2], b[3]);
    *(u32x4*)(dst + base) = o;
}
DEVI void transpose_tile(const float* __restrict__ src, bf16_t* __restrict__ dst, int R, int C, int tr, int tc, float* sm) {
    const int tid = threadIdx.x;
    __syncthreads();
#pragma unroll
    for (int i = 0; i < 2; ++i) {
        const int r = (tid >> 4) + 32 * i, c4 = (tid & 15) * 4;
        const f32x4 v = *(const f32x4*)(src + (size_t)(tr * 64 + r) * C + tc * 64 + c4);
        float* d = sm + r * 65 + c4; d[0] = v[0]; d[1] = v[1]; d[2] = v[2]; d[3] = v[3];
    }
    __syncthreads();
    const int c = tid >> 3, r8 = (tid & 7) * 8;
    float v[8];
#pragma unroll
    for (int k = 0; k < 8; ++k) v[k] = sm[(r8 + k) * 65 + c];
    u32x4 o; o[0] = pack2(v[0], v[1]); o[1] = pack2(v[2], v[3]); o[2] = pack2(v[4], v[5]); o[3] = pack2(v[6], v[7]);
    *(u32x4*)(dst + (size_t)(tc * 64 + c) * R + tr * 64 + r8) = o;
}

constexpr int GLD = 72;
struct IdRows { int base; DEVI int operator()(int r) const { return base + r; } };
struct GatherRows { const int* list; int n; DEVI int operator()(int r) const { return r < n ? list[r] : 0; } };

template <int MF, class RowMap>
DEVI void gemm_accum(f32x4 (&acc)[MF][4], const bf16_t* __restrict__ A, int lda, RowMap rowmap,
                     const bf16_t* __restrict__ Bt, int ldb, int K, bf16_t* sm) {
    bf16_t* sA = sm; bf16_t* sB = sm + MF * 64 * GLD;
    const int tid = threadIdx.x, lane = tid & 63, wid = tid >> 6, wr = wid >> 1, wc = wid & 1, fr = lane & 15, fq = lane >> 4;
    const int lrow = tid >> 3, kc = tid & 7;
    const bf16_t* ap[MF]; const bf16_t* bp[2];
#pragma unroll
    for (int i = 0; i < MF; ++i) ap[i] = A + (size_t)rowmap(lrow + 64 * i) * lda + kc * 8;
#pragma unroll
    for (int i = 0; i < 2; ++i) bp[i] = Bt + (size_t)(lrow + 64 * i) * ldb + kc * 8;
    u32x4 ra[MF], rb[2];
#pragma unroll
    for (int i = 0; i < MF; ++i) ra[i] = *(const u32x4*)(ap[i]);
#pragma unroll
    for (int i = 0; i < 2; ++i) rb[i] = *(const u32x4*)(bp[i]);
    const int nk = K >> 6;
    for (int kt = 0; kt < nk; ++kt) {
        __syncthreads();
#pragma unroll
        for (int i = 0; i < MF; ++i) *(u32x4*)(sA + (lrow + 64 * i) * GLD + kc * 8) = ra[i];
#pragma unroll
        for (int i = 0; i < 2; ++i) *(u32x4*)(sB + (lrow + 64 * i) * GLD + kc * 8) = rb[i];
        __syncthreads();
        if (kt + 1 < nk) {
#pragma unroll
            for (int i = 0; i < MF; ++i) ra[i] = *(const u32x4*)(ap[i] + (kt + 1) * 64);
#pragma unroll
            for (int i = 0; i < 2; ++i) rb[i] = *(const u32x4*)(bp[i] + (kt + 1) * 64);
        }
#pragma unroll
        for (int kk = 0; kk < 2; ++kk) {
            bf16x8 af[MF], bfr[4];
#pragma unroll
            for (int m = 0; m < MF; ++m) af[m] = *(const bf16x8*)(sA + (wr * (MF * 16) + m * 16 + fr) * GLD + kk * 32 + fq * 8);
#pragma unroll
            for (int n = 0; n < 4; ++n) bfr[n] = *(const bf16x8*)(sB + (wc * 64 + n * 16 + fr) * GLD + kk * 32 + fq * 8);
#pragma unroll
            for (int m = 0; m < MF; ++m)
#pragma unroll
                for (int n = 0; n < 4; ++n) acc[m][n] = __builtin_amdgcn_mfma_f32_16x16x32_bf16(bfr[n], af[m], acc[m][n], 0, 0, 0);
        }
    }
}
template <int MF> DEVI void acc_zero(f32x4 (&acc)[MF][4]) {
#pragma unroll
    for (int m = 0; m < MF; ++m)
#pragma unroll
        for (int n = 0; n < 4; ++n) acc[m][n] = (f32x4){0.f, 0.f, 0.f, 0.f};
}
template <int MF, class F> DEVI void epi1(const f32x4 (&acc)[MF][4], F f) {
    const int lane = threadIdx.x & 63, wid = threadIdx.x >> 6, wr = wid >> 1, wc = wid & 1, fr = lane & 15, fq = lane >> 4;
#pragma unroll
    for (int m = 0; m < MF; ++m)
#pragma unroll
        for (int n = 0; n < 4; ++n) f(wr * (MF * 16) + m * 16 + fr, wc * 64 + n * 16 + fq * 4, acc[m][n]);
}
template <int MF, class F> DEVI void epi2(const f32x4 (&a1)[MF][4], const f32x4 (&a2)[MF][4], F f) {
    const int lane = threadIdx.x & 63, wid = threadIdx.x >> 6, wr = wid >> 1, wc = wid & 1, fr = lane & 15, fq = lane >> 4;
#pragma unroll
    for (int m = 0; m < MF; ++m)
#pragma unroll
        for (int n = 0; n < 4; ++n) f(wr * (MF * 16) + m * 16 + fr, wc * 64 + n * 16 + fq * 4, a1[m][n], a2[m][n]);
}

DEVI void phase_prep(const Params& p, unsigned char* smem) {
    float* sm = (float*)smem;
    bf16_t* xb = (bf16_t*)(p.ws + WS_XB); bf16_t* pb = (bf16_t*)(p.ws + WS_PB);
    constexpr int T_X = 4096, T_P = 1024, T_WIN = 16 * 92, T_WA = 8 * 16, T_WB = 8 * 16, T_WO = 16 * 16, T_WPE = 4 * 16, T_WPG = 16 * 16;
    constexpr int TOTAL = T_X + T_P + T_WIN + T_WA + T_WB + T_WO + T_WPE + T_WPG;
    for (int t = blockIdx.x; t < TOTAL; t += gridDim.x) {
        int u = t;
        if (u < T_X) { cvt_tile(p.in[0], xb, u); continue; } u -= T_X;
        if (u < T_P) { cvt_tile(p.in[1], pb, u); continue; } u -= T_P;
        if (u < T_WIN) { transpose_tile(p.in[2], (bf16_t*)(p.ws + WS_WINT), 1024, NIN, u / 92, u % 92, sm); continue; } u -= T_WIN;
        if (u < T_WA) { transpose_tile(p.in[14], (bf16_t*)(p.ws + WS_WAT), 512, 1024, u / 16, u % 16, sm); continue; } u -= T_WA;
        if (u < T_WB) { transpose_tile(p.in[17], (bf16_t*)(p.ws + WS_WBT), 512, 1024, u / 16, u % 16, sm); continue; } u -= T_WB;
        if (u < T_WO) { transpose_tile(p.in[18], (bf16_t*)(p.ws + WS_WOT), 1024, 1024, u / 16, u % 16, sm); continue; } u -= T_WO;
        if (u < T_WPE) { transpose_tile(p.in[30], (bf16_t*)(p.ws + WS_WPET), 256, 1024, u / 16, u % 16, sm); continue; } u -= T_WPE;
        transpose_tile(p.in[31], (bf16_t*)(p.ws + WS_WPGT), 1024, 1024, u / 16, u % 16, sm);
    }
    if (blockIdx.x == 0 && threadIdx.x < 32) ((int*)(p.ws + WS_CNT))[threadIdx.x] = 0;
}

DEVI void phase_inproj(const Params& p, unsigned char* smem) {
    const bf16_t* xb = (const bf16_t*)(p.ws + WS_XB); const bf16_t* WinT = (const bf16_t*)(p.ws + WS_WINT);
    for (int t = blockIdx.x; t < 64 * 46; t += gridDim.x) {
        const int tm = t / 46, tn = t % 46;
        f32x4 acc[4][4]; acc_zero(acc);
        gemm_accum(acc, xb, 1024, IdRows{tm * 256}, WinT + (size_t)tn * 128 * 1024, 1024, 1024, (bf16_t*)smem);
        bf16_t* dst; int ld;
        if (tn < 14) { dst = (bf16_t*)(p.ws + WS_PRW) + tn * 128; ld = NRW; }
        else if (tn < 30) { dst = (bf16_t*)(p.ws + WS_PHG) + (tn - 14) * 128; ld = NHG; }
        else { dst = (bf16_t*)(p.ws + WS_PGT) + (tn - 30) * 128; ld = NHG; }
        epi1(acc, [&](int r, int c, f32x4 v) { st_bf4(dst + (size_t)(tm * 256 + r) * ld + c, v); });
    }
}

DEVI bf16_t* prep_arr(const Params& p, int i) { return i < 4 ? (bf16_t*)(p.ws + WS_PREP + (size_t)i * 16 * MiB) : (bf16_t*)((unsigned char*)p.out + (size_t)(i - 4) * 16 * MiB); }
DEVI void phase_rwkv_prep(const Params& p, unsigned char* smem) {
    float* lin = (float*)smem;
    const bf16_t* proj = (const bf16_t*)(p.ws + WS_PRW);
    const float* mu = p.in[3]; const float* w_up = p.in[5]; const float* a_up = p.in[7]; const float* g_up = p.in[8];
    const int tid = threadIdx.x, c = tid;
    const float mu_r = mu[c], mu_k = mu[C_K + c], mu_v = mu[C_V + c];
    const float w0 = p.in[4][c], a0 = p.in[6][c], kkc = p.in[9][c], kac = p.in[10][c];
    bf16_t* oR = prep_arr(p, 0); bf16_t* oK = prep_arr(p, 1); bf16_t* oV = prep_arr(p, 2); bf16_t* oW = prep_arr(p, 3);
    bf16_t* oKK = prep_arr(p, 4); bf16_t* oA = prep_arr(p, 5); bf16_t* oG = prep_arr(p, 6);
    for (int grp = blockIdx.x; grp < NTOK / 16; grp += gridDim.x) {
        const int t0 = grp * 16;
        __syncthreads();
#pragma unroll
        for (int i = 0; i < 8; ++i) {
            const int idx = tid + 512 * i, tt = idx >> 8, l = idx & 255, t = t0 + tt, col = C_WD + l;
            const float cur = bf2f(proj[(size_t)t * NRW + col]);
            const float prev = (t % SEQ == 0) ? 0.f : bf2f(proj[(size_t)(t - 1) * NRW + col]);
            const float u = cur + (prev - cur) * mu[col];
            lin[tt * 256 + l] = l < 64 ? tanhf(u) : (l < 128 ? u : sigm(u));
        }
        __syncthreads();
        float aw[16], aa[16], ag[16];
#pragma unroll
        for (int tt = 0; tt < 16; ++tt) { aw[tt] = 0.f; aa[tt] = 0.f; ag[tt] = 0.f; }
        for (int l = 0; l < 64; ++l) {
            const float w = w_up[l * 512 + c], a = a_up[l * 512 + c];
#pragma unroll
            for (int tt = 0; tt < 16; ++tt) { aw[tt] += lin[tt * 256 + l] * w; aa[tt] += lin[tt * 256 + 64 + l] * a; }
        }
        for (int l = 0; l < 128; ++l) {
            const float g = g_up[l * 512 + c];
#pragma unroll
            for (int tt = 0; tt < 16; ++tt) ag[tt] += lin[tt * 256 + 128 + l] * g;
        }
#pragma unroll
        for (int tt = 0; tt < 16; ++tt) {
            const int t = t0 + tt; const bool first = (t % SEQ == 0);
            const bf16_t* row = proj + (size_t)t * NRW; const bf16_t* prow = row - NRW;
            float r = bf2f(row[c]), k = bf2f(row[C_K + c]), v = bf2f(row[C_V + c]);
            const float pr = first ? 0.f : bf2f(prow[c]), pk = first ? 0.f : bf2f(prow[C_K + c]), pv = first ? 0.f : bf2f(prow[C_V + c]);
            r += (pr - r) * mu_r; k += (pk - k) * mu_k; v += (pv - v) * mu_v;
            const float z = -(w0 + aw[tt]);
            const float sp = z > 20.f ? z : log1pf(__expf(z));
            const float wl = -sp - 0.5f;
            const float logw = -__expf(wl);
            const float a = sigm(a0 + aa[tt]);
            const float kkv = k * kkc;
            const float ss = wave_sum(kkv * kkv);
            const float kkn = kkv / fmaxf(sqrtf(ss), 1e-12f);
            const float kp = k * (1.f + (a - 1.f) * kac);
            const size_t o = (size_t)t * 512 + c;
            oR[o] = f2bf(r); oK[o] = f2bf(kp); oV[o] = f2bf(v); oW[o] = f2bf(logw); oKK[o] = f2bf(kkn); oA[o] = f2bf(a); oG[o] = f2bf(ag[tt]);
        }
    }
}

DEVI void scan_rwkv_naive(const Params& p, unsigned char* smem, int blk) {
    const int tid = threadIdx.x, lane = tid & 63, wid = tid >> 6;
    const int unit = blk * 8 + wid, b = unit >> 3, h = unit & 7, c = h * 64 + lane;
    float* sw = (float*)smem + wid * (4 * 7 * 64);
    float* srk = (float*)smem + 8 * (4 * 7 * 64) + wid * 64;
    const bf16_t* iR = prep_arr(p, 0); const bf16_t* iK = prep_arr(p, 1); const bf16_t* iV = prep_arr(p, 2); const bf16_t* iW = prep_arr(p, 3);
    const bf16_t* iKK = prep_arr(p, 4); const bf16_t* iA = prep_arr(p, 5); const bf16_t* iG = prep_arr(p, 6);
    bf16_t* ya = (bf16_t*)(p.ws + WS_YA);
    srk[lane] = p.in[11][c];
    const float gnw = p.in[12][c], gnb = p.in[13][c];
    float S[64];
#pragma unroll
    for (int j = 0; j < 64; ++j) S[j] = 0.f;
    for (int t0 = 0; t0 < SEQ; t0 += 4) {
        __syncthreads();
#pragma unroll
        for (int s = 0; s < 4; ++s) {
            const size_t o = (size_t)(b * SEQ + t0 + s) * 512 + c;
            const float r = bf2f(iR[o]), k = bf2f(iK[o]), w = __expf(bf2f(iW[o])), kk = bf2f(iKK[o]), a = bf2f(iA[o]);
            float* d = sw + s * 7 * 64 + lane;
            d[0] = r; d[64] = k; d[128] = w; d[192] = -kk; d[256] = kk * a; d[320] = bf2f(iV[o]); d[384] = bf2f(iG[o]);
        }
        __syncthreads();
#pragma unroll 1
        for (int s = 0; s < 4; ++s) {
            const f32x4* vr = (const f32x4*)(sw + s * 7 * 64);
            const f32x4* vk = vr + 16; const f32x4* vw = vr + 32; const f32x4* va = vr + 48; const f32x4* vb = vr + 64;
            const float v = sw[s * 7 * 64 + 320 + lane], g = sw[s * 7 * 64 + 384 + lane];
            float sa = 0.f;
#pragma unroll
            for (int j4 = 0; j4 < 16; ++j4) { const f32x4 a4 = va[j4];
#pragma unroll
                for (int q = 0; q < 4; ++q) sa += S[j4 * 4 + q] * a4[q]; }
            float y = 0.f, bon = 0.f;
#pragma unroll
            for (int j4 = 0; j4 < 16; ++j4) {
                const f32x4 w4 = vw[j4], b4 = vb[j4], k4 = vk[j4], r4 = vr[j4], rk4 = ((const f32x4*)srk)[j4];
#pragma unroll
                for (int q = 0; q < 4; ++q) {
                    const float sn = S[j4 * 4 + q] * w4[q] + sa * b4[q] + v * k4[q];
                    S[j4 * 4 + q] = sn; y += sn * r4[q]; bon += r4[q] * k4[q] * rk4[q];
                }
            }
            const float mean = wave_sum(y) * (1.f / 64.f);
            const float d = y - mean;
            const float var = wave_sum(d * d) * (1.f / 64.f);
            const float outv = (d * rsqrtf(var + GN_EPS) * gnw + gnb + bon * v) * g;
            ya[(size_t)(b * SEQ + t0 + s) * 512 + c] = f2bf(outv);
        }
    }
}
DEVI void scan_hgrn_naive(const Params& p, unsigned char* smem, int blk) {
    const int tid = threadIdx.x, lane = tid & 63, ul = tid >> 7, v = tid & 127, wiu = (tid >> 6) & 1;
    const int unit = blk * 4 + ul, b = unit >> 2, h = unit & 3, c = h * 128 + v;
    float* su = (float*)smem + ul * (4 * 5 * 128);
    float* spart = (float*)smem + 4 * (4 * 5 * 128) + ul * 8;
    const bf16_t* proj = (const bf16_t*)(p.ws + WS_PHG);
    bf16_t* yb = (bf16_t*)(p.ws + WS_YB);
    const float l0 = p.in[15][c], l1 = p.in[15][512 + c];
    const float lb = 1.f / (1.f + __expf(l1 - l0));
    const float nw = p.in[16][c];
    float S[128];
#pragma unroll
    for (int e = 0; e < 128; ++e) S[e] = 0.f;
    for (int t0 = 0; t0 < SEQ; t0 += 4) {
        __syncthreads();
#pragma unroll
        for (int s = 0; s < 4; ++s) {
            const bf16_t* row = proj + (size_t)(b * SEQ + t0 + s) * NHG;
            const float z = bf2f(row[H_F + c]), qr = bf2f(row[H_Q + c]);
            const float sg = sigm(z);
            float* d = su + s * 5 * 128 + v;
            d[0] = lb + (1.f - lb) * sg; d[128] = (1.f - lb) * (1.f - sg); d[256] = qr * sigm(qr); d[384] = bf2f(row[H_I + c]); d[512] = bf2f(row[H_OG + c]);
        }
        __syncthreads();
        float os[4];
#pragma unroll
        for (int s = 0; s < 4; ++s) {
            const f32x4* vf = (const f32x4*)(su + s * 5 * 128); const f32x4* vk = vf + 32; const f32x4* vq = vf + 64;
            const float vin = su[s * 5 * 128 + 384 + v];
            float o = 0.f;
#pragma unroll
            for (int e4 = 0; e4 < 32; ++e4) {
                const f32x4 f4 = vf[e4], k4 = vk[e4], q4 = vq[e4];
#pragma unroll
                for (int q = 0; q < 4; ++q) { const float sn = f4[q] * S[e4 * 4 + q] + k4[q] * vin; S[e4 * 4 + q] = sn; o += q4[q] * sn; }
            }
            os[s] = o;
            const float ss = wave_sum(o * o);
            if (lane == 0) spart[s * 2 + wiu] = ss;
        }
        __syncthreads();
#pragma unroll
        for (int s = 0; s < 4; ++s) {
            const float tot = spart[s * 2] + spart[s * 2 + 1];
            const float og = su[s * 5 * 128 + 512 + v];
            yb[(size_t)(b * SEQ + t0 + s) * 512 + c] = f2bf(os[s] * rsqrtf(tot * (1.f / 128.f) + RMS_EPS) * nw * sigm(og));
        }
    }
}

template <int MT, int NTL, int KS>
DEVI void mma_lds(f32x4 (&acc)[MT][NTL], const bf16_t* sA, int lda, const bf16_t* sB, int ldb) {
    const int lane = threadIdx.x & 63, fr = lane & 15, fq = lane >> 4;
#pragma unroll
    for (int ks = 0; ks < KS; ++ks) {
        bf16x8 af[MT], bfr[NTL];
#pragma unroll
        for (int m = 0; m < MT; ++m) af[m] = *(const bf16x8*)(sA + (m * 16 + fr) * lda + ks * 32 + fq * 8);
#pragma unroll
        for (int n = 0; n < NTL; ++n) bfr[n] = *(const bf16x8*)(sB + (n * 16 + fr) * ldb + ks * 32 + fq * 8);
#pragma unroll
        for (int m = 0; m < MT; ++m)
#pragma unroll
            for (int n = 0; n < NTL; ++n) acc[m][n] = __builtin_amdgcn_mfma_f32_16x16x32_bf16(bfr[n], af[m], acc[m][n], 0, 0, 0);
    }
}
template <int MT, int NTL> DEVI void accz(f32x4 (&acc)[MT][NTL]) {
#pragma unroll
    for (int m = 0; m < MT; ++m)
#pragma unroll
        for (int n = 0; n < NTL; ++n) acc[m][n] = (f32x4){0.f, 0.f, 0.f, 0.f};
}

DEVI bf16_t* kv_ptr(const Params& p, int unit) {
    return unit < 768 ? (bf16_t*)(p.ws + WS_PRW + 32 * MiB) + (size_t)unit * 16384 : (bf16_t*)((unsigned char*)p.out + 48 * MiB) + (size_t)(unit - 768) * 16384;
}
DEVI void hgrn_h1(const Params& p, unsigned char* smem, int unit) {
    const int tid = threadIdx.x, wid = tid >> 6, lane = tid & 63, fr = lane & 15, fq = lane >> 4;
    const int c = unit & 63, bh = unit >> 6, h = bh & 3, b = bh >> 2, t0 = b * SEQ + c * 64;
    bf16_t* phg = (bf16_t*)(p.ws + WS_PHG);
    bf16_t* sZ = (bf16_t*)smem; bf16_t* sQ = sZ + 64 * 136; bf16_t* sKtT = sQ + 64 * 136; bf16_t* sVT = sKtT + 128 * 72; float* sG = (float*)(sVT + 128 * 72);
    __syncthreads();
#pragma unroll
    for (int i = 0; i < 2; ++i) {
        const int idx = tid + 512 * i, t = idx >> 4, ch = idx & 15;
        const bf16_t* row = phg + (size_t)(t0 + t) * NHG + h * 128 + ch * 8;
        *(u32x4*)(sZ + t * 136 + ch * 8) = *(const u32x4*)(row + H_F);
        *(u32x4*)(sQ + t * 136 + ch * 8) = *(const u32x4*)(row + H_Q);
        const u32x4 vv = *(const u32x4*)(row + H_I);
#pragma unroll
        for (int k = 0; k < 4; ++k) { sVT[(ch * 8 + 2 * k) * 72 + t] = (bf16_t)(vv[k] & 0xffffu); sVT[(ch * 8 + 2 * k + 1) * 72 + t] = (bf16_t)(vv[k] >> 16); }
    }
    __syncthreads();
    if (tid < 128) {
        const int e = tid, col = h * 128 + e;
        const float l0 = p.in[15][col], l1 = p.in[15][512 + col];
        const float lb = 1.f / (1.f + __expf(l1 - l0));
        float bsum = 0.f;
        for (int t = 0; t < 64; ++t) {
            const float z = bf2f(sZ[t * 136 + e]), qr = bf2f(sQ[t * 136 + e]);
            const float sg = sigm(z), f = lb + (1.f - lb) * sg, k = (1.f - lb) * (1.f - sg);
            bsum += __logf(f);
            const bf16_t kt = f2bf(k * __expf(-bsum)), qt = f2bf(qr * sigm(qr) * __expf(bsum));
            sKtT[e * 72 + t] = kt;
            bf16_t* row = phg + (size_t)(t0 + t) * NHG + col;
            row[H_F] = kt; row[H_Q] = qt;
        }
        const float G = __expf(bsum);
        sG[e] = G; ((float*)(p.ws + WS_GBUF))[(size_t)unit * 128 + e] = G;
    }
    __syncthreads();
    f32x4 acc[1][8]; accz(acc);
    mma_lds<1, 8, 2>(acc, sVT + wid * 16 * 72, 72, sKtT, 72);
    bf16_t* kv = kv_ptr(p, unit);
#pragma unroll
    for (int n = 0; n < 8; ++n) {
        const f32x4 g4 = *(const f32x4*)(sG + n * 16 + fq * 4);
        st_bf4(kv + (size_t)(wid * 16 + fr) * 128 + n * 16 + fq * 4, acc[0][n] * g4);
    }
}
DEVI void hgrn_h2(const Params& p, int item) {
    const int bh = item >> 11, rem = item & 2047, off = (rem >> 4) * 128 + (rem & 15) * 8;
    const float* gbuf = (const float*)(p.ws + WS_GBUF);
    float S[8];
#pragma unroll
    for (int k = 0; k < 8; ++k) S[k] = 0.f;
    for (int c0 = 0; c0 < 64; c0 += 4) {
        u32x4 kv[4]; f32x4 g0[4], g1[4];
#pragma unroll
        for (int i = 0; i < 4; ++i) {
            const int unit = bh * 64 + c0 + i;
            kv[i] = *(const u32x4*)(kv_ptr(p, unit) + off);
            g0[i] = *(const f32x4*)(gbuf + (size_t)unit * 128 + (rem & 15) * 8); g1[i] = *(const f32x4*)(gbuf + (size_t)unit * 128 + (rem & 15) * 8 + 4);
        }
#pragma unroll
        for (int i = 0; i < 4; ++i) {
            u32x4 o;
#pragma unroll
            for (int k = 0; k < 4; ++k) {
                const float ga = k < 2 ? g0[i][2 * k] : g1[i][2 * k - 4], gb = k < 2 ? g0[i][2 * k + 1] : g1[i][2 * k - 3];
                S[2 * k] = ga * S[2 * k] + __uint_as_float(kv[i][k] << 16);
                S[2 * k + 1] = gb * S[2 * k + 1] + __uint_as_float(kv[i][k] & 0xffff0000u);
                o[k] = pack2(S[2 * k], S[2 * k + 1]);
            }
            *(u32x4*)(kv_ptr(p, bh * 64 + c0 + i) + off) = o;
        }
    }
}
DEVI void hgrn_h3(const Params& p, unsigned char* smem, int unit) {
    const int tid = threadIdx.x, wid = tid >> 6, lane = tid & 63, fr = lane & 15, fq = lane >> 4;
    const int c = unit & 63, bh = unit >> 6, h = bh & 3, b = bh >> 2, t0 = b * SEQ + c * 64;
    bf16_t* phg = (bf16_t*)(p.ws + WS_PHG);
    bf16_t* sQt = (bf16_t*)smem; bf16_t* sKt = sQt + 64 * 136; bf16_t* sVT = sKt + 64 * 136; bf16_t* sS0 = sVT + 128 * 72; bf16_t* sAtt = sS0 + 128 * 136;
    float* sO = (float*)sS0;
    __syncthreads();
#pragma unroll
    for (int i = 0; i < 2; ++i) {
        const int idx = tid + 512 * i, t = idx >> 4, ch = idx & 15;
        const bf16_t* row = phg + (size_t)(t0 + t) * NHG + h * 128 + ch * 8;
        *(u32x4*)(sKt + t * 136 + ch * 8) = *(const u32x4*)(row + H_F);
        *(u32x4*)(sQt + t * 136 + ch * 8) = *(const u32x4*)(row + H_Q);
        const u32x4 vv = *(const u32x4*)(row + H_I);
#pragma unroll
        for (int k = 0; k < 4; ++k) { sVT[(ch * 8 + 2 * k) * 72 + t] = (bf16_t)(vv[k] & 0xffffu); sVT[(ch * 8 + 2 * k + 1) * 72 + t] = (bf16_t)(vv[k] >> 16); }
    }
    {
        const bf16_t* s0 = c > 0 ? kv_ptr(p, unit - 1) : nullptr;
#pragma unroll
        for (int i = 0; i < 4; ++i) {
            const int idx = tid + 512 * i, v = idx >> 4, ch = idx & 15;
            u32x4 x = (u32x4){0u, 0u, 0u, 0u};
            if (c > 0) x = *(const u32x4*)(s0 + v * 128 + ch * 8);
            *(u32x4*)(sS0 + v * 136 + ch * 8) = x;
        }
    }
    __syncthreads();
    const int rb = wid >> 1, ch2 = wid & 1, t = rb * 16 + fr;
    {
        f32x4 at[1][2]; accz(at);
        mma_lds<1, 2, 4>(at, sQt + rb * 16 * 136, 136, sKt + ch2 * 32 * 136, 136);
#pragma unroll
        for (int n = 0; n < 2; ++n) {
            const int s0i = ch2 * 32 + n * 16 + fq * 4;
            f32x4 m;
#pragma unroll
            for (int x = 0; x < 4; ++x) m[x] = (s0i + x <= t) ? at[0][n][x] : 0.f;
            st_bf4(sAtt + t * 72 + s0i, m);
        }
    }
    f32x4 ao[1][4]; accz(ao);
    mma_lds<1, 4, 4>(ao, sQt + rb * 16 * 136, 136, sS0 + ch2 * 64 * 136, 136);
    __syncthreads();
    mma_lds<1, 4, 2>(ao, sAtt + rb * 16 * 72, 72, sVT + ch2 * 64 * 72, 72);
#pragma unroll
    for (int n = 0; n < 4; ++n) *(f32x4*)(sO + t * 132 + ch2 * 64 + n * 16 + fq * 4) = ao[0][n];
    __syncthreads();
    {
        const int te = tid >> 3, v0 = (tid & 7) * 16;
        f32x4 o[4]; float ss = 0.f;
#pragma unroll
        for (int k = 0; k < 4; ++k) { o[k] = *(const f32x4*)(sO + te * 132 + v0 + k * 4); ss += o[k][0] * o[k][0] + o[k][1] * o[k][1] + o[k][2] * o[k][2] + o[k][3] * o[k][3]; }
        ss += __shfl_xor(ss, 1, 64); ss += __shfl_xor(ss, 2, 64); ss += __shfl_xor(ss, 4, 64);
        const float rstd = rsqrtf(ss * (1.f / 128.f) + RMS_EPS);
        bf16_t* row = phg + (size_t)(t0 + te) * NHG + h * 128 + v0;
        const float* nw = p.in[16] + h * 128 + v0;
#pragma unroll
        for (int k = 0; k < 4; ++k) {
            const f32x4 og = ld_bf4(row + H_OG + k * 4), w4 = *(const f32x4*)(nw + k * 4);
            f32x4 r;
#pragma unroll
            for (int x = 0; x < 4; ++x) r[x] = o[k][x] * rstd * w4[x] * sigm(og[x]);
            st_bf4(row + H_I + k * 4, r);
        }
    }
}


DEVI void rwkv_r1(const Params& p, unsigned char* smem, int unit) {
    const int tid = threadIdx.x, wid = tid >> 6, lane = tid & 63, fr = lane & 15, fq = lane >> 4;
    const int c = unit & 63, bh = unit >> 6, h = bh & 7, b = bh >> 3, t0 = b * SEQ + c * 64, cb = h * 64;
    bf16_t* aR = prep_arr(p, 0); bf16_t* aK = prep_arr(p, 1); bf16_t* aV = prep_arr(p, 2); bf16_t* aW = prep_arr(p, 3);
    bf16_t* aKK = prep_arr(p, 4); bf16_t* aA = prep_arr(p, 5);
    float* sAab = (float*)smem; float* sP = sAab + 64 * 64; float* sWC = sP + 64 * 64;
    bf16_t* sAt = (bf16_t*)(sWC + 64); bf16_t* sBt = sAt + 64 * 72; bf16_t* sKt = sBt + 64 * 72; bf16_t* sBtT = sKt + 64 * 72; bf16_t* sKtT = sBtT + 64 * 72;
    bf16_t* sVT = sKtT + 64 * 72; bf16_t* sAak = sVT + 64 * 72;
    bf16_t* sLW = (bf16_t*)sAab; bf16_t* sR = (bf16_t*)sP;
    bf16_t* sX1T = sAt; bf16_t* sUT = sAak;
    __syncthreads();
    {
        const int t = tid >> 3, ch = tid & 7; const size_t o = (size_t)(t0 + t) * 512 + cb + ch * 8; const int lo = t * 72 + ch * 8;
        *(u32x4*)(sAt + lo) = *(const u32x4*)(aKK + o);
        *(u32x4*)(sBt + lo) = *(const u32x4*)(aA + o);
        *(u32x4*)(sKt + lo) = *(const u32x4*)(aK + o);
        *(u32x4*)(sLW + lo) = *(const u32x4*)(aW + o);
        *(u32x4*)(sR + lo) = *(const u32x4*)(aR + o);
        const u32x4 vv = *(const u32x4*)(aV + o);
#pragma unroll
        for (int k = 0; k < 4; ++k) { sVT[(ch * 8 + 2 * k) * 72 + t] = (bf16_t)(vv[k] & 0xffffu); sVT[(ch * 8 + 2 * k + 1) * 72 + t] = (bf16_t)(vv[k] >> 16); }
    }
    __syncthreads();
    if (tid < 64) {
        const int j = tid; float L = 0.f;
        for (int t = 0; t < 64; ++t) {
            const float lw = bf2f(sLW[t * 72 + j]), kkv = bf2f(sAt[t * 72 + j]), av = bf2f(sBt[t * 72 + j]), kp = bf2f(sKt[t * 72 + j]), rv = bf2f(sR[t * 72 + j]);
            const float eprev = __expf(L);
            L += lw;
            const float ecur = __expf(L), einv = __expf(-L);
            const bf16_t at = f2bf(-kkv * eprev), bt = f2bf(kkv * av * einv), kt = f2bf(kp * einv), rt = f2bf(rv * ecur);
            sAt[t * 72 + j] = at; sBt[t * 72 + j] = bt; sKt[t * 72 + j] = kt; sBtT[j * 72 + t] = bt; sKtT[j * 72 + t] = kt;
            const size_t o = (size_t)(t0 + t) * 512 + cb + j;
            aR[o] = rt; aK[o] = kt; aKK[o] = bt;
        }
        sWC[j] = __expf(L);
    }
    __syncthreads();
    const int rb = wid >> 1, ch2 = wid & 1, tr = rb * 16 + fr;
    {
        f32x4 ab[1][2], ak[1][2]; accz(ab); accz(ak);
        mma_lds<1, 2, 2>(ab, sAt + rb * 16 * 72, 72, sBt + ch2 * 32 * 72, 72);
        mma_lds<1, 2, 2>(ak, sAt + rb * 16 * 72, 72, sKt + ch2 * 32 * 72, 72);
#pragma unroll
        for (int n = 0; n < 2; ++n) {
            const int s0 = ch2 * 32 + n * 16 + fq * 4;
            f32x4 m1, m2;
#pragma unroll
            for (int x = 0; x < 4; ++x) { const bool keep = (s0 + x) < tr; m1[x] = keep ? ab[0][n][x] : 0.f; m2[x] = keep ? ak[0][n][x] : 0.f; }
            *(f32x4*)(sAab + tr * 64 + s0) = m1;
            st_bf4(sAak + tr * 72 + s0, m2);
        }
    }
    __syncthreads();
    {
        f32x4 pp[1][2]; accz(pp);
        mma_lds<1, 2, 2>(pp, sAak + rb * 16 * 72, 72, sVT + ch2 * 32 * 72, 72);
#pragma unroll
        for (int n = 0; n < 2; ++n) *(f32x4*)(sP + tr * 64 + ch2 * 32 + n * 16 + fq * 4) = pp[0][n];
    }
    __syncthreads();
    f32x2 x2[32];
    if (tid < 128) {
        if (tid < 64) {
#pragma unroll
            for (int t = 0; t < 64; ++t) x2[t >> 1][t & 1] = bf2f(sAt[t * 72 + tid]);
        } else {
#pragma unroll
            for (int t = 0; t < 64; ++t) x2[t >> 1][t & 1] = sP[t * 64 + tid - 64];
        }
    }
    __syncthreads();
    if (tid < 128) {
#pragma unroll
        for (int t = 1; t < 64; ++t) {
            if (t >= 4) asm volatile("" : "+v"(x2[(t - 4) >> 1]) :: "memory"); else asm volatile("" ::: "memory");
            const f32x4* arow = (const f32x4*)(sAab + t * 64);
            f32x2 a0 = (f32x2){0.f, 0.f}, a1 = (f32x2){0.f, 0.f};
#pragma unroll
            for (int s4 = 0; s4 < (t + 3) / 4; ++s4) {
                const f32x4 a4 = arow[s4];
                a0 += (f32x2){a4[0], a4[1]} * x2[2 * s4];
                a1 += (f32x2){a4[2], a4[3]} * x2[2 * s4 + 1];
            }
            const f32x2 sm = a0 + a1;
            x2[t >> 1][t & 1] += sm[0] + sm[1];
        }
        const int col = tid & 63;
        bf16_t* srow = (tid < 64 ? sX1T : sUT) + col * 72;
        bf16_t* gdst = (tid < 64 ? aA : aW) + (size_t)t0 * 512 + cb + col;
#pragma unroll
        for (int t = 0; t < 64; t += 2) {
            const unsigned pk = pack2(x2[t >> 1][0], x2[t >> 1][1]);
            *(unsigned*)(srow + t) = pk;
            gdst[(size_t)t * 512] = (bf16_t)(pk & 0xffffu); gdst[(size_t)(t + 1) * 512] = (bf16_t)(pk >> 16);
        }
    }
    __syncthreads();
    {
        float* Mg = (float*)(p.ws + WS_PRW) + (size_t)unit * 4096; float* Ng = (float*)(p.ws + WS_XB) + (size_t)unit * 4096;
        f32x4 am[1][2]; accz(am);
        mma_lds<1, 2, 2>(am, sBtT + rb * 16 * 72, 72, sX1T + ch2 * 32 * 72, 72);
        const float wcj = sWC[tr];
#pragma unroll
        for (int n = 0; n < 2; ++n) {
            const int j0 = ch2 * 32 + n * 16 + fq * 4;
            f32x4 o;
#pragma unroll
            for (int xx = 0; xx < 4; ++xx) o[xx] = (am[0][n][xx] + ((j0 + xx) == tr ? 1.f : 0.f)) * wcj;
            *(f32x4*)(Mg + tr * 64 + j0) = o;
        }
        f32x4 an[1][2]; accz(an);
        mma_lds<1, 2, 2>(an, sUT + rb * 16 * 72, 72, sBtT + ch2 * 32 * 72, 72);
        mma_lds<1, 2, 2>(an, sVT + rb * 16 * 72, 72, sKtT + ch2 * 32 * 72, 72);
#pragma unroll
        for (int n = 0; n < 2; ++n) {
            const int j0 = ch2 * 32 + n * 16 + fq * 4;
            const f32x4 w4 = *(const f32x4*)(sWC + j0);
            *(f32x4*)(Ng + tr * 64 + j0) = an[0][n] * w4;
        }
    }
}
DEVI void rwkv_r2(const Params& p, int bh, int ib) {
    const int lane = threadIdx.x & 63, q = lane >> 4, cl = lane & 15;
    const float* Mb = (const float*)(p.ws + WS_PRW) + (size_t)bh * 64 * 4096; float* Nb = (float*)(p.ws + WS_XB) + (size_t)bh * 64 * 4096;
    f32x4 z[4];
#pragma unroll
    for (int kb = 0; kb < 4; ++kb) z[kb] = (f32x4){0.f, 0.f, 0.f, 0.f};
    f32x4 mr[4][4], nr[4];
#pragma unroll
    for (int jb = 0; jb < 4; ++jb) {
#pragma unroll
        for (int kb = 0; kb < 4; ++kb) mr[jb][kb] = *(const f32x4*)(Mb + (jb * 16 + cl) * 64 + kb * 16 + 4 * q);
        nr[jb] = *(const f32x4*)(Nb + (ib * 16 + cl) * 64 + jb * 16 + 4 * q);
    }
    for (int c = 0; c < 64; ++c) {
        f32x4 mn[4][4], nn[4];
        const int cn = c < 63 ? c + 1 : 63;
        const float* Mu = Mb + (size_t)cn * 4096; const float* Nu = Nb + (size_t)cn * 4096;
#pragma unroll
        for (int jb = 0; jb < 4; ++jb) {
#pragma unroll
            for (int kb = 0; kb < 4; ++kb) mn[jb][kb] = *(const f32x4*)(Mu + (jb * 16 + cl) * 64 + kb * 16 + 4 * q);
            nn[jb] = *(const f32x4*)(Nu + (ib * 16 + cl) * 64 + jb * 16 + 4 * q);
        }
        f32x4 acc[4];
#pragma unroll
        for (int jb = 0; jb < 4; ++jb) {
            acc[jb] = nr[jb];
#pragma unroll
            for (int kb = 0; kb < 4; ++kb)
#pragma unroll
                for (int ks = 0; ks < 4; ++ks) acc[jb] = __builtin_amdgcn_mfma_f32_16x16x4f32(mr[jb][kb][ks], z[kb][ks], acc[jb], 0, 0, 0);
        }
        float* Zo = Nb + (size_t)c * 4096;
#pragma unroll
        for (int jb = 0; jb < 4; ++jb) { z[jb] = acc[jb]; *(f32x4*)(Zo + (ib * 16 + cl) * 64 + jb * 16 + 4 * q) = acc[jb]; }
#pragma unroll
        for (int jb = 0; jb < 4; ++jb) {
#pragma unroll
            for (int kb = 0; kb < 4; ++kb) mr[jb][kb] = mn[jb][kb];
            nr[jb] = nn[jb];
        }
    }
}
DEVI void rwkv_r3(const Params& p, unsigned char* smem, int unit) {
    const int tid = threadIdx.x, wid = tid >> 6, lane = tid & 63, fr = lane & 15, fq = lane >> 4;
    const int c = unit & 63, bh = unit >> 6, h = bh & 7, b = bh >> 3, t0 = b * SEQ + c * 64, cb = h * 64;
    const bf16_t* aR = prep_arr(p, 0); const bf16_t* aK = prep_arr(p, 1); bf16_t* aV = prep_arr(p, 2); const bf16_t* aU = prep_arr(p, 3);
    const bf16_t* aB = prep_arr(p, 4); const bf16_t* aX = prep_arr(p, 5); const bf16_t* aG = prep_arr(p, 6);
    bf16_t* sRt = (bf16_t*)smem; bf16_t* sBt = sRt + 64 * 72; bf16_t* sKt = sBt + 64 * 72; bf16_t* sX1 = sKt + 64 * 72; bf16_t* sVT = sX1 + 64 * 72;
    bf16_t* sZ0 = sVT + 64 * 72; bf16_t* sUT = sZ0 + 64 * 72; bf16_t* sArb = sUT + 64 * 72; bf16_t* sArk = sArb + 64 * 72; float* sY = (float*)(sArk + 64 * 72);
    __syncthreads();
    {
        const int t = tid >> 3, ch = tid & 7; const size_t o = (size_t)(t0 + t) * 512 + cb + ch * 8; const int lo = t * 72 + ch * 8;
        *(u32x4*)(sRt + lo) = *(const u32x4*)(aR + o);
        *(u32x4*)(sBt + lo) = *(const u32x4*)(aB + o);
        *(u32x4*)(sKt + lo) = *(const u32x4*)(aK + o);
        *(u32x4*)(sX1 + lo) = *(const u32x4*)(aX + o);
        const u32x4 vv = *(const u32x4*)(aV + o);
#pragma unroll
        for (int k = 0; k < 4; ++k) { sVT[(ch * 8 + 2 * k) * 72 + t] = (bf16_t)(vv[k] & 0xffffu); sVT[(ch * 8 + 2 * k + 1) * 72 + t] = (bf16_t)(vv[k] >> 16); }
        u32x4 zz = (u32x4){0u, 0u, 0u, 0u};
        if (c > 0) {
            const float* Z = (const float*)(p.ws + WS_XB) + (size_t)(unit - 1) * 4096 + t * 64 + ch * 8;
            const f32x4 z0 = *(const f32x4*)Z, z1 = *(const f32x4*)(Z + 4);
            zz[0] = pack2(z0[0], z0[1]); zz[1] = pack2(z0[2], z0[3]); zz[2] = pack2(z1[0], z1[1]); zz[3] = pack2(z1[2], z1[3]);
        }
        *(u32x4*)(sZ0 + lo) = zz;
    }
    __syncthreads();
    const int rb = wid >> 1, ch2 = wid & 1, tr = rb * 16 + fr;
    f32x4 ay[1][2]; accz(ay);
    {
        f32x4 au[1][2]; accz(au);
        mma_lds<1, 2, 2>(au, sX1 + rb * 16 * 72, 72, sZ0 + ch2 * 32 * 72, 72);
#pragma unroll
        for (int n = 0; n < 2; ++n) {
            const int i0 = ch2 * 32 + n * 16 + fq * 4;
            const f32x4 ul = ld_bf4(aU + (size_t)(t0 + tr) * 512 + cb + i0);
#pragma unroll
            for (int x = 0; x < 4; ++x) sUT[(i0 + x) * 72 + tr] = f2bf(au[0][n][x] + ul[x]);
        }
        f32x4 a1[1][2], a2[1][2]; accz(a1); accz(a2);
        mma_lds<1, 2, 2>(a1, sRt + rb * 16 * 72, 72, sBt + ch2 * 32 * 72, 72);
        mma_lds<1, 2, 2>(a2, sRt + rb * 16 * 72, 72, sKt + ch2 * 32 * 72, 72);
#pragma unroll
        for (int n = 0; n < 2; ++n) {
            const int s0 = ch2 * 32 + n * 16 + fq * 4;
            f32x4 m1, m2;
#pragma unroll
            for (int x = 0; x < 4; ++x) { const bool keep = (s0 + x) <= tr; m1[x] = keep ? a1[0][n][x] : 0.f; m2[x] = keep ? a2[0][n][x] : 0.f; }
            st_bf4(sArb + tr * 72 + s0, m1); st_bf4(sArk + tr * 72 + s0, m2);
        }
        mma_lds<1, 2, 2>(ay, sRt + rb * 16 * 72, 72, sZ0 + ch2 * 32 * 72, 72);
    }
    __syncthreads();
    mma_lds<1, 2, 2>(ay, sArb + rb * 16 * 72, 72, sUT + ch2 * 32 * 72, 72);
    mma_lds<1, 2, 2>(ay, sArk + rb * 16 * 72, 72, sVT + ch2 * 32 * 72, 72);
#pragma unroll
    for (int n = 0; n < 2; ++n) *(f32x4*)(sY + tr * 68 + ch2 * 32 + n * 16 + fq * 4) = ay[0][n];
    __syncthreads();
    {
        const int te = tid >> 3, i0 = (tid & 7) * 8;
        float y[8], s = 0.f, bon = 0.f;
        const float* rk = p.in[11] + cb + i0;
#pragma unroll
        for (int k = 0; k < 8; ++k) { y[k] = sY[te * 68 + i0 + k]; s += y[k]; bon += bf2f(sRt[te * 72 + i0 + k]) * bf2f(sKt[te * 72 + i0 + k]) * rk[k]; }
        s += __shfl_xor(s, 1, 64); s += __shfl_xor(s, 2, 64); s += __shfl_xor(s, 4, 64);
        bon += __shfl_xor(bon, 1, 64); bon += __shfl_xor(bon, 2, 64); bon += __shfl_xor(bon, 4, 64);
        const float mean = s * (1.f / 64.f);
        float s2 = 0.f;
#pragma unroll
        for (int k = 0; k < 8; ++k) { const float d = y[k] - mean; s2 += d * d; }
        s2 += __shfl_xor(s2, 1, 64); s2 += __shfl_xor(s2, 2, 64); s2 += __shfl_xor(s2, 4, 64);
        const float rstd = rsqrtf(s2 * (1.f / 64.f) + GN_EPS);
        const size_t o = (size_t)(t0 + te) * 512 + cb + i0;
        const u32x4 gg = *(const u32x4*)(aG + o);
        const float* gw = p.in[12] + cb + i0; const float* gb = p.in[13] + cb + i0;
        float r[8];
#pragma unroll
        for (int k = 0; k < 8; ++k) {
            const float g = (k & 1) ? __uint_as_float(gg[k >> 1] & 0xffff0000u) : __uint_as_float(gg[k >> 1] << 16);
            const float v = bf2f(sVT[(i0 + k) * 72 + te]);
            r[k] = ((y[k] - mean) * rstd * gw[k] + gb[k] + bon * v) * g;
        }
        u32x4 ov; ov[0] = pack2(r[0], r[1]); ov[1] = pack2(r[2], r[3]); ov[2] = pack2(r[4], r[5]); ov[3] = pack2(r[6], r[7]);
        *(u32x4*)(aV + o) = ov;
    }
}

DEVI void phase_scans_naive(const Params& p, unsigned char* smem) {
    if (blockIdx.x < 4) scan_rwkv_naive(p, smem, blockIdx.x);
    else if (blockIdx.x < 8) scan_hgrn_naive(p, smem, blockIdx.x - 4);
}
DEVI void phase_3a(const Params& p, unsigned char* smem) {
    for (int u = blockIdx.x; u < 3072; u += gridDim.x) { if (u < 2048) rwkv_r1(p, smem, u); else hgrn_h1(p, smem, u - 2048); }
}
DEVI void phase_3b(const Params& p, unsigned char* smem) {
    if (blockIdx.x < 32) { if (threadIdx.x < 256) rwkv_r2(p, blockIdx.x, threadIdx.x >> 6); }
    else if (blockIdx.x < 96) hgrn_h2(p, (blockIdx.x - 32) * 512 + threadIdx.x);
}
DEVI void phase_3c(const Params& p, unsigned char* smem) {
    for (int u = blockIdx.x; u < 3072; u += gridDim.x) { if (u < 2048) rwkv_r3(p, smem, u); else hgrn_h3(p, smem, u - 2048); }
}

DEVI void phase_merge(const Params& p, unsigned char* smem) {
    const bf16_t* ya = prep_arr(p, 2); const bf16_t* yb = (const bf16_t*)(p.ws + WS_PHG) + H_I;
    const bf16_t* WaT = (const bf16_t*)(p.ws + WS_WAT); const bf16_t* WbT = (const bf16_t*)(p.ws + WS_WBT);
    const bf16_t* pgt = (const bf16_t*)(p.ws + WS_PGT);
    bf16_t* merged = (bf16_t*)(p.ws + WS_MERGED);
    for (int t = blockIdx.x; t < 128 * 8; t += gridDim.x) {
        const int tm = t >> 3, tn = t & 7;
        f32x4 a1[2][4], a2[2][4]; acc_zero(a1); acc_zero(a2);
        gemm_accum(a1, ya, 512, IdRows{tm * 128}, WaT + (size_t)tn * 128 * 512, 512, 512, (bf16_t*)smem);
        gemm_accum(a2, yb, NHG, IdRows{tm * 128}, WbT + (size_t)tn * 128 * 512, 512, 512, (bf16_t*)smem);
        epi2(a1, a2, [&](int r, int c, f32x4 v1, f32x4 v2) {
            const size_t row = tm * 128 + r; const int col = tn * 128 + c;
            const f32x4 ga = ld_bf4(pgt + row * NHG + col), gb = ld_bf4(pgt + row * NHG + 1024 + col);
            f32x4 o;
#pragma unroll
            for (int q = 0; q < 4; ++q) o[q] = sigm(ga[q]) * v1[q] + sigm(gb[q]) * v2[q];
            st_bf4(merged + row * 1024 + col, o);
        });
    }
}

DEVI void phase_wo(const Params& p, unsigned char* smem) {
    const bf16_t* merged = (const bf16_t*)(p.ws + WS_MERGED); const bf16_t* WoT = (const bf16_t*)(p.ws + WS_WOT);
    const float* x = p.in[0]; float* x1pre = p.out;
    constexpr int T_G = 64 * 8, T_W = 4096;
    for (int t = blockIdx.x; t < T_G + 3 * T_W; t += gridDim.x) {
        if (t < T_G) {
            const int tm = t >> 3, tn = t & 7;
            f32x4 acc[4][4]; acc_zero(acc);
            gemm_accum(acc, merged, 1024, IdRows{tm * 256}, WoT + (size_t)tn * 128 * 1024, 1024, 1024, (bf16_t*)smem);
            epi1(acc, [&](int r, int c, f32x4 v) {
                const size_t o = (size_t)(tm * 256 + r) * 1024 + tn * 128 + c;
                const f32x4 xv = *(const f32x4*)(x + o);
                *(f32x4*)(x1pre + o) = xv * ALPHA + v;
            });
        } else {
            int u = t - T_G; const int which = u / T_W; u -= which * T_W;
            const int e = u >> 7, tt = u & 127;
            if (which == 0) transpose_tile(p.in[25] + (size_t)e * 1024 * 512, (bf16_t*)(p.ws + WS_W1T) + (size_t)e * 512 * 1024, 1024, 512, tt >> 3, tt & 7, (float*)smem);
            else if (which == 1) transpose_tile(p.in[26] + (size_t)e * 1024 * 512, (bf16_t*)(p.ws + WS_W3T) + (size_t)e * 512 * 1024, 1024, 512, tt >> 3, tt & 7, (float*)smem);
            else transpose_tile(p.in[27] + (size_t)e * 512 * 1024, (bf16_t*)(p.ws + WS_W2T) + (size_t)e * 1024 * 512, 512, 1024, tt >> 4, tt & 15, (float*)smem);
        }
    }
}

DEVI void phase_ln1_route(const Params& p, unsigned char* smem) {
    const float* x1pre = p.out; float* x1 = (float*)(p.ws + WS_X1); bf16_t* x1b = (bf16_t*)(p.ws + WS_X1B);
    const float* g = p.in[19]; const float* bta = p.in[20];
    const float* wg = p.in[21]; const float* bg = p.in[22]; const float* we = p.in[23]; const float* be = p.in[24];
    int* cnt = (int*)(p.ws + WS_CNT); int* slot = (int*)(p.ws + WS_SLOT); float* tw = (float*)(p.ws + WS_TW); int* list = (int*)(p.ws + WS_LIST);
    const int lane = threadIdx.x & 63, wid = threadIdx.x >> 6;
    for (int tk = blockIdx.x * 8 + wid; tk < NTOK; tk += gridDim.x * 8) {
        f32x4 xv[4]; float s = 0.f;
#pragma unroll
        for (int i = 0; i < 4; ++i) { xv[i] = *(const f32x4*)(x1pre + (size_t)tk * 1024 + i * 256 + lane * 4); s += xv[i][0] + xv[i][1] + xv[i][2] + xv[i][3]; }
        const float mean = wave_sum(s) * (1.f / 1024.f);
        float s2 = 0.f;
#pragma unroll
        for (int i = 0; i < 4; ++i)
#pragma unroll
            for (int q = 0; q < 4; ++q) { const float d = xv[i][q] - mean; s2 += d * d; }
        const float rstd = rsqrtf(wave_sum(s2) * (1.f / 1024.f) + LN_EPS);
        float lg[36];
#pragma unroll
        for (int o = 0; o < 36; ++o) lg[o] = 0.f;
        float* sy = (float*)smem + wid * 1024;
#pragma unroll
        for (int i = 0; i < 4; ++i) {
            const int col = i * 256 + lane * 4;
            const f32x4 g4 = *(const f32x4*)(g + col), b4 = *(const f32x4*)(bta + col);
            f32x4 y;
#pragma unroll
            for (int q = 0; q < 4; ++q) { y[q] = (xv[i][q] - mean) * rstd * g4[q] + b4[q]; sy[(i * 4 + q) * 64 + lane] = y[q]; }
            *(f32x4*)(x1 + (size_t)tk * 1024 + col) = y;
            st_bf4(x1b + (size_t)tk * 1024 + col, y);
        }
#pragma unroll 1
        for (int cc = 0; cc < 16; ++cc) {
            const float yv = sy[cc * 64 + lane];
            const int col = (cc >> 2) * 256 + lane * 4 + (cc & 3);
            const f32x4 w4 = *(const f32x4*)(wg + (size_t)col * 4);
#pragma unroll
            for (int o = 0; o < 4; ++o) lg[o] += yv * w4[o];
#pragma unroll
            for (int u = 0; u < 8; ++u) {
                const f32x4 e4 = *(const f32x4*)(we + (size_t)col * 32 + u * 4);
#pragma unroll
                for (int o = 0; o < 4; ++o) lg[4 + u * 4 + o] += yv * e4[o];
            }
        }
#pragma unroll
        for (int o = 0; o < 36; ++o) lg[o] = wave_sum(lg[o]);
        float gl[4];
#pragma unroll
        for (int q = 0; q < 4; ++q) gl[q] = lg[q] + bg[q];
        int gs = 0; float gm = gl[0];
#pragma unroll
        for (int q = 1; q < 4; ++q) if (gl[q] > gm) { gm = gl[q]; gs = q; }
        float gden = 0.f;
#pragma unroll
        for (int q = 0; q < 4; ++q) gden += __expf(gl[q] - gm);
        const float pg = 1.f / gden;
        float el[8];
#pragma unroll
        for (int j = 0; j < 8; ++j) {
            const float v0 = lg[4 + j] + be[j], v1 = lg[12 + j] + be[8 + j], v2 = lg[20 + j] + be[16 + j], v3 = lg[28 + j] + be[24 + j];
            el[j] = gs == 0 ? v0 : (gs == 1 ? v1 : (gs == 2 ? v2 : v3));
        }
        int i1 = 0; float m1 = el[0];
#pragma unroll
        for (int j = 1; j < 8; ++j) if (el[j] > m1) { m1 = el[j]; i1 = j; }
        int i2 = -1; float m2 = -3.0e38f;
#pragma unroll
        for (int j = 0; j < 8; ++j) if (j != i1 && el[j] > m2) { m2 = el[j]; i2 = j; }
        const float ex = __expf(m2 - m1);
        const float p1 = 1.f / (1.f + ex), p2 = ex / (1.f + ex);
        if (lane == 0) {
            const int e1 = gs * 8 + i1, e2 = gs * 8 + i2;
            const int pos1 = atomicAdd(cnt + e1, 1), pos2 = atomicAdd(cnt + e2, 1);
            list[(size_t)e1 * NTOK + pos1] = tk; list[(size_t)e2 * NTOK + pos2] = tk;
            slot[tk * 2] = (e1 << 16) | pos1; slot[tk * 2 + 1] = (e2 << 16) | pos2;
            tw[tk * 2] = pg * p1; tw[tk * 2 + 1] = pg * p2;
        }
    }
}

DEVI void moe_find(const int* cnt, int rti, int& e, int& rt, int& rowbase, int& nrows) {
    int rt0 = 0; rowbase = 0; e = 0;
    for (; e < NEXP - 1; ++e) { const int nt = (cnt[e] + 255) >> 8; if (rti < rt0 + nt) break; rt0 += nt; rowbase += nt * 256; }
    rt = rti - rt0; nrows = cnt[e] - rt * 256; nrows = nrows > 256 ? 256 : nrows;
}
DEVI int moe_total_rt(const int* cnt) { int s = 0; for (int e = 0; e < NEXP; ++e) s += (cnt[e] + 255) >> 8; return s; }
DEVI void phase_moe1(const Params& p, unsigned char* smem) {
    const int* cnt = (const int*)(p.ws + WS_CNT); const int* list = (const int*)(p.ws + WS_LIST);
    const bf16_t* x1b = (const bf16_t*)(p.ws + WS_X1B);
    const bf16_t* W1T = (const bf16_t*)(p.ws + WS_W1T); const bf16_t* W3T = (const bf16_t*)(p.ws + WS_W3T);
    bf16_t* hbuf = (bf16_t*)p.out;
    const int total = moe_total_rt(cnt) * 8;
    for (int t = blockIdx.x; t < total; t += gridDim.x) {
        const int rti = t >> 3, ct = t & 3, half = (t >> 2) & 1; int e, rt, rowbase, nrows; moe_find(cnt, rti, e, rt, rowbase, nrows);
        nrows -= half * 128; if (nrows <= 0) continue;
        rowbase += half * 128;
        f32x4 a1[2][4], a2[2][4]; acc_zero(a1); acc_zero(a2);
        const GatherRows gr{list + (size_t)e * NTOK + rt * 256 + half * 128, nrows > 128 ? 128 : nrows};
        gemm_accum(a1, x1b, 1024, gr, W1T + ((size_t)e * 512 + ct * 128) * 1024, 1024, 1024, (bf16_t*)smem);
        gemm_accum(a2, x1b, 1024, gr, W3T + ((size_t)e * 512 + ct * 128) * 1024, 1024, 1024, (bf16_t*)smem);
        epi2(a1, a2, [&](int r, int c, f32x4 v1, f32x4 v2) {
            f32x4 o;
#pragma unroll
            for (int q = 0; q < 4; ++q) o[q] = v1[q] * sigm(v1[q]) * v2[q];
            st_bf4(hbuf + (size_t)(rowbase + rt * 256 + r) * 512 + ct * 128 + c, o);
        });
    }
}
DEVI void phase_moe2(const Params& p, unsigned char* smem) {
    const int* cnt = (const int*)(p.ws + WS_CNT);
    const bf16_t* hbuf = (const bf16_t*)p.out; const bf16_t* W2T = (const bf16_t*)(p.ws + WS_W2T);
    bf16_t* y = (bf16_t*)(p.ws + WS_Y);
    const int total = moe_total_rt(cnt) * 8;
    for (int t = blockIdx.x; t < total; t += gridDim.x) {
        const int rti = t >> 3, ct = t & 7; int e, rt, rowbase, nrows; moe_find(cnt, rti, e, rt, rowbase, nrows);
        f32x4 acc[4][4]; acc_zero(acc);
        gemm_accum(acc, hbuf, 512, IdRows{rowbase + rt * 256}, W2T + ((size_t)e * 1024 + ct * 128) * 512, 512, 512, (bf16_t*)smem);
        epi1(acc, [&](int r, int c, f32x4 v) { st_bf4(y + (size_t)(rowbase + rt * 256 + r) * 1024 + ct * 128 + c, v); });
    }
}

DEVI void phase_ln2(const Params& p, unsigned char* smem) {
    float* x1 = (float*)(p.ws + WS_X1); bf16_t* x2b = (bf16_t*)(p.ws + WS_X1B);
    const bf16_t* y = (const bf16_t*)(p.ws + WS_Y);
    const int* cnt = (const int*)(p.ws + WS_CNT); const int* slot = (const int*)(p.ws + WS_SLOT); const float* tw = (const float*)(p.ws + WS_TW);
    const float* g = p.in[28]; const float* bta = p.in[29];
    const int lane = threadIdx.x & 63, wid = threadIdx.x >> 6;
    for (int tk = blockIdx.x * 8 + wid; tk < NTOK; tk += gridDim.x * 8) {
        const int s0 = slot[tk * 2], s1 = slot[tk * 2 + 1]; const float w0 = tw[tk * 2], w1 = tw[tk * 2 + 1];
        const int e0 = s0 >> 16, e1 = s1 >> 16;
        int rb0 = 0, rb1 = 0;
        for (int e = 0; e < NEXP; ++e) { const int pd = ((cnt[e] + 255) >> 8) << 8; if (e < e0) rb0 += pd; if (e < e1) rb1 += pd; }
        const size_t r0 = (size_t)(rb0 + (s0 & 0xffff)), r1 = (size_t)(rb1 + (s1 & 0xffff));
        f32x4 xv[4]; float s = 0.f;
#pragma unroll
        for (int i = 0; i < 4; ++i) {
            const int col = i * 256 + lane * 4;
            const f32x4 a = *(const f32x4*)(x1 + (size_t)tk * 1024 + col);
            const f32x4 y0 = ld_bf4(y + r0 * 1024 + col), y1 = ld_bf4(y + r1 * 1024 + col);
            xv[i] = a * ALPHA + y0 * w0 + y1 * w1;
            s += xv[i][0] + xv[i][1] + xv[i][2] + xv[i][3];
        }
        const float mean = wave_sum(s) * (1.f / 1024.f);
        float s2 = 0.f;
#pragma unroll
        for (int i = 0; i < 4; ++i)
#pragma unroll
            for (int q = 0; q < 4; ++q) { const float d = xv[i][q] - mean; s2 += d * d; }
        const float rstd = rsqrtf(wave_sum(s2) * (1.f / 1024.f) + LN_EPS);
#pragma unroll
        for (int i = 0; i < 4; ++i) {
            const int col = i * 256 + lane * 4;
            const f32x4 g4 = *(const f32x4*)(g + col), b4 = *(const f32x4*)(bta + col);
            f32x4 o;
#pragma unroll
            for (int q = 0; q < 4; ++q) o[q] = (xv[i][q] - mean) * rstd * g4[q] + b4[q];
            *(f32x4*)(x1 + (size_t)tk * 1024 + col) = o;
            st_bf4(x2b + (size_t)tk * 1024 + col, o);
        }
    }
}

DEVI void phase_final(const Params& p, unsigned char* smem) {
    const float* x2 = (const float*)(p.ws + WS_X1); const bf16_t* x2b = (const bf16_t*)(p.ws + WS_X1B); const bf16_t* pb = (const bf16_t*)(p.ws + WS_PB);
    const bf16_t* WpgT = (const bf16_t*)(p.ws + WS_WPGT); const bf16_t* WpeT = (const bf16_t*)(p.ws + WS_WPET);
    float* out = p.out;
    for (int t = blockIdx.x; t < 128 * 8; t += gridDim.x) {
        const int tm = t >> 3, tn = t & 7;
        f32x4 a1[2][4], a2[2][4]; acc_zero(a1); acc_zero(a2);
        gemm_accum(a1, x2b, 1024, IdRows{tm * 128}, WpgT + (size_t)tn * 128 * 1024, 1024, 1024, (bf16_t*)smem);
        gemm_accum(a2, pb, 256, IdRows{tm * 128}, WpeT + (size_t)tn * 128 * 256, 256, 256, (bf16_t*)smem);
        epi2(a1, a2, [&](int r, int c, f32x4 v1, f32x4 v2) {
            const size_t o = (size_t)(tm * 128 + r) * 1024 + tn * 128 + c;
            const f32x4 xv = *(const f32x4*)(x2 + o);
            f32x4 res;
#pragma unroll
            for (int q = 0; q < 4; ++q) res[q] = xv[q] + sigm(v1[q]) * v2[q];
            *(f32x4*)(out + o) = res;
        });
    }
}

extern __shared__ __attribute__((aligned(16))) unsigned char dyn_smem[];
#define PHASE_KERNEL(name, fn) __global__ void __launch_bounds__(NT) name(Params p) { fn(p, dyn_smem); }
PHASE_KERNEL(k_prep, phase_prep)
PHASE_KERNEL(k_inproj, phase_inproj)
PHASE_KERNEL(k_rwkv_prep, phase_rwkv_prep)
PHASE_KERNEL(k_scans, phase_scans_naive)
PHASE_KERNEL(k_merge, phase_merge)
PHASE_KERNEL(k_wo, phase_wo)
PHASE_KERNEL(k_ln1, phase_ln1_route)
PHASE_KERNEL(k_moe1, phase_moe1)
PHASE_KERNEL(k_moe2, phase_moe2)
PHASE_KERNEL(k_ln2, phase_ln2)
PHASE_KERNEL(k_final, phase_final)

__global__ void __launch_bounds__(NT) k_mega(Params p) {
    cg::grid_group grid = cg::this_grid();
    phase_prep(p, dyn_smem); grid.sync();
    phase_inproj(p, dyn_smem); grid.sync();
    phase_rwkv_prep(p, dyn_smem); grid.sync();
    phase_3a(p, dyn_smem); grid.sync();
    phase_3b(p, dyn_smem); grid.sync();
    phase_3c(p, dyn_smem); grid.sync();
    phase_merge(p, dyn_smem); grid.sync();
    phase_wo(p, dyn_smem); grid.sync();
    phase_ln1_route(p, dyn_smem); grid.sync();
    phase_moe1(p, dyn_smem); grid.sync();
    phase_moe2(p, dyn_smem); grid.sync();
    phase_ln2(p, dyn_smem); grid.sync();
    phase_final(p, dyn_smem);
}

extern "C" void kernel_launch(void* const* d_in, const int* in_sizes, int n_in, void* d_out, int out_size, void* d_ws, size_t ws_size, hipStream_t stream) {
    static int grid = 0;
    if (grid == 0) {
        if (n_in != 32 || out_size != NTOK * DM || ws_size < WS_END) { fprintf(stderr, "kernel_launch: unexpected shapes (n_in %d out %d ws %zu, need %zu)\n", n_in, out_size, ws_size, (size_t)WS_END); grid = -1; return; }
        int dev = 0, cus = 0, per_cu = 0;
        hipGetDevice(&dev); hipDeviceGetAttribute(&cus, hipDeviceAttributeMultiprocessorCount, dev);
#if MODE == 0
        const void* ks[] = {(const void*)k_prep, (const void*)k_inproj, (const void*)k_rwkv_prep, (const void*)k_scans, (const void*)k_merge, (const void*)k_wo,
                            (const void*)k_ln1, (const void*)k_moe1, (const void*)k_moe2, (const void*)k_ln2, (const void*)k_final};
        for (auto k : ks) hipFuncSetAttribute(k, hipFuncAttributeMaxDynamicSharedMemorySize, LDS_BYTES);
        grid = cus > 0 ? cus : 256;
#else
        hipFuncSetAttribute((const void*)k_mega, hipFuncAttributeMaxDynamicSharedMemorySize, LDS_BYTES);
        hipOccupancyMaxActiveBlocksPerMultiprocessor(&per_cu, (const void*)k_mega, NT, LDS_BYTES);
        if (per_cu < 1) { fprintf(stderr, "kernel_launch: occupancy query says %d blocks per CU\n", per_cu); grid = -1; return; }
        grid = cus;
#endif
        (void)hipGetLastError();
    }
    if (grid < 0) return;
    Params p{};
    for (int i = 0; i < 32; ++i) p.in[i] = (const float*)d_in[i];
    p.out = (float*)d_out; p.ws = (unsigned char*)d_ws;
#if MODE == 0
    k_prep<<<grid, NT, LDS_BYTES, stream>>>(p);
    k_inproj<<<grid, NT, LDS_BYTES, stream>>>(p);
    k_rwkv_prep<<<grid, NT, LDS_BYTES, stream>>>(p);
    k_scans<<<8, NT, LDS_BYTES, stream>>>(p);
    k_merge<<<grid, NT, LDS_BYTES, stream>>>(p);
    k_wo<<<grid, NT, LDS_BYTES, stream>>>(p);
    k_ln1<<<grid, NT, LDS_BYTES, stream>>>(p);
    k_moe1<<<grid, NT, LDS_BYTES, stream>>>(p);
    k_moe2<<<grid, NT, LDS_BYTES, stream>>>(p);
    k_ln2<<<grid, NT, LDS_BYTES, stream>>>(p);
    k_final<<<grid, NT, LDS_BYTES, stream>>>(p);
#else
    void* args[] = {&p};
    hipError_t e = hipLaunchCooperativeKernel((const void*)k_mega, dim3(grid), dim3(NT), args, LDS_BYTES, stream);
    if (e != hipSuccess) fprintf(stderr, "cooperative launch failed: %s (grid %d)\n", hipGetErrorString(e), grid);
#endif
}
```

```cpp
#include <hip/hip_runtime.h>
#include <hip/hip_cooperative_groups.h>
#include <cstdio>
#include <cstdint>
namespace cg = cooperative_groups;

#ifndef MODE
#define MODE 1
#endif

typedef unsigned short bf16_t;
typedef short bf16x8 __attribute__((ext_vector_type(8)));
typedef float f32x4 __attribute__((ext_vector_type(4)));
typedef unsigned u32x4 __attribute__((ext_vector_type(4)));
typedef unsigned u32x2 __attribute__((ext_vector_type(2)));
typedef float f32x2 __attribute__((ext_vector_type(2)));
#define DEVI __device__ __forceinline__

constexpr int NT = 512;
constexpr int NTOK = 16384, DM = 1024, SEQ = 4096, NIN = 5888, PLE = 256;
constexpr int C_K = 512, C_V = 1024, C_WD = 1536, NRW = 1792, NHG = 2048;
constexpr int H_Q = 0, H_F = 512, H_I = 1024, H_OG = 1536;
constexpr int NEXP = 32;
constexpr float ALPHA = 1.189207115002721f;
constexpr float LN_EPS = 1e-5f, RMS_EPS = 1e-6f, GN_EPS = 64e-5f;
constexpr int LDS_BYTES = 131072;

constexpr size_t MiB = 1048576;
constexpr size_t WS_WAT = 0, WS_WBT = 1 * MiB, WS_WOT = 2 * MiB, WS_WPGT = 4 * MiB, WS_WPET = 6 * MiB;
constexpr size_t WS_CNT = 6 * MiB + 512 * 1024;
constexpr size_t WS_SLOT = WS_CNT + 4096;
constexpr size_t WS_TW = WS_SLOT + (size_t)NTOK * 2 * 4;
constexpr size_t WS_LIST = WS_TW + (size_t)NTOK * 2 * 4;
constexpr size_t WS_BAR = 9 * MiB + 768 * 1024;
constexpr size_t WS_GBUF = 9 * MiB;
constexpr size_t WS_PB = 12 * MiB;
constexpr size_t WS_PRW = 20 * MiB;
constexpr size_t WS_PHG = 76 * MiB;
constexpr size_t WS_PGT = 140 * MiB;
constexpr size_t WS_W1T = 20 * MiB, WS_W3T = 52 * MiB, WS_W2T = 84 * MiB;
constexpr size_t WS_Y = 116 * MiB;
constexpr size_t WS_XB = 204 * MiB;
constexpr size_t WS_YA = 204 * MiB, WS_YB = 220 * MiB;
constexpr size_t WS_X1B = 204 * MiB;
constexpr size_t WS_WINT = 236 * MiB;
constexpr size_t WS_PREP = 236 * MiB;
constexpr size_t WS_MERGED = 236 * MiB;
constexpr size_t WS_X1 = 236 * MiB;
constexpr size_t WS_END = 300 * MiB;
constexpr int YROWS = 40960;

struct Params { const float* in[32]; float* out; unsigned char* ws; };

DEVI float bf2f(bf16_t h) { return __uint_as_float(((unsigned)h) << 16); }
DEVI bf16_t f2bf(float f) { unsigned u = __float_as_uint(f); u += 0x7fffu + ((u >> 16) & 1u); return (bf16_t)(u >> 16); }
DEVI unsigned pack2(float a, float b) { return (unsigned)f2bf(a) | ((unsigned)f2bf(b) << 16); }
DEVI float sigm(float x) { return 1.f / (1.f + __expf(-x)); }
DEVI float wave_sum(float v) {
#pragma unroll
    for (int o = 32; o > 0; o >>= 1) v += __shfl_xor(v, o, 64);
    return v;
}
DEVI f32x4 ld_bf4(const bf16_t* p) { u32x2 u = *(const u32x2*)p; f32x4 r; r[0] = __uint_as_float(u[0] << 16); r[1] = __uint_as_float(u[0] & 0xffff0000u); r[2] = __uint_as_float(u[1] << 16); r[3] = __uint_as_float(u[1] & 0xffff0000u); return r; }
DEVI void st_bf4(bf16_t* p, f32x4 v) { u32x2 o; o[0] = pack2(v[0], v[1]); o[1] = pack2(v[2], v[3]); *(u32x2*)p = o; }

DEVI void cvt_tile(const float* __restrict__ src, bf16_t* __restrict__ dst, int tile) {
    const size_t base = (size_t)tile * 4096 + threadIdx.x * 8;
    const f32x4 a = *(const f32x4*)(src + base), b = *(const f32x4*)(src + base + 4);
    u32x4 o; o[0] = pack2(a[0], a[1]); o[1] = pack2(a[2], a[3]); o[2] = pack2(b[0], b[1]); o[3] = pack2(b[2], b[3]);
    *(u32x4*)(dst + base) = o;
}
DEVI void transpose_tile(const float* __restrict__ src, bf16_t* __restrict__ dst, int R, int C, int tr, int tc, float* sm) {
    const int tid = threadIdx.x;
    __syncthreads();
#pragma unroll
    for (int i = 0; i < 2; ++i) {
        const int r = (tid >> 4) + 32 * i, c4 = (tid & 15) * 4;
        const f32x4 v = *(const f32x4*)(src + (size_t)(tr * 64 + r) * C + tc * 64 + c4);
        float* d = sm + r * 65 + c4; d[0] = v[0]; d[1] = v[1]; d[2] = v[2]; d[3] = v[3];
    }
    __syncthreads();
    const int c = tid >> 3, r8 = (tid & 7) * 8;
    float v[8];
#pragma unroll
    for (int k = 0; k < 8; ++k) v[k] = sm[(r8 + k) * 65 + c];
    u32x4 o; o[0] = pack2(v[0], v[1]); o[1] = pack2(v[2], v[3]); o[2] = pack2(v[4], v[5]); o[3] = pack2(v[6], v[7]);
    *(u32x4*)(dst + (size_t)(tc * 64 + c) * R + tr * 64 + r8) = o;
}

constexpr int GLD = 72;
struct IdRows { int base; DEVI int operator()(int r) const { return base + r; } };
struct GatherRows { const int* list; int n; DEVI int operator()(int r) const { return r < n ? list[r] : 0; } };

template <int MF, class RowMap>
DEVI void gemm_accum(f32x4 (&acc)[MF][4], const bf16_t* __restrict__ A, int lda, RowMap rowmap,
                     const bf16_t* __restrict__ Bt, int ldb, int K, bf16_t* sm) {
    bf16_t* sA = sm; bf16_t* sB = sm + MF * 64 * GLD;
    const int tid = threadIdx.x, lane = tid & 63, wid = tid >> 6, wr = wid >> 1, wc = wid & 1, fr = lane & 15, fq = lane >> 4;
    const int lrow = tid >> 3, kc = tid & 7;
    const bf16_t* ap[MF]; const bf16_t* bp[2];
#pragma unroll
    for (int i = 0; i < MF; ++i) ap[i] = A + (size_t)rowmap(lrow + 64 * i) * lda + kc * 8;
#pragma unroll
    for (int i = 0; i < 2; ++i) bp[i] = Bt + (size_t)(lrow + 64 * i) * ldb + kc * 8;
    u32x4 ra[MF], rb[2];
#pragma unroll
    for (int i = 0; i < MF; ++i) ra[i] = *(const u32x4*)(ap[i]);
#pragma unroll
    for (int i = 0; i < 2; ++i) rb[i] = *(const u32x4*)(bp[i]);
    const int nk = K >> 6;
    for (int kt = 0; kt < nk; ++kt) {
        __syncthreads();
#pragma unroll
        for (int i = 0; i < MF; ++i) *(u32x4*)(sA + (lrow + 64 * i) * GLD + kc * 8) = ra[i];
#pragma unroll
        for (int i = 0; i < 2; ++i) *(u32x4*)(sB + (lrow + 64 * i) * GLD + kc * 8) = rb[i];
        __syncthreads();
        if (kt + 1 < nk) {
#pragma unroll
            for (int i = 0; i < MF; ++i) ra[i] = *(const u32x4*)(ap[i] + (kt + 1) * 64);
#pragma unroll
            for (int i = 0; i < 2; ++i) rb[i] = *(const u32x4*)(bp[i] + (kt + 1) * 64);
        }
#pragma unroll
        for (int kk = 0; kk < 2; ++kk) {
            bf16x8 af[MF], bfr[4];
#pragma unroll
            for (int m = 0; m < MF; ++m) af[m] = *(const bf16x8*)(sA + (wr * (MF * 16) + m * 16 + fr) * GLD + kk * 32 + fq * 8);
#pragma unroll
            for (int n = 0; n < 4; ++n) bfr[n] = *(const bf16x8*)(sB + (wc * 64 + n * 16 + fr) * GLD + kk * 32 + fq * 8);
#pragma unroll
            for (int m = 0; m < MF; ++m)
#pragma unroll
                for (int n = 0; n < 4; ++n) acc[m][n] = __builtin_amdgcn_mfma_f32_16x16x32_bf16(bfr[n], af[m], acc[m][n], 0, 0, 0);
        }
    }
}
template <int MF> DEVI void acc_zero(f32x4 (&acc)[MF][4]) {
#pragma unroll
    for (int m = 0; m < MF; ++m)
#pragma unroll
        for (int n = 0; n < 4; ++n) acc[m][n] = (f32x4){0.f, 0.f, 0.f, 0.f};
}
template <int MF, class F> DEVI void epi1(const f32x4 (&acc)[MF][4], F f) {
    const int lane = threadIdx.x & 63, wid = threadIdx.x >> 6, wr = wid >> 1, wc = wid & 1, fr = lane & 15, fq = lane >> 4;
#pragma unroll
    for (int m = 0; m < MF; ++m)
#pragma unroll
        for (int n = 0; n < 4; ++n) f(wr * (MF * 16) + m * 16 + fr, wc * 64 + n * 16 + fq * 4, acc[m][n]);
}
template <int MF, class F> DEVI void epi2(const f32x4 (&a1)[MF][4], const f32x4 (&a2)[MF][4], F f) {
    const int lane = threadIdx.x & 63, wid = threadIdx.x >> 6, wr = wid >> 1, wc = wid & 1, fr = lane & 15, fq = lane >> 4;
#pragma unroll
    for (int m = 0; m < MF; ++m)
#pragma unroll
        for (int n = 0; n < 4; ++n) f(wr * (MF * 16) + m * 16 + fr, wc * 64 + n * 16 + fq * 4, a1[m][n], a2[m][n]);
}

DEVI void phase_prep(const Params& p, unsigned char* smem) {
    float* sm = (float*)smem;
    bf16_t* xb = (bf16_t*)(p.ws + WS_XB); bf16_t* pb = (bf16_t*)(p.ws + WS_PB);
    constexpr int T_X = 4096, T_P = 1024, T_WIN = 16 * 92, T_WA = 8 * 16, T_WB = 8 * 16, T_WO = 16 * 16, T_WPE = 4 * 16, T_WPG = 16 * 16;
    constexpr int TOTAL = T_X + T_P + T_WIN + T_WA + T_WB + T_WO + T_WPE + T_WPG;
    for (int t = blockIdx.x; t < TOTAL; t += gridDim.x) {
        int u = t;
        if (u < T_X) { cvt_tile(p.in[0], xb, u); continue; } u -= T_X;
        if (u < T_P) { cvt_tile(p.in[1], pb, u); continue; } u -= T_P;
        if (u < T_WIN) { transpose_tile(p.in[2], (bf16_t*)(p.ws + WS_WINT), 1024, NIN, u / 92, u % 92, sm); continue; } u -= T_WIN;
        if (u < T_WA) { transpose_tile(p.in[14], (bf16_t*)(p.ws + WS_WAT), 512, 1024, u / 16, u % 16, sm); continue; } u -= T_WA;
        if (u < T_WB) { transpose_tile(p.in[17], (bf16_t*)(p.ws + WS_WBT), 512, 1024, u / 16, u % 16, sm); continue; } u -= T_WB;
        if (u < T_WO) { transpose_tile(p.in[18], (bf16_t*)(p.ws + WS_WOT), 1024, 1024, u / 16, u % 16, sm); continue; } u -= T_WO;
        if (u < T_WPE) { transpose_tile(p.in[30], (bf16_t*)(p.ws + WS_WPET), 256, 1024, u / 16, u % 16, sm); continue; } u -= T_WPE;
        transpose_tile(p.in[31], (bf16_t*)(p.ws + WS_WPGT), 1024, 1024, u / 16, u % 16, sm);
    }
    if (blockIdx.x == 0 && threadIdx.x < 32) ((int*)(p.ws + WS_CNT))[threadIdx.x] = 0;
}

DEVI void phase_inproj(const Params& p, unsigned char* smem) {
    const bf16_t* xb = (const bf16_t*)(p.ws + WS_XB); const bf16_t* WinT = (const bf16_t*)(p.ws + WS_WINT);
    for (int t = blockIdx.x; t < 64 * 46; t += gridDim.x) {
        const int tm = t / 46, tn = t % 46;
        f32x4 acc[4][4]; acc_zero(acc);
        gemm_accum(acc, xb, 1024, IdRows{tm * 256}, WinT + (size_t)tn * 128 * 1024, 1024, 1024, (bf16_t*)smem);
        bf16_t* dst; int ld;
        if (tn < 14) { dst = (bf16_t*)(p.ws + WS_PRW) + tn * 128; ld = NRW; }
        else if (tn < 30) { dst = (bf16_t*)(p.ws + WS_PHG) + (tn - 14) * 128; ld = NHG; }
        else { dst = (bf16_t*)(p.ws + WS_PGT) + (tn - 30) * 128; ld = NHG; }
        epi1(acc, [&](int r, int c, f32x4 v) { st_bf4(dst + (size_t)(tm * 256 + r) * ld + c, v); });
    }
}

DEVI bf16_t* prep_arr(const Params& p, int i) { return i < 4 ? (bf16_t*)(p.ws + WS_PREP + (size_t)i * 16 * MiB) : (bf16_t*)((unsigned char*)p.out + (size_t)(i - 4) * 16 * MiB); }
DEVI void phase_rwkv_prep(const Params& p, unsigned char* smem) {
    float* lin = (float*)smem;
    const bf16_t* proj = (const bf16_t*)(p.ws + WS_PRW);
    const float* mu = p.in[3]; const float* w_up = p.in[5]; const float* a_up = p.in[7]; const float* g_up = p.in[8];
    const int tid = threadIdx.x, c = tid;
    const float mu_r = mu[c], mu_k = mu[C_K + c], mu_v = mu[C_V + c];
    const float w0 = p.in[4][c], a0 = p.in[6][c], kkc = p.in[9][c], kac = p.in[10][c];
    bf16_t* oR = prep_arr(p, 0); bf16_t* oK = prep_arr(p, 1); bf16_t* oV = prep_arr(p, 2); bf16_t* oW = prep_arr(p, 3);
    bf16_t* oKK = prep_arr(p, 4); bf16_t* oA = prep_arr(p, 5); bf16_t* oG = prep_arr(p, 6);
    for (int grp = blockIdx.x; grp < NTOK / 16; grp += gridDim.x) {
        const int t0 = grp * 16;
        __syncthreads();
#pragma unroll
        for (int i = 0; i < 8; ++i) {
            const int idx = tid + 512 * i, tt = idx >> 8, l = idx & 255, t = t0 + tt, col = C_WD + l;
            const float cur = bf2f(proj[(size_t)t * NRW + col]);
            const float prev = (t % SEQ == 0) ? 0.f : bf2f(proj[(size_t)(t - 1) * NRW + col]);
            const float u = cur + (prev - cur) * mu[col];
            lin[tt * 256 + l] = l < 64 ? tanhf(u) : (l < 128 ? u : sigm(u));
        }
        __syncthreads();
        float aw[16], aa[16], ag[16];
#pragma unroll
        for (int tt = 0; tt < 16; ++tt) { aw[tt] = 0.f; aa[tt] = 0.f; ag[tt] = 0.f; }
        for (int l = 0; l < 64; ++l) {
            const float w = w_up[l * 512 + c], a = a_up[l * 512 + c];
#pragma unroll
            for (int tt = 0; tt < 16; ++tt) { aw[tt] += lin[tt * 256 + l] * w; aa[tt] += lin[tt * 256 + 64 + l] * a; }
        }
        for (int l = 0; l < 128; ++l) {
            const float g = g_up[l * 512 + c];
#pragma unroll
            for (int tt = 0; tt < 16; ++tt) ag[tt] += lin[tt * 256 + 128 + l] * g;
        }
#pragma unroll
        for (int tt = 0; tt < 16; ++tt) {
            const int t = t0 + tt; const bool first = (t % SEQ == 0);
            const bf16_t* row = proj + (size_t)t * NRW; const bf16_t* prow = row - NRW;
            float r = bf2f(row[c]), k = bf2f(row[C_K + c]), v = bf2f(row[C_V + c]);
            const float pr = first ? 0.f : bf2f(prow[c]), pk = first ? 0.f : bf2f(prow[C_K + c]), pv = first ? 0.f : bf2f(prow[C_V + c]);
            r += (pr - r) * mu_r; k += (pk - k) * mu_k; v += (pv - v) * mu_v;
            const float z = -(w0 + aw[tt]);
            const float sp = z > 20.f ? z : log1pf(__expf(z));
            const float wl = -sp - 0.5f;
            const float logw = -__expf(wl);
            const float a = sigm(a0 + aa[tt]);
            const float kkv = k * kkc;
            const float ss = wave_sum(kkv * kkv);
            const float kkn = kkv / fmaxf(sqrtf(ss), 1e-12f);
            const float kp = k * (1.f + (a - 1.f) * kac);
            const size_t o = (size_t)t * 512 + c;
            oR[o] = f2bf(r); oK[o] = f2bf(kp); oV[o] = f2bf(v); oW[o] = f2bf(logw); oKK[o] = f2bf(kkn); oA[o] = f2bf(a); oG[o] = f2bf(ag[tt]);
        }
    }
}

DEVI void scan_rwkv_naive(const Params& p, unsigned char* smem, int blk) {
    const int tid = threadIdx.x, lane = tid & 63, wid = tid >> 6;
    const int unit = blk * 8 + wid, b = unit >> 3, h = unit & 7, c = h * 64 + lane;
    float* sw = (float*)smem + wid * (4 * 7 * 64);
    float* srk = (float*)smem + 8 * (4 * 7 * 64) + wid * 64;
    const bf16_t* iR = prep_arr(p, 0); const bf16_t* iK = prep_arr(p, 1); const bf16_t* iV = prep_arr(p, 2); const bf16_t* iW = prep_arr(p, 3);
    const bf16_t* iKK = prep_arr(p, 4); const bf16_t* iA = prep_arr(p, 5); const bf16_t* iG = prep_arr(p, 6);
    bf16_t* ya = (bf16_t*)(p.ws + WS_YA);
    srk[lane] = p.in[11][c];
    const float gnw = p.in[12][c], gnb = p.in[13][c];
    float S[64];
#pragma unroll
    for (int j = 0; j < 64; ++j) S[j] = 0.f;
    for (int t0 = 0; t0 < SEQ; t0 += 4) {
        __syncthreads();
#pragma unroll
        for (int s = 0; s < 4; ++s) {
            const size_t o = (size_t)(b * SEQ + t0 + s) * 512 + c;
            const float r = bf2f(iR[o]), k = bf2f(iK[o]), w = __expf(bf2f(iW[o])), kk = bf2f(iKK[o]), a = bf2f(iA[o]);
            float* d = sw + s * 7 * 64 + lane;
            d[0] = r; d[64] = k; d[128] = w; d[192] = -kk; d[256] = kk * a; d[320] = bf2f(iV[o]); d[384] = bf2f(iG[o]);
        }
        __syncthreads();
#pragma unroll 1
        for (int s = 0; s < 4; ++s) {
            const f32x4* vr = (const f32x4*)(sw + s * 7 * 64);
            const f32x4* vk = vr + 16; const f32x4* vw = vr + 32; const f32x4* va = vr + 48; const f32x4* vb = vr + 64;
            const float v = sw[s * 7 * 64 + 320 + lane], g = sw[s * 7 * 64 + 384 + lane];
            float sa = 0.f;
#pragma unroll
            for (int j4 = 0; j4 < 16; ++j4) { const f32x4 a4 = va[j4];
#pragma unroll
                for (int q = 0; q < 4; ++q) sa += S[j4 * 4 + q] * a4[q]; }
            float y = 0.f, bon = 0.f;
#pragma unroll
            for (int j4 = 0; j4 < 16; ++j4) {
                const f32x4 w4 = vw[j4], b4 = vb[j4], k4 = vk[j4], r4 = vr[j4], rk4 = ((const f32x4*)srk)[j4];
#pragma unroll
                for (int q = 0; q < 4; ++q) {
                    const float sn = S[j4 * 4 + q] * w4[q] + sa * b4[q] + v * k4[q];
                    S[j4 * 4 + q] = sn; y += sn * r4[q]; bon += r4[q] * k4[q] * rk4[q];
                }
            }
            const float mean = wave_sum(y) * (1.f / 64.f);
            const float d = y - mean;
            const float var = wave_sum(d * d) * (1.f / 64.f);
            const float outv = (d * rsqrtf(var + GN_EPS) * gnw + gnb + bon * v) * g;
            ya[(size_t)(b * SEQ + t0 + s) * 512 + c] = f2bf(outv);
        }
    }
}
DEVI void scan_hgrn_naive(const Params& p, unsigned char* smem, int blk) {
    const int tid = threadIdx.x, lane = tid & 63, ul = tid >> 7, v = tid & 127, wiu = (tid >> 6) & 1;
    const int unit = blk * 4 + ul, b = unit >> 2, h = unit & 3, c = h * 128 + v;
    float* su = (float*)smem + ul * (4 * 5 * 128);
    float* spart = (float*)smem + 4 * (4 * 5 * 128) + ul * 8;
    const bf16_t* proj = (const bf16_t*)(p.ws + WS_PHG);
    bf16_t* yb = (bf16_t*)(p.ws + WS_YB);
    const float l0 = p.in[15][c], l1 = p.in[15][512 + c];
    const float lb = 1.f / (1.f + __expf(l1 - l0));
    const float nw = p.in[16][c];
    float S[128];
#pragma unroll
    for (int e = 0; e < 128; ++e) S[e] = 0.f;
    for (int t0 = 0; t0 < SEQ; t0 += 4) {
        __syncthreads();
#pragma unroll
        for (int s = 0; s < 4; ++s) {
            const bf16_t* row = proj + (size_t)(b * SEQ + t0 + s) * NHG;
            const float z = bf2f(row[H_F + c]), qr = bf2f(row[H_Q + c]);
            const float sg = sigm(z);
            float* d = su + s * 5 * 128 + v;
            d[0] = lb + (1.f - lb) * sg; d[128] = (1.f - lb) * (1.f - sg); d[256] = qr * sigm(qr); d[384] = bf2f(row[H_I + c]); d[512] = bf2f(row[H_OG + c]);
        }
        __syncthreads();
        float os[4];
#pragma unroll
        for (int s = 0; s < 4; ++s) {
            const f32x4* vf = (const f32x4*)(su + s * 5 * 128); const f32x4* vk = vf + 32; const f32x4* vq = vf + 64;
            const float vin = su[s * 5 * 128 + 384 + v];
            float o = 0.f;
#pragma unroll
            for (int e4 = 0; e4 < 32; ++e4) {
                const f32x4 f4 = vf[e4], k4 = vk[e4], q4 = vq[e4];
#pragma unroll
                for (int q = 0; q < 4; ++q) { const float sn = f4[q] * S[e4 * 4 + q] + k4[q] * vin; S[e4 * 4 + q] = sn; o += q4[q] * sn; }
            }
            os[s] = o;
            const float ss = wave_sum(o * o);
            if (lane == 0) spart[s * 2 + wiu] = ss;
        }
        __syncthreads();
#pragma unroll
        for (int s = 0; s < 4; ++s) {
            const float tot = spart[s * 2] + spart[s * 2 + 1];
            const float og = su[s * 5 * 128 + 512 + v];
            yb[(size_t)(b * SEQ + t0 + s) * 512 + c] = f2bf(os[s] * rsqrtf(tot * (1.f / 128.f) + RMS_EPS) * nw * sigm(og));
        }
    }
}

template <int MT, int NTL, int KS>
DEVI void mma_lds(f32x4 (&acc)[MT][NTL], const bf16_t* sA, int lda, const bf16_t* sB, int ldb) {
    const int lane = threadIdx.x & 63, fr = lane & 15, fq = lane >> 4;
#pragma unroll
    for (int ks = 0; ks < KS; ++ks) {
        bf16x8 af[MT], bfr[NTL];
#pragma unroll
        for (int m = 0; m < MT; ++m) af[m] = *(const bf16x8*)(sA + (m * 16 + fr) * lda + ks * 32 + fq * 8);
#pragma unroll
        for (int n = 0; n < NTL; ++n) bfr[n] = *(const bf16x8*)(sB + (n * 16 + fr) * ldb + ks * 32 + fq * 8);
#pragma unroll
        for (int m = 0; m < MT; ++m)
#pragma unroll
            for (int n = 0; n < NTL; ++n) acc[m][n] = __builtin_amdgcn_mfma_f32_16x16x32_bf16(bfr[n], af[m], acc[m][n], 0, 0, 0);
    }
}
template <int MT, int NTL> DEVI void accz(f32x4 (&acc)[MT][NTL]) {
#pragma unroll
    for (int m = 0; m < MT; ++m)
#pragma unroll
        for (int n = 0; n < NTL; ++n) acc[m][n] = (f32x4){0.f, 0.f, 0.f, 0.f};
}

DEVI bf16_t* kv_ptr(const Params& p, int unit) {
    return unit < 768 ? (bf16_t*)(p.ws + WS_PRW + 32 * MiB) + (size_t)unit * 16384 : (bf16_t*)((unsigned char*)p.out + 48 * MiB) + (size_t)(unit - 768) * 16384;
}
DEVI void hgrn_h1(const Params& p, unsigned char* smem, int unit) {
    const int tid = threadIdx.x, wid = tid >> 6, lane = tid & 63, fr = lane & 15, fq = lane >> 4;
    const int c = unit & 63, bh = unit >> 6, h = bh & 3, b = bh >> 2, t0 = b * SEQ + c * 64;
    bf16_t* phg = (bf16_t*)(p.ws + WS_PHG);
    bf16_t* sZ = (bf16_t*)smem; bf16_t* sQ = sZ + 64 * 136; bf16_t* sKtT = sQ + 64 * 136; bf16_t* sVT = sKtT + 128 * 72; float* sG = (float*)(sVT + 128 * 72);
    __syncthreads();
#pragma unroll
    for (int i = 0; i < 2; ++i) {
        const int idx = tid + 512 * i, t = idx >> 4, ch = idx & 15;
        const bf16_t* row = phg + (size_t)(t0 + t) * NHG + h * 128 + ch * 8;
        *(u32x4*)(sZ + t * 136 + ch * 8) = *(const u32x4*)(row + H_F);
        *(u32x4*)(sQ + t * 136 + ch * 8) = *(const u32x4*)(row + H_Q);
        const u32x4 vv = *(const u32x4*)(row + H_I);
#pragma unroll
        for (int k = 0; k < 4; ++k) { sVT[(ch * 8 + 2 * k) * 72 + t] = (bf16_t)(vv[k] & 0xffffu); sVT[(ch * 8 + 2 * k + 1) * 72 + t] = (bf16_t)(vv[k] >> 16); }
    }
    __syncthreads();
    if (tid < 128) {
        const int e = tid, col = h * 128 + e;
        const float l0 = p.in[15][col], l1 = p.in[15][512 + col];
        const float lb = 1.f / (1.f + __expf(l1 - l0));
        float bsum = 0.f;
        for (int t = 0; t < 64; ++t) {
            const float z = bf2f(sZ[t * 136 + e]), qr = bf2f(sQ[t * 136 + e]);
            const float sg = sigm(z), f = lb + (1.f - lb) * sg, k = (1.f - lb) * (1.f - sg);
            bsum += __logf(f);
            const bf16_t kt = f2bf(k * __expf(-bsum)), qt = f2bf(qr * sigm(qr) * __expf(bsum));
            sKtT[e * 72 + t] = kt;
            bf16_t* row = phg + (size_t)(t0 + t) * NHG + col;
            row[H_F] = kt; row[H_Q] = qt;
        }
        const float G = __expf(bsum);
        sG[e] = G; ((float*)(p.ws + WS_GBUF))[(size_t)unit * 128 + e] = G;
    }
    __syncthreads();
    f32x4 acc[1][8]; accz(acc);
    mma_lds<1, 8, 2>(acc, sVT + wid * 16 * 72, 72, sKtT, 72);
    bf16_t* kv = kv_ptr(p, unit);
#pragma unroll
    for (int n = 0; n < 8; ++n) {
        const f32x4 g4 = *(const f32x4*)(sG + n * 16 + fq * 4);
        st_bf4(kv + (size_t)(wid * 16 + fr) * 128 + n * 16 + fq * 4, acc[0][n] * g4);
    }
}
DEVI void hgrn_h2(const Params& p, int item) {
    const int bh = item >> 11, rem = item & 2047, off = (rem >> 4) * 128 + (rem & 15) * 8;
    const float* gbuf = (const float*)(p.ws + WS_GBUF);
    float S[8];
#pragma unroll
    for (int k = 0; k < 8; ++k) S[k] = 0.f;
    for (int c0 = 0; c0 < 64; c0 += 4) {
        u32x4 kv[4]; f32x4 g0[4], g1[4];
#pragma unroll
        for (int i = 0; i < 4; ++i) {
            const int unit = bh * 64 + c0 + i;
            kv[i] = *(const u32x4*)(kv_ptr(p, unit) + off);
            g0[i] = *(const f32x4*)(gbuf + (size_t)unit * 128 + (rem & 15) * 8); g1[i] = *(const f32x4*)(gbuf + (size_t)unit * 128 + (rem & 15) * 8 + 4);
        }
#pragma unroll
        for (int i = 0; i < 4; ++i) {
            u32x4 o;
#pragma unroll
            for (int k = 0; k < 4; ++k) {
                const float ga = k < 2 ? g0[i][2 * k] : g1[i][2 * k - 4], gb = k < 2 ? g0[i][2 * k + 1] : g1[i][2 * k - 3];
                S[2 * k] = ga * S[2 * k] + __uint_as_float(kv[i][k] << 16);
                S[2 * k + 1] = gb * S[2 * k + 1] + __uint_as_float(kv[i][k] & 0xffff0000u);
                o[k] = pack2(S[2 * k], S[2 * k + 1]);
            }
            *(u32x4*)(kv_ptr(p, bh * 64 + c0 + i) + off) = o;
        }
    }
}
DEVI void hgrn_h3(const Params& p, unsigned char* smem, int unit) {
    const int tid = threadIdx.x, wid = tid >> 6, lane = tid & 63, fr = lane & 15, fq = lane >> 4;
    const int c = unit & 63, bh = unit >> 6, h = bh & 3, b = bh >> 2, t0 = b * SEQ + c * 64;
    bf16_t* phg = (bf16_t*)(p.ws + WS_PHG);
    bf16_t* sQt = (bf16_t*)smem; bf16_t* sKt = sQt + 64 * 136; bf16_t* sVT = sKt + 64 * 136; bf16_t* sS0 = sVT + 128 * 72; bf16_t* sAtt = sS0 + 128 * 136;
    float* sO = (float*)sS0;
    __syncthreads();
#pragma unroll
    for (int i = 0; i < 2; ++i) {
        const int idx = tid + 512 * i, t = idx >> 4, ch = idx & 15;
        const bf16_t* row = phg + (size_t)(t0 + t) * NHG + h * 128 + ch * 8;
        *(u32x4*)(sKt + t * 136 + ch * 8) = *(const u32x4*)(row + H_F);
        *(u32x4*)(sQt + t * 136 + ch * 8) = *(const u32x4*)(row + H_Q);
        const u32x4 vv = *(const u32x4*)(row + H_I);
#pragma unroll
        for (int k = 0; k < 4; ++k) { sVT[(ch * 8 + 2 * k) * 72 + t] = (bf16_t)(vv[k] & 0xffffu); sVT[(ch * 8 + 2 * k + 1) * 72 + t] = (bf16_t)(vv[k] >> 16); }
    }
    {
        const bf16_t* s0 = c > 0 ? kv_ptr(p, unit - 1) : nullptr;
#pragma unroll
        for (int i = 0; i < 4; ++i) {
            const int idx = tid + 512 * i, v = idx >> 4, ch = idx & 15;
            u32x4 x = (u32x4){0u, 0u, 0u, 0u};
            if (c > 0) x = *(const u32x4*)(s0 + v * 128 + ch * 8);
            *(u32x4*)(sS0 + v * 136 + ch * 8) = x;
        }
    }
    __syncthreads();
    const int rb = wid >> 1, ch2 = wid & 1, t = rb * 16 + fr;
    {
        f32x4 at[1][2]; accz(at);
        mma_lds<1, 2, 4>(at, sQt + rb * 16 * 136, 136, sKt + ch2 * 32 * 136, 136);
#pragma unroll
        for (int n = 0; n < 2; ++n) {
            const int s0i = ch2 * 32 + n * 16 + fq * 4;
            f32x4 m;
#pragma unroll
            for (int x = 0; x < 4; ++x) m[x] = (s0i + x <= t) ? at[0][n][x] : 0.f;
            st_bf4(sAtt + t * 72 + s0i, m);
        }
    }
    f32x4 ao[1][4]; accz(ao);
    mma_lds<1, 4, 4>(ao, sQt + rb * 16 * 136, 136, sS0 + ch2 * 64 * 136, 136);
    __syncthreads();
    mma_lds<1, 4, 2>(ao, sAtt + rb * 16 * 72, 72, sVT + ch2 * 64 * 72, 72);
#pragma unroll
    for (int n = 0; n < 4; ++n) *(f32x4*)(sO + t * 132 + ch2 * 64 + n * 16 + fq * 4) = ao[0][n];
    __syncthreads();
    {
        const int te = tid >> 3, v0 = (tid & 7) * 16;
        f32x4 o[4]; float ss = 0.f;
#pragma unroll
        for (int k = 0; k < 4; ++k) { o[k] = *(const f32x4*)(sO + te * 132 + v0 + k * 4); ss += o[k][0] * o[k][0] + o[k][1] * o[k][1] + o[k][2] * o[k][2] + o[k][3] * o[k][3]; }
        ss += __shfl_xor(ss, 1, 64); ss += __shfl_xor(ss, 2, 64); ss += __shfl_xor(ss, 4, 64);
        const float rstd = rsqrtf(ss * (1.f / 128.f) + RMS_EPS);
        bf16_t* row = phg + (size_t)(t0 + te) * NHG + h * 128 + v0;
        const float* nw = p.in[16] + h * 128 + v0;
#pragma unroll
        for (int k = 0; k < 4; ++k) {
            const f32x4 og = ld_bf4(row + H_OG + k * 4), w4 = *(const f32x4*)(nw + k * 4);
            f32x4 r;
#pragma unroll
            for (int x = 0; x < 4; ++x) r[x] = o[k][x] * rstd * w4[x] * sigm(og[x]);
            st_bf4(row + H_I + k * 4, r);
        }
    }
}


DEVI void rwkv_r1(const Params& p, unsigned char* smem, int unit) {
    const int tid = threadIdx.x, wid = tid >> 6, lane = tid & 63, fr = lane & 15, fq = lane >> 4;
    const int c = unit & 63, bh = unit >> 6, h = bh & 7, b = bh >> 3, t0 = b * SEQ + c * 64, cb = h * 64;
    bf16_t* aR = prep_arr(p, 0); bf16_t* aK = prep_arr(p, 1); bf16_t* aV = prep_arr(p, 2); bf16_t* aW = prep_arr(p, 3);
    bf16_t* aKK = prep_arr(p, 4); bf16_t* aA = prep_arr(p, 5);
    float* sAab = (float*)smem; float* sP = sAab + 64 * 64; float* sWC = sP + 64 * 64;
    bf16_t* sAt = (bf16_t*)(sWC + 64); bf16_t* sBt = sAt + 64 * 72; bf16_t* sKt = sBt + 64 * 72; bf16_t* sBtT = sKt + 64 * 72; bf16_t* sKtT = sBtT + 64 * 72;
    bf16_t* sVT = sKtT + 64 * 72; bf16_t* sAak = sVT + 64 * 72;
    bf16_t* sLW = (bf16_t*)sAab; bf16_t* sR = (bf16_t*)sP;
    bf16_t* sX1T = sAt; bf16_t* sUT = sAak;
    __syncthreads();
    {
        const int t = tid >> 3, ch = tid & 7; const size_t o = (size_t)(t0 + t) * 512 + cb + ch * 8; const int lo = t * 72 + ch * 8;
        *(u32x4*)(sAt + lo) = *(const u32x4*)(aKK + o);
        *(u32x4*)(sBt + lo) = *(const u32x4*)(aA + o);
        *(u32x4*)(sKt + lo) = *(const u32x4*)(aK + o);
        *(u32x4*)(sLW + lo) = *(const u32x4*)(aW + o);
        *(u32x4*)(sR + lo) = *(const u32x4*)(aR + o);
        const u32x4 vv = *(const u32x4*)(aV + o);
#pragma unroll
        for (int k = 0; k < 4; ++k) { sVT[(ch * 8 + 2 * k) * 72 + t] = (bf16_t)(vv[k] & 0xffffu); sVT[(ch * 8 + 2 * k + 1) * 72 + t] = (bf16_t)(vv[k] >> 16); }
    }
    __syncthreads();
    if (tid < 64) {
        const int j = tid; float L = 0.f;
        for (int t = 0; t < 64; ++t) {
            const float lw = bf2f(sLW[t * 72 + j]), kkv = bf2f(sAt[t * 72 + j]), av = bf2f(sBt[t * 72 + j]), kp = bf2f(sKt[t * 72 + j]), rv = bf2f(sR[t * 72 + j]);
            const float eprev = __expf(L);
            L += lw;
            const float ecur = __expf(L), einv = __expf(-L);
            const bf16_t at = f2bf(-kkv * eprev), bt = f2bf(kkv * av * einv), kt = f2bf(kp * einv), rt = f2bf(rv * ecur);
            sAt[t * 72 + j] = at; sBt[t * 72 + j] = bt; sKt[t * 72 + j] = kt; sBtT[j * 72 + t] = bt; sKtT[j * 72 + t] = kt;
            const size_t o = (size_t)(t0 + t) * 512 + cb + j;
            aR[o] = rt; aK[o] = kt; aKK[o] = bt;
        }
        sWC[j] = __expf(L);
    }
    __syncthreads();
    const int rb = wid >> 1, ch2 = wid & 1, tr = rb * 16 + fr;
    {
        f32x4 ab[1][2], ak[1][2]; accz(ab); accz(ak);
        mma_lds<1, 2, 2>(ab, sAt + rb * 16 * 72, 72, sBt + ch2 * 32 * 72, 72);
        mma_lds<1, 2, 2>(ak, sAt + rb * 16 * 72, 72, sKt + ch2 * 32 * 72, 72);
#pragma unroll
        for (int n = 0; n < 2; ++n) {
            const int s0 = ch2 * 32 + n * 16 + fq * 4;
            f32x4 m1, m2;
#pragma unroll
            for (int x = 0; x < 4; ++x) { const bool keep = (s0 + x) < tr; m1[x] = keep ? ab[0][n][x] : 0.f; m2[x] = keep ? ak[0][n][x] : 0.f; }
            *(f32x4*)(sAab + tr * 64 + s0) = m1;
            st_bf4(sAak + tr * 72 + s0, m2);
        }
    }
    __syncthreads();
    {
        f32x4 pp[1][2]; accz(pp);
        mma_lds<1, 2, 2>(pp, sAak + rb * 16 * 72, 72, sVT + ch2 * 32 * 72, 72);
#pragma unroll
        for (int n = 0; n < 2; ++n) *(f32x4*)(sP + tr * 64 + ch2 * 32 + n * 16 + fq * 4) = pp[0][n];
    }
    __syncthreads();
    f32x2 x2[32];
    if (tid < 128) {
        if (tid < 64) {
#pragma unroll
            for (int t = 0; t < 64; ++t) x2[t >> 1][t & 1] = bf2f(sAt[t * 72 + tid]);
        } else {
#pragma unroll
            for (int t = 0; t < 64; ++t) x2[t >> 1][t & 1] = sP[t * 64 + tid - 64];
        }
    }
    __syncthreads();
    if (tid < 128) {
#pragma unroll
        for (int t = 1; t < 64; ++t) {
            if (t >= 4) asm volatile("" : "+v"(x2[(t - 4) >> 1]) :: "memory"); else asm volatile("" ::: "memory");
            const f32x4* arow = (const f32x4*)(sAab + t * 64);
            f32x2 a0 = (f32x2){0.f, 0.f}, a1 = (f32x2){0.f, 0.f};
#pragma unroll
            for (int s4 = 0; s4 < (t + 3) / 4; ++s4) {
                const f32x4 a4 = arow[s4];
                a0 += (f32x2){a4[0], a4[1]} * x2[2 * s4];
                a1 += (f32x2){a4[2], a4[3]} * x2[2 * s4 + 1];
            }
            const f32x2 sm = a0 + a1;
            x2[t >> 1][t & 1] += sm[0] + sm[1];
        }
        const int col = tid & 63;
        bf16_t* srow = (tid < 64 ? sX1T : sUT) + col * 72;
        bf16_t* gdst = (tid < 64 ? aA : aW) + (size_t)t0 * 512 + cb + col;
#pragma unroll
        for (int t = 0; t < 64; t += 2) {
            const unsigned pk = pack2(x2[t >> 1][0], x2[t >> 1][1]);
            *(unsigned*)(srow + t) = pk;
            gdst[(size_t)t * 512] = (bf16_t)(pk & 0xffffu); gdst[(size_t)(t + 1) * 512] = (bf16_t)(pk >> 16);
        }
    }
    __syncthreads();
    {
        float* Mg = (float*)(p.ws + WS_PRW) + (size_t)unit * 4096; float* Ng = (float*)(p.ws + WS_XB) + (size_t)unit * 4096;
        f32x4 am[1][2]; accz(am);
        mma_lds<1, 2, 2>(am, sBtT + rb * 16 * 72, 72, sX1T + ch2 * 32 * 72, 72);
        const float wcj = sWC[tr];
#pragma unroll
        for (int n = 0; n < 2; ++n) {
            const int j0 = ch2 * 32 + n * 16 + fq * 4;
            f32x4 o;
#pragma unroll
            for (int xx = 0; xx < 4; ++xx) o[xx] = (am[0][n][xx] + ((j0 + xx) == tr ? 1.f : 0.f)) * wcj;
            *(f32x4*)(Mg + tr * 64 + j0) = o;
        }
        f32x4 an[1][2]; accz(an);
        mma_lds<1, 2, 2>(an, sUT + rb * 16 * 72, 72, sBtT + ch2 * 32 * 72, 72);
        mma_lds<1, 2, 2>(an, sVT + rb * 16 * 72, 72, sKtT + ch2 * 32 * 72, 72);
#pragma unroll
        for (int n = 0; n < 2; ++n) {
            const int j0 = ch2 * 32 + n * 16 + fq * 4;
            const f32x4 w4 = *(const f32x4*)(sWC + j0);
            *(f32x4*)(Ng + tr * 64 + j0) = an[0][n] * w4;
        }
    }
}
DEVI void rwkv_r2(const Params& p, int bh, int ib) {
    const int lane = threadIdx.x & 63, q = lane >> 4, cl = lane & 15;
    const float* Mb = (const float*)(p.ws + WS_PRW) + (size_t)bh * 64 * 4096; float* Nb = (float*)(p.ws + WS_XB) + (size_t)bh * 64 * 4096;
    f32x4 z[4];
#pragma unroll
    for (int kb = 0; kb < 4; ++kb) z[kb] = (f32x4){0.f, 0.f, 0.f, 0.f};
    f32x4 mr[4][4], nr[4];
#pragma unroll
    for (int jb = 0; jb < 4; ++jb) {
#pragma unroll
        for (int kb = 0; kb < 4; ++kb) mr[jb][kb] = *(const f32x4*)(Mb + (jb * 16 + cl) * 64 + kb * 16 + 4 * q);
        nr[jb] = *(const f32x4*)(Nb + (ib * 16 + cl) * 64 + jb * 16 + 4 * q);
    }
    for (int c = 0; c < 64; ++c) {
        f32x4 mn[4][4], nn[4];
        const int cn = c < 63 ? c + 1 : 63;
        const float* Mu = Mb + (size_t)cn * 4096; const float* Nu = Nb + (size_t)cn * 4096;
#pragma unroll
        for (int jb = 0; jb < 4; ++jb) {
#pragma unroll
            for (int kb = 0; kb < 4; ++kb) mn[jb][kb] = *(const f32x4*)(Mu + (jb * 16 + cl) * 64 + kb * 16 + 4 * q);
            nn[jb] = *(const f32x4*)(Nu + (ib * 16 + cl) * 64 + jb * 16 + 4 * q);
        }
        f32x4 acc[4];
#pragma unroll
        for (int jb = 0; jb < 4; ++jb) {
            acc[jb] = nr[jb];
#pragma unroll
            for (int kb = 0; kb < 4; ++kb)
#pragma unroll
                for (int ks = 0; ks < 4; ++ks) acc[jb] = __builtin_amdgcn_mfma_f32_16x16x4f32(mr[jb][kb][ks], z[kb][ks], acc[jb], 0, 0, 0);
        }
        float* Zo = Nb + (size_t)c * 4096;
#pragma unroll
        for (int jb = 0; jb < 4; ++jb) { z[jb] = acc[jb]; *(f32x4*)(Zo + (ib * 16 + cl) * 64 + jb * 16 + 4 * q) = acc[jb]; }
#pragma unroll
        for (int jb = 0; jb < 4; ++jb) {
#pragma unroll
            for (int kb = 0; kb < 4; ++kb) mr[jb][kb] = mn[jb][kb];
            nr[jb] = nn[jb];
        }
    }
}
DEVI void rwkv_r3(const Params& p, unsigned char* smem, int unit) {
    const int tid = threadIdx.x, wid = tid >> 6, lane = tid & 63, fr = lane & 15, fq = lane >> 4;
    const int c = unit & 63, bh = unit >> 6, h = bh & 7, b = bh >> 3, t0 = b * SEQ + c * 64, cb = h * 64;
    const bf16_t* aR = prep_arr(p, 0); const bf16_t* aK = prep_arr(p, 1); bf16_t* aV = prep_arr(p, 2); const bf16_t* aU = prep_arr(p, 3);
    const bf16_t* aB = prep_arr(p, 4); const bf16_t* aX = prep_arr(p, 5); const bf16_t* aG = prep_arr(p, 6);
    bf16_t* sRt = (bf16_t*)smem; bf16_t* sBt = sRt + 64 * 72; bf16_t* sKt = sBt + 64 * 72; bf16_t* sX1 = sKt + 64 * 72; bf16_t* sVT = sX1 + 64 * 72;
    bf16_t* sZ0 = sVT + 64 * 72; bf16_t* sUT = sZ0 + 64 * 72; bf16_t* sArb = sUT + 64 * 72; bf16_t* sArk = sArb + 64 * 72; float* sY = (float*)(sArk + 64 * 72);
    __syncthreads();
    {
        const int t = tid >> 3, ch = tid & 7; const size_t o = (size_t)(t0 + t) * 512 + cb + ch * 8; const int lo = t * 72 + ch * 8;
        *(u32x4*)(sRt + lo) = *(const u32x4*)(aR + o);
        *(u32x4*)(sBt + lo) = *(const u32x4*)(aB + o);
        *(u32x4*)(sKt + lo) = *(const u32x4*)(aK + o);
        *(u32x4*)(sX1 + lo) = *(const u32x4*)(aX + o);
        const u32x4 vv = *(const u32x4*)(aV + o);
#pragma unroll
        for (int k = 0; k < 4; ++k) { sVT[(ch * 8 + 2 * k) * 72 + t] = (bf16_t)(vv[k] & 0xffffu); sVT[(ch * 8 + 2 * k + 1) * 72 + t] = (bf16_t)(vv[k] >> 16); }
        u32x4 zz = (u32x4){0u, 0u, 0u, 0u};
        if (c > 0) {
            const float* Z = (const float*)(p.ws + WS_XB) + (size_t)(unit - 1) * 4096 + t * 64 + ch * 8;
            const f32x4 z0 = *(const f32x4*)Z, z1 = *(const f32x4*)(Z + 4);
            zz[0] = pack2(z0[0], z0[1]); zz[1] = pack2(z0[2], z0[3]); zz[2] = pack2(z1[0], z1[1]); zz[3] = pack2(z1[2], z1[3]);
        }
        *(u32x4*)(sZ0 + lo) = zz;
    }
    __syncthreads();
    const int rb = wid >> 1, ch2 = wid & 1, tr = rb * 16 + fr;
    f32x4 ay[1][2]; accz(ay);
    {
        f32x4 au[1][2]; accz(au);
        mma_lds<1, 2, 2>(au, sX1 + rb * 16 * 72, 72, sZ0 + ch2 * 32 * 72, 72);
#pragma unroll
        for (int n = 0; n < 2; ++n) {
            const int i0 = ch2 * 32 + n * 16 + fq * 4;
            const f32x4 ul = ld_bf4(aU + (size_t)(t0 + tr) * 512 + cb + i0);
#pragma unroll
            for (int x = 0; x < 4; ++x) sUT[(i0 + x) * 72 + tr] = f2bf(au[0][n][x] + ul[x]);
        }
        f32x4 a1[1][2], a2[1][2]; accz(a1); accz(a2);
        mma_lds<1, 2, 2>(a1, sRt + rb * 16 * 72, 72, sBt + ch2 * 32 * 72, 72);
        mma_lds<1, 2, 2>(a2, sRt + rb * 16 * 72, 72, sKt + ch2 * 32 * 72, 72);
#pragma unroll
        for (int n = 0; n < 2; ++n) {
            const int s0 = ch2 * 32 + n * 16 + fq * 4;
            f32x4 m1, m2;
#pragma unroll
            for (int x = 0; x < 4; ++x) { const bool keep = (s0 + x) <= tr; m1[x] = keep ? a1[0][n][x] : 0.f; m2[x] = keep ? a2[0][n][x] : 0.f; }
            st_bf4(sArb + tr * 72 + s0, m1); st_bf4(sArk + tr * 72 + s0, m2);
        }
        mma_lds<1, 2, 2>(ay, sRt + rb * 16 * 72, 72, sZ0 + ch2 * 32 * 72, 72);
    }
    __syncthreads();
    mma_lds<1, 2, 2>(ay, sArb + rb * 16 * 72, 72, sUT + ch2 * 32 * 72, 72);
    mma_lds<1, 2, 2>(ay, sArk + rb * 16 * 72, 72, sVT + ch2 * 32 * 72, 72);
#pragma unroll
    for (int n = 0; n < 2; ++n) *(f32x4*)(sY + tr * 68 + ch2 * 32 + n * 16 + fq * 4) = ay[0][n];
    __syncthreads();
    {
        const int te = tid >> 3, i0 = (tid & 7) * 8;
        float y[8], s = 0.f, bon = 0.f;
        const float* rk = p.in[11] + cb + i0;
#pragma unroll
        for (int k = 0; k < 8; ++k) { y[k] = sY[te * 68 + i0 + k]; s += y[k]; bon += bf2f(sRt[te * 72 + i0 + k]) * bf2f(sKt[te * 72 + i0 + k]) * rk[k]; }
        s += __shfl_xor(s, 1, 64); s += __shfl_xor(s, 2, 64); s += __shfl_xor(s, 4, 64);
        bon += __shfl_xor(bon, 1, 64); bon += __shfl_xor(bon, 2, 64); bon += __shfl_xor(bon, 4, 64);
        const float mean = s * (1.f / 64.f);
        float s2 = 0.f;
#pragma unroll
        for (int k = 0; k < 8; ++k) { const float d = y[k] - mean; s2 += d * d; }
        s2 += __shfl_xor(s2, 1, 64); s2 += __shfl_xor(s2, 2, 64); s2 += __shfl_xor(s2, 4, 64);
        const float rstd = rsqrtf(s2 * (1.f / 64.f) + GN_EPS);
        const size_t o = (size_t)(t0 + te) * 512 + cb + i0;
        const u32x4 gg = *(const u32x4*)(aG + o);
        const float* gw = p.in[12] + cb + i0; const float* gb = p.in[13] + cb + i0;
        float r[8];
#pragma unroll
        for (int k = 0; k < 8; ++k) {
            const float g = (k & 1) ? __uint_as_float(gg[k >> 1] & 0xffff0000u) : __uint_as_float(gg[k >> 1] << 16);
            const float v = bf2f(sVT[(i0 + k) * 72 + te]);
            r[k] = ((y[k] - mean) * rstd * gw[k] + gb[k] + bon * v) * g;
        }
        u32x4 ov; ov[0] = pack2(r[0], r[1]); ov[1] = pack2(r[2], r[3]); ov[2] = pack2(r[4], r[5]); ov[3] = pack2(r[6], r[7]);
        *(u32x4*)(aV + o) = ov;
    }
}

DEVI void phase_scans_naive(const Params& p, unsigned char* smem) {
    if (blockIdx.x < 4) scan_rwkv_naive(p, smem, blockIdx.x);
    else if (blockIdx.x < 8) scan_hgrn_naive(p, smem, blockIdx.x - 4);
}
DEVI void phase_3a(const Params& p, unsigned char* smem) {
    for (int u = blockIdx.x; u < 3072; u += gridDim.x) { if (u < 2048) rwkv_r1(p, smem, u); else hgrn_h1(p, smem, u - 2048); }
}
DEVI void phase_3b(const Params& p, unsigned char* smem) {
    if (blockIdx.x < 32) { if (threadIdx.x < 256) rwkv_r2(p, blockIdx.x, threadIdx.x >> 6); }
    else if (blockIdx.x < 96) hgrn_h2(p, (blockIdx.x - 32) * 512 + threadIdx.x);
}
DEVI void phase_3c(const Params& p, unsigned char* smem) {
    for (int u = blockIdx.x; u < 3072; u += gridDim.x) { if (u < 2048) rwkv_r3(p, smem, u); else hgrn_h3(p, smem, u - 2048); }
}

DEVI void phase_merge(const Params& p, unsigned char* smem) {
    const bf16_t* ya = prep_arr(p, 2); const bf16_t* yb = (const bf16_t*)(p.ws + WS_PHG) + H_I;
    const bf16_t* WaT = (const bf16_t*)(p.ws + WS_WAT); const bf16_t* WbT = (const bf16_t*)(p.ws + WS_WBT);
    const bf16_t* pgt = (const bf16_t*)(p.ws + WS_PGT);
    bf16_t* merged = (bf16_t*)(p.ws + WS_MERGED);
    for (int t = blockIdx.x; t < 128 * 8; t += gridDim.x) {
        const int tm = t >> 3, tn = t & 7;
        f32x4 a1[2][4], a2[2][4]; acc_zero(a1); acc_zero(a2);
        gemm_accum(a1, ya, 512, IdRows{tm * 128}, WaT + (size_t)tn * 128 * 512, 512, 512, (bf16_t*)smem);
        gemm_accum(a2, yb, NHG, IdRows{tm * 128}, WbT + (size_t)tn * 128 * 512, 512, 512, (bf16_t*)smem);
        epi2(a1, a2, [&](int r, int c, f32x4 v1, f32x4 v2) {
            const size_t row = tm * 128 + r; const int col = tn * 128 + c;
            const f32x4 ga = ld_bf4(pgt + row * NHG + col), gb = ld_bf4(pgt + row * NHG + 1024 + col);
            f32x4 o;
#pragma unroll
            for (int q = 0; q < 4; ++q) o[q] = sigm(ga[q]) * v1[q] + sigm(gb[q]) * v2[q];
            st_bf4(merged + row * 1024 + col, o);
        });
    }
}

DEVI void phase_wo(const Params& p, unsigned char* smem) {
    const bf16_t* merged = (const bf16_t*)(p.ws + WS_MERGED); const bf16_t* WoT = (const bf16_t*)(p.ws + WS_WOT);
    const float* x = p.in[0]; float* x1pre = p.out;
    constexpr int T_G = 64 * 8, T_W = 4096;
    for (int t = blockIdx.x; t < T_G + 3 * T_W; t += gridDim.x) {
        if (t < T_G) {
            const int tm = t >> 3, tn = t & 7;
            f32x4 acc[4][4]; acc_zero(acc);
            gemm_accum(acc, merged, 1024, IdRows{tm * 256}, WoT + (size_t)tn * 128 * 1024, 1024, 1024, (bf16_t*)smem);
            epi1(acc, [&](int r, int c, f32x4 v) {
                const size_t o = (size_t)(tm * 256 + r) * 1024 + tn * 128 + c;
                const f32x4 xv = *(const f32x4*)(x + o);
                *(f32x4*)(x1pre + o) = xv * ALPHA + v;
            });
        } else {
            int u = t - T_G; const int which = u / T_W; u -= which * T_W;
            const int e = u >> 7, tt = u & 127;
            if (which == 0) transpose_tile(p.in[25] + (size_t)e * 1024 * 512, (bf16_t*)(p.ws + WS_W1T) + (size_t)e * 512 * 1024, 1024, 512, tt >> 3, tt & 7, (float*)smem);
            else if (which == 1) transpose_tile(p.in[26] + (size_t)e * 1024 * 512, (bf16_t*)(p.ws + WS_W3T) + (size_t)e * 512 * 1024, 1024, 512, tt >> 3, tt & 7, (float*)smem);
            else transpose_tile(p.in[27] + (size_t)e * 512 * 1024, (bf16_t*)(p.ws + WS_W2T) + (size_t)e * 1024 * 512, 512, 1024, tt >> 4, tt & 15, (float*)smem);
        }
    }
}

DEVI void phase_ln1_route(const Params& p, unsigned char* smem) {
    const float* x1pre = p.out; float* x1 = (float*)(p.ws + WS_X1); bf16_t* x1b = (bf16_t*)(p.ws + WS_X1B);
    const float* g = p.in[19]; const float* bta = p.in[20];
    const float* wg = p.in[21]; const float* bg = p.in[22]; const float* we = p.in[23]; const float* be = p.in[24];
    int* cnt = (int*)(p.ws + WS_CNT); int* slot = (int*)(p.ws + WS_SLOT); float* tw = (float*)(p.ws + WS_TW); int* list = (int*)(p.ws + WS_LIST);
    const int lane = threadIdx.x & 63, wid = threadIdx.x >> 6;
    for (int tk = blockIdx.x * 8 + wid; tk < NTOK; tk += gridDim.x * 8) {
        f32x4 xv[4]; float s = 0.f;
#pragma unroll
        for (int i = 0; i < 4; ++i) { xv[i] = *(const f32x4*)(x1pre + (size_t)tk * 1024 + i * 256 + lane * 4); s += xv[i][0] + xv[i][1] + xv[i][2] + xv[i][3]; }
        const float mean = wave_sum(s) * (1.f / 1024.f);
        float s2 = 0.f;
#pragma unroll
        for (int i = 0; i < 4; ++i)
#pragma unroll
            for (int q = 0; q < 4; ++q) { const float d = xv[i][q] - mean; s2 += d * d; }
        const float rstd = rsqrtf(wave_sum(s2) * (1.f / 1024.f) + LN_EPS);
        float lg[36];
#pragma unroll
        for (int o = 0; o < 36; ++o) lg[o] = 0.f;
        float* sy = (float*)smem + wid * 1024;
#pragma unroll
        for (int i = 0; i < 4; ++i) {
            const int col = i * 256 + lane * 4;
            const f32x4 g4 = *(const f32x4*)(g + col), b4 = *(const f32x4*)(bta + col);
            f32x4 y;
#pragma unroll
            for (int q = 0; q < 4; ++q) { y[q] = (xv[i][q] - mean) * rstd * g4[q] + b4[q]; sy[(i * 4 + q) * 64 + lane] = y[q]; }
            *(f32x4*)(x1 + (size_t)tk * 1024 + col) = y;
            st_bf4(x1b + (size_t)tk * 1024 + col, y);
        }
#pragma unroll 1
        for (int cc = 0; cc < 16; ++cc) {
            const float yv = sy[cc * 64 + lane];
            const int col = (cc >> 2) * 256 + lane * 4 + (cc & 3);
            const f32x4 w4 = *(const f32x4*)(wg + (size_t)col * 4);
#pragma unroll
            for (int o = 0; o < 4; ++o) lg[o] += yv * w4[o];
#pragma unroll
            for (int u = 0; u < 8; ++u) {
                const f32x4 e4 = *(const f32x4*)(we + (size_t)col * 32 + u * 4);
#pragma unroll
                for (int o = 0; o < 4; ++o) lg[4 + u * 4 + o] += yv * e4[o];
            }
        }
#pragma unroll
        for (int o = 0; o < 36; ++o) lg[o] = wave_sum(lg[o]);
        float gl[4];
#pragma unroll
        for (int q = 0; q < 4; ++q) gl[q] = lg[q] + bg[q];
        int gs = 0; float gm = gl[0];
#pragma unroll
        for (int q = 1; q < 4; ++q) if (gl[q] > gm) { gm = gl[q]; gs = q; }
        float gden = 0.f;
#pragma unroll
        for (int q = 0; q < 4; ++q) gden += __expf(gl[q] - gm);
        const float pg = 1.f / gden;
        float el[8];
#pragma unroll
        for (int j = 0; j < 8; ++j) {
            const float v0 = lg[4 + j] + be[j], v1 = lg[12 + j] + be[8 + j], v2 = lg[20 + j] + be[16 + j], v3 = lg[28 + j] + be[24 + j];
            el[j] = gs == 0 ? v0 : (gs == 1 ? v1 : (gs == 2 ? v2 : v3));
        }
        int i1 = 0; float m1 = el[0];
#pragma unroll
        for (int j = 1; j < 8; ++j) if (el[j] > m1) { m1 = el[j]; i1 = j; }
        int i2 = -1; float m2 = -3.0e38f;
#pragma unroll
        for (int j = 0; j < 8; ++j) if (j != i1 && el[j] > m2) { m2 = el[j]; i2 = j; }
        const float ex = __expf(m2 - m1);
        const float p1 = 1.f / (1.f + ex), p2 = ex / (1.f + ex);
        if (lane == 0) {
            const int e1 = gs * 8 + i1, e2 = gs * 8 + i2;
            const int pos1 = atomicAdd(cnt + e1, 1), pos2 = atomicAdd(cnt + e2, 1);
            list[(size_t)e1 * NTOK + pos1] = tk; list[(size_t)e2 * NTOK + pos2] = tk;
            slot[tk * 2] = (e1 << 16) | pos1; slot[tk * 2 + 1] = (e2 << 16) | pos2;
            tw[tk * 2] = pg * p1; tw[tk * 2 + 1] = pg * p2;
        }
    }
}

DEVI void moe_find(const int* cnt, int rti, int& e, int& rt, int& rowbase, int& nrows) {
    int rt0 = 0; rowbase = 0; e = 0;
    for (; e < NEXP - 1; ++e) { const int nt = (cnt[e] + 255) >> 8; if (rti < rt0 + nt) break; rt0 += nt; rowbase += nt * 256; }
    rt = rti - rt0; nrows = cnt[e] - rt * 256; nrows = nrows > 256 ? 256 : nrows;
}
DEVI int moe_total_rt(const int* cnt) { int s = 0; for (int e = 0; e < NEXP; ++e) s += (cnt[e] + 255) >> 8; return s; }
DEVI void phase_moe1(const Params& p, unsigned char* smem) {
    const int* cnt = (const int*)(p.ws + WS_CNT); const int* list = (const int*)(p.ws + WS_LIST);
    const bf16_t* x1b = (const bf16_t*)(p.ws + WS_X1B);
    const bf16_t* W1T = (const bf16_t*)(p.ws + WS_W1T); const bf16_t* W3T = (const bf16_t*)(p.ws + WS_W3T);
    bf16_t* hbuf = (bf16_t*)p.out;
    const int total = moe_total_rt(cnt) * 8;
    for (int t = blockIdx.x; t < total; t += gridDim.x) {
        const int rti = t >> 3, ct = t & 3, half = (t >> 2) & 1; int e, rt, rowbase, nrows; moe_find(cnt, rti, e, rt, rowbase, nrows);
        nrows -= half * 128; if (nrows <= 0) continue;
        rowbase += half * 128;
        f32x4 a1[2][4], a2[2][4]; acc_zero(a1); acc_zero(a2);
        const GatherRows gr{list + (size_t)e * NTOK + rt * 256 + half * 128, nrows > 128 ? 128 : nrows};
        gemm_accum(a1, x1b, 1024, gr, W1T + ((size_t)e * 512 + ct * 128) * 1024, 1024, 1024, (bf16_t*)smem);
        gemm_accum(a2, x1b, 1024, gr, W3T + ((size_t)e * 512 + ct * 128) * 1024, 1024, 1024, (bf16_t*)smem);
        epi2(a1, a2, [&](int r, int c, f32x4 v1, f32x4 v2) {
            f32x4 o;
#pragma unroll
            for (int q = 0; q < 4; ++q) o[q] = v1[q] * sigm(v1[q]) * v2[q];
            st_bf4(hbuf + (size_t)(rowbase + rt * 256 + r) * 512 + ct * 128 + c, o);
        });
    }
}
DEVI void phase_moe2(const Params& p, unsigned char* smem) {
    const int* cnt = (const int*)(p.ws + WS_CNT);
    const bf16_t* hbuf = (const bf16_t*)p.out; const bf16_t* W2T = (const bf16_t*)(p.ws + WS_W2T);
    bf16_t* y = (bf16_t*)(p.ws + WS_Y);
    const int total = moe_total_rt(cnt) * 8;
    for (int t = blockIdx.x; t < total; t += gridDim.x) {
        const int rti = t >> 3, ct = t & 7; int e, rt, rowbase, nrows; moe_find(cnt, rti, e, rt, rowbase, nrows);
        f32x4 acc[4][4]; acc_zero(acc);
        gemm_accum(acc, hbuf, 512, IdRows{rowbase + rt * 256}, W2T + ((size_t)e * 1024 + ct * 128) * 512, 512, 512, (bf16_t*)smem);
        epi1(acc, [&](int r, int c, f32x4 v) { st_bf4(y + (size_t)(rowbase + rt * 256 + r) * 1024 + ct * 128 + c, v); });
    }
}

DEVI void phase_ln2(const Params& p, unsigned char* smem) {
    float* x1 = (float*)(p.ws + WS_X1); bf16_t* x2b = (bf16_t*)(p.ws + WS_X1B);
    const bf16_t* y = (const bf16_t*)(p.ws + WS_Y);
    const int* cnt = (const int*)(p.ws + WS_CNT); const int* slot = (const int*)(p.ws + WS_SLOT); const float* tw = (const float*)(p.ws + WS_TW);
    const float* g = p.in[28]; const float* bta = p.in[29];
    const int lane = threadIdx.x & 63, wid = threadIdx.x >> 6;
    for (int tk = blockIdx.x * 8 + wid; tk < NTOK; tk += gridDim.x * 8) {
        const int s0 = slot[tk * 2], s1 = slot[tk * 2 + 1]; const float w0 = tw[tk * 2], w1 = tw[tk * 2 + 1];
        const int e0 = s0 >> 16, e1 = s1 >> 16;
        int rb0 = 0, rb1 = 0;
        for (int e = 0; e < NEXP; ++e) { const int pd = ((cnt[e] + 255) >> 8) << 8; if (e < e0) rb0 += pd; if (e < e1) rb1 += pd; }
        const size_t r0 = (size_t)(rb0 + (s0 & 0xffff)), r1 = (size_t)(rb1 + (s1 & 0xffff));
        f32x4 xv[4]; float s = 0.f;
#pragma unroll
        for (int i = 0; i < 4; ++i) {
            const int col = i * 256 + lane * 4;
            const f32x4 a = *(const f32x4*)(x1 + (size_t)tk * 1024 + col);
            const f32x4 y0 = ld_bf4(y + r0 * 1024 + col), y1 = ld_bf4(y + r1 * 1024 + col);
            xv[i] = a * ALPHA + y0 * w0 + y1 * w1;
            s += xv[i][0] + xv[i][1] + xv[i][2] + xv[i][3];
        }
        const float mean = wave_sum(s) * (1.f / 1024.f);
        float s2 = 0.f;
#pragma unroll
        for (int i = 0; i < 4; ++i)
#pragma unroll
            for (int q = 0; q < 4; ++q) { const float d = xv[i][q] - mean; s2 += d * d; }
        const float rstd = rsqrtf(wave_sum(s2) * (1.f / 1024.f) + LN_EPS);
#pragma unroll
        for (int i = 0; i < 4; ++i) {
            const int col = i * 256 + lane * 4;
            const f32x4 g4 = *(const f32x4*)(g + col), b4 = *(const f32x4*)(bta + col);
            f32x4 o;
#pragma unroll
            for (int q = 0; q < 4; ++q) o[q] = (xv[i][q] - mean) * rstd * g4[q] + b4[q];
            *(f32x4*)(x1 + (size_t)tk * 1024 + col) = o;
            st_bf4(x2b + (size_t)tk * 1024 + col, o);
        }
    }
}

DEVI void phase_final(const Params& p, unsigned char* smem) {
    const float* x2 = (const float*)(p.ws + WS_X1); const bf16_t* x2b = (const bf16_t*)(p.ws + WS_X1B); const bf16_t* pb = (const bf16_t*)(p.ws + WS_PB);
    const bf16_t* WpgT = (const bf16_t*)(p.ws + WS_WPGT); const bf16_t* WpeT = (const bf16_t*)(p.ws + WS_WPET);
    float* out = p.out;
    for (int t = blockIdx.x; t < 128 * 8; t += gridDim.x) {
        const int tm = t >> 3, tn = t & 7;
        f32x4 a1[2][4], a2[2][4]; acc_zero(a1); acc_zero(a2);
        gemm_accum(a1, x2b, 1024, IdRows{tm * 128}, WpgT + (size_t)tn * 128 * 1024, 1024, 1024, (bf16_t*)smem);
        gemm_accum(a2, pb, 256, IdRows{tm * 128}, WpeT + (size_t)tn * 128 * 256, 256, 256, (bf16_t*)smem);
        epi2(a1, a2, [&](int r, int c, f32x4 v1, f32x4 v2) {
            const size_t o = (size_t)(tm * 128 + r) * 1024 + tn * 128 + c;
            const f32x4 xv = *(const f32x4*)(x2 + o);
            f32x4 res;
#pragma unroll
            for (int q = 0; q < 4; ++q) res[q] = xv[q] + sigm(v1[q]) * v2[q];
            *(f32x4*)(out + o) = res;
        });
    }
}


#define XB_TMO      128
#define XB_XCNT(j)  (256  + 64 * (j))
#define XB_XSUB(j)  (1280 + 64 * (j))
#define XB_XGEN(j)  (2304 + 64 * (j))
#define XB_TOP      3328
#define XB_TOPGEN   3392
#define XCD_BAR_WORDS 3456
#define XB_SPIN_CAP (1u << 22)
#define LAS __attribute__((address_space(3)))
DEVI unsigned xb_ld(unsigned* p) { return __hip_atomic_load(p, __ATOMIC_RELAXED, __HIP_MEMORY_SCOPE_AGENT); }
DEVI unsigned xb_add(unsigned* p, unsigned v) { return __hip_atomic_fetch_add(p, v, __ATOMIC_RELAXED, __HIP_MEMORY_SCOPE_AGENT); }
DEVI unsigned xb_xcc_id() { return (unsigned)__builtin_amdgcn_s_getreg((3 << 11) | 20) & 0xFu; }
#define XB_SPIN(cond, bar) do { unsigned _sp = 0; while (cond) { __builtin_amdgcn_s_sleep(1); \
    if ((++_sp & 255u) == 0u) { if (xb_ld(&(bar)[XB_TMO])) break; if (_sp > XB_SPIN_CAP) { atomicAdd(&(bar)[XB_TMO], 1u); break; } } } } while (0)
struct XcdBarrier { unsigned* bar; unsigned x; volatile LAS unsigned* st; };
DEVI XcdBarrier xcd_barrier_post(unsigned* bar, volatile LAS unsigned* st) {
    XcdBarrier b; b.bar = bar; b.x = xb_xcc_id(); b.st = st;
    if (threadIdx.x == 0) (void)xb_add(&bar[XB_XCNT(b.x)], 1u);
    return b;
}
DEVI void xcd_barrier_complete(unsigned* bar, unsigned x, unsigned& nloc, unsigned& nx) {
    const unsigned G = gridDim.x * gridDim.y * gridDim.z;
    unsigned sum, cnt, mine, sp = 0u;
    for (;;) {
        sum = 0u; cnt = 0u; mine = 0u;
#pragma unroll
        for (unsigned j = 0; j < 16; ++j) { const unsigned c = xb_ld(&bar[XB_XCNT(j)]); sum += c; cnt += (c > 0u) ? 1u : 0u; mine = (j == x) ? c : mine; }
        if (sum == G) break;
        __builtin_amdgcn_s_sleep(1);
        if ((++sp & 255u) == 0u) { if (xb_ld(&bar[XB_TMO])) break; if (sp > XB_SPIN_CAP) { atomicAdd(&bar[XB_TMO], 1u); break; } }
    }
    nloc = mine > 0u ? mine : 1u; nx = cnt > 0u ? cnt : 1u;
}
DEVI void xcd_barrier(const XcdBarrier& b) {
    asm volatile("s_waitcnt vmcnt(0)" ::: "memory");
    __syncthreads();
    if (threadIdx.x == 0) {
        unsigned* bar = b.bar;
        __builtin_amdgcn_s_waitcnt(0);
        unsigned nloc = b.st[0], nx = b.st[1];
        if (nloc == 0u) { xcd_barrier_complete(bar, b.x, nloc, nx); b.st[0] = nloc; b.st[1] = nx; }
        const unsigned old = xb_add(&bar[XB_XSUB(b.x)], 1u);
        const unsigned gen = old / nloc;
        if (old + 1u == (gen + 1u) * nloc) {
            __builtin_amdgcn_fence(__ATOMIC_RELEASE, "agent");
            asm volatile("s_waitcnt vmcnt(0)" ::: "memory");
            const unsigned og = xb_add(&bar[XB_TOP], 1u);
            const unsigned tg = og / nx;
            if (og + 1u == (tg + 1u) * nx) xb_add(&bar[XB_TOPGEN], 1u);
            else XB_SPIN(xb_ld(&bar[XB_TOPGEN]) == tg, bar);
            __builtin_amdgcn_fence(__ATOMIC_ACQUIRE, "agent");
            xb_add(&bar[XB_XGEN(b.x)], 1u);
            asm volatile("s_waitcnt vmcnt(0)" ::: "memory");
        } else {
            XB_SPIN(xb_ld(&bar[XB_XGEN(b.x)]) == gen, bar);
            __builtin_amdgcn_fence(__ATOMIC_ACQUIRE, "agent");
            asm volatile("s_waitcnt vmcnt(0)" ::: "memory");
        }
    }
    __syncthreads();
}

extern __shared__ __attribute__((aligned(16))) unsigned char dyn_smem[];
#define PHASE_KERNEL(name, fn) __global__ void __launch_bounds__(NT) name(Params p) { fn(p, dyn_smem); }
PHASE_KERNEL(k_prep, phase_prep)
PHASE_KERNEL(k_inproj, phase_inproj)
PHASE_KERNEL(k_rwkv_prep, phase_rwkv_prep)
PHASE_KERNEL(k_scans, phase_scans_naive)
PHASE_KERNEL(k_merge, phase_merge)
PHASE_KERNEL(k_wo, phase_wo)
PHASE_KERNEL(k_ln1, phase_ln1_route)
PHASE_KERNEL(k_moe1, phase_moe1)
PHASE_KERNEL(k_moe2, phase_moe2)
PHASE_KERNEL(k_ln2, phase_ln2)
PHASE_KERNEL(k_final, phase_final)

__global__ void __launch_bounds__(NT) k_mega(Params p) {
    volatile LAS unsigned* st = (volatile LAS unsigned*)(dyn_smem + LDS_BYTES - 16);
    if (threadIdx.x == 0) { st[0] = 0u; st[1] = 0u; st[2] = 0u; st[3] = 0u; }
    __syncthreads();
    const XcdBarrier gb = xcd_barrier_post((unsigned*)(p.ws + WS_BAR), st);
    phase_prep(p, dyn_smem); xcd_barrier(gb);
    phase_inproj(p, dyn_smem); xcd_barrier(gb);
    phase_rwkv_prep(p, dyn_smem); xcd_barrier(gb);
    phase_3a(p, dyn_smem); xcd_barrier(gb);
    phase_3b(p, dyn_smem); xcd_barrier(gb);
    phase_3c(p, dyn_smem); xcd_barrier(gb);
    phase_merge(p, dyn_smem); xcd_barrier(gb);
    phase_wo(p, dyn_smem); xcd_barrier(gb);
    phase_ln1_route(p, dyn_smem); xcd_barrier(gb);
    phase_moe1(p, dyn_smem); xcd_barrier(gb);
    phase_moe2(p, dyn_smem); xcd_barrier(gb);
    phase_ln2(p, dyn_smem); xcd_barrier(gb);
    phase_final(p, dyn_smem);
}

extern "C" void kernel_launch(void* const* d_in, const int* in_sizes, int n_in, void* d_out, int out_size, void* d_ws, size_t ws_size, hipStream_t stream) {
    static int grid = 0;
    if (grid == 0) {
        if (n_in != 32 || out_size != NTOK * DM || ws_size < WS_END) { fprintf(stderr, "kernel_launch: unexpected shapes (n_in %d out %d ws %zu, need %zu)\n", n_in, out_size, ws_size, (size_t)WS_END); grid = -1; return; }
        int dev = 0, cus = 0, per_cu = 0;
        hipGetDevice(&dev); hipDeviceGetAttribute(&cus, hipDeviceAttributeMultiprocessorCount, dev);
#if MODE == 0
        const void* ks[] = {(const void*)k_prep, (const void*)k_inproj, (const void*)k_rwkv_prep, (const void*)k_scans, (const void*)k_merge, (const void*)k_wo,
                            (const void*)k_ln1, (const void*)k_moe1, (const void*)k_moe2, (const void*)k_ln2, (const void*)k_final};
        for (auto k : ks) hipFuncSetAttribute(k, hipFuncAttributeMaxDynamicSharedMemorySize, LDS_BYTES);
        grid = cus > 0 ? cus : 256;
#else
        hipFuncSetAttribute((const void*)k_mega, hipFuncAttributeMaxDynamicSharedMemorySize, LDS_BYTES);
        hipOccupancyMaxActiveBlocksPerMultiprocessor(&per_cu, (const void*)k_mega, NT, LDS_BYTES);
        if (per_cu < 1) { fprintf(stderr, "kernel_launch: occupancy query says %d blocks per CU\n", per_cu); grid = -1; return; }
        grid = cus;
#endif
        (void)hipGetLastError();
    }
    if (grid < 0) return;
    Params p{};
    for (int i = 0; i < 32; ++i) p.in[i] = (const float*)d_in[i];
    p.out = (float*)d_out; p.ws = (unsigned char*)d_ws;
#if MODE == 0
    k_prep<<<grid, NT, LDS_BYTES, stream>>>(p);
    k_inproj<<<grid, NT, LDS_BYTES, stream>>>(p);
    k_rwkv_prep<<<grid, NT, LDS_BYTES, stream>>>(p);
    k_scans<<<8, NT, LDS_BYTES, stream>>>(p);
    k_merge<<<grid, NT, LDS_BYTES, stream>>>(p);
    k_wo<<<grid, NT, LDS_BYTES, stream>>>(p);
    k_ln1<<<grid, NT, LDS_BYTES, stream>>>(p);
    k_moe1<<<grid, NT, LDS_BYTES, stream>>>(p);
    k_moe2<<<grid, NT, LDS_BYTES, stream>>>(p);
    k_ln2<<<grid, NT, LDS_BYTES, stream>>>(p);
    k_final<<<grid, NT, LDS_BYTES, stream>>>(p);
#else
    (void)hipMemsetAsync((char*)d_ws + WS_BAR, 0, XCD_BAR_WORDS * 4, stream);
    void* args[] = {&p};
    hipError_t e = hipLaunchCooperativeKernel((const void*)k_mega, dim3(grid), dim3(NT), args, LDS_BYTES, stream);
    if (e != hipSuccess) fprintf(stderr, "cooperative launch failed: %s (grid %d)\n", hipGetErrorString(e), grid);
#endif
}
```

```cpp
#include <hip/hip_runtime.h>
#include <hip/hip_cooperative_groups.h>
#include <cstdio>
#include <cstdint>
namespace cg = cooperative_groups;


typedef unsigned short bf16_t;
typedef short bf16x8 __attribute__((ext_vector_type(8)));
typedef float f32x4 __attribute__((ext_vector_type(4)));
typedef unsigned u32x4 __attribute__((ext_vector_type(4)));
typedef unsigned u32x2 __attribute__((ext_vector_type(2)));
typedef float f32x2 __attribute__((ext_vector_type(2)));
#define DEVI __device__ __forceinline__
DEVI int tidx() { int t = threadIdx.x; asm volatile("" : "+v"(t)); return t; }

constexpr int NT = 512;
constexpr int NTOK = 16384, DM = 1024, SEQ = 4096, NIN = 5888, PLE = 256;
constexpr int C_K = 512, C_V = 1024, C_WD = 1536, NRW = 1792, NHG = 2048;
constexpr int H_Q = 0, H_F = 512, H_I = 1024, H_OG = 1536;
constexpr int NEXP = 32;
constexpr float ALPHA = 1.189207115002721f;
constexpr float LN_EPS = 1e-5f, RMS_EPS = 1e-6f, GN_EPS = 64e-5f;
constexpr int LDS_BYTES = 163840;

constexpr size_t MiB = 1048576;
constexpr size_t WS_WAT = 0, WS_WBT = 1 * MiB, WS_WOT = 2 * MiB, WS_WPGT = 4 * MiB, WS_WPET = 6 * MiB;
constexpr size_t WS_CNT = 6 * MiB + 512 * 1024;
constexpr int CNT_STRIDE = 64;
constexpr size_t WS_SLOT = WS_CNT + 8192;
constexpr size_t WS_TW = WS_SLOT + (size_t)NTOK * 2 * 4;
constexpr size_t WS_LIST = WS_TW + (size_t)NTOK * 2 * 4;
constexpr size_t WS_BAR = 9 * MiB + 768 * 1024;
constexpr size_t WS_GBUF = 9 * MiB;
constexpr size_t WS_WR = 10 * MiB + 768 * 1024;
constexpr size_t WS_LORA = 10 * MiB;
constexpr size_t WS_PB = 12 * MiB;
constexpr size_t WS_PRW = 20 * MiB;
constexpr size_t WS_PHG = 76 * MiB;
constexpr size_t WS_PGT = 140 * MiB;
constexpr size_t WS_W1T = 20 * MiB, WS_W3T = 52 * MiB, WS_W2T = 84 * MiB;
constexpr size_t WS_Y = 116 * MiB;
constexpr size_t WS_XB = 204 * MiB;
constexpr size_t WS_YA = 204 * MiB, WS_YB = 220 * MiB;
constexpr size_t WS_YAB = 20 * MiB;
constexpr size_t WS_X1B = 204 * MiB;
constexpr size_t WS_WINT = 236 * MiB;
constexpr size_t WS_PREP = 236 * MiB;
constexpr size_t WS_MERGED = 236 * MiB;
constexpr size_t WS_X1 = 236 * MiB;
constexpr size_t WS_PE = 236 * MiB;
constexpr size_t WS_WCAT = 300 * MiB;
constexpr size_t WS_END = 304 * MiB;
constexpr int YROWS = 40960;

struct Params { const float* in[32]; float* out; unsigned char* ws; };

DEVI float bf2f(bf16_t h) { return __uint_as_float(((unsigned)h) << 16); }
DEVI unsigned pack2(float a, float b) { unsigned r; asm volatile("v_cvt_pk_bf16_f32 %0, %1, %2" : "=v"(r) : "v"(a), "v"(b)); return r; }
DEVI bf16_t f2bf(float f) { return (bf16_t)(pack2(f, f) & 0xffffu); }
DEVI float sigm(float x) { return __builtin_amdgcn_rcpf(1.f + __expf(-x)); }
DEVI float wave_sum(float v) {
#pragma unroll
    for (int o = 32; o > 0; o >>= 1) v += __shfl_xor(v, o, 64);
    return v;
}
template <int CTRL> DEVI float dpp_mov(float v) { return __int_as_float(__builtin_amdgcn_update_dpp(0, __float_as_int(v), CTRL, 0xf, 0xf, true)); }
DEVI float sum8(float v) { v += dpp_mov<0xB1>(v); v += dpp_mov<0x4E>(v); v += dpp_mov<0x141>(v); return v; }
DEVI f32x4 ld_bf4(const bf16_t* p) { u32x2 u = *(const u32x2*)p; f32x4 r; r[0] = __uint_as_float(u[0] << 16); r[1] = __uint_as_float(u[0] & 0xffff0000u); r[2] = __uint_as_float(u[1] << 16); r[3] = __uint_as_float(u[1] & 0xffff0000u); return r; }
DEVI void st_bf4(bf16_t* p, f32x4 v) { u32x2 o; o[0] = pack2(v[0], v[1]); o[1] = pack2(v[2], v[3]); *(u32x2*)p = o; }

DEVI void cvt_tile4(const float* __restrict__ src, bf16_t* __restrict__ dst, int tile4) {
    const size_t base = (size_t)tile4 * 16384 + tidx() * 8;
    f32x4 a[4], b[4];
#pragma unroll
    for (int i = 0; i < 4; ++i) { a[i] = *(const f32x4*)(src + base + i * 4096); b[i] = *(const f32x4*)(src + base + i * 4096 + 4); }
#pragma unroll
    for (int i = 0; i < 4; ++i) {
        u32x4 o; o[0] = pack2(a[i][0], a[i][1]); o[1] = pack2(a[i][2], a[i][3]); o[2] = pack2(b[i][0], b[i][1]); o[3] = pack2(b[i][2], b[i][3]);
        *(u32x4*)(dst + base + i * 4096) = o;
    }
}
DEVI void transpose_tile(const float* __restrict__ src, bf16_t* __restrict__ dst, int R, int C, int tr, int tc, float* sm, int dld = 0) {
    if (dld == 0) dld = R;
    const int tid = tidx();
    __syncthreads();
#pragma unroll
    for (int i = 0; i < 2; ++i) {
        const int r = (tid >> 4) + 32 * i, c4 = (tid & 15) * 4;
        const f32x4 v = *(const f32x4*)(src + (size_t)(tr * 64 + r) * C + tc * 64 + c4);
        float* d = sm + r * 65 + c4; d[0] = v[0]; d[1] = v[1]; d[2] = v[2]; d[3] = v[3];
    }
    __syncthreads();
    const int c = tid >> 3, r8 = (tid & 7) * 8;
    float v[8];
#pragma unroll
    for (int k = 0; k < 8; ++k) v[k] = sm[(r8 + k) * 65 + c];
    u32x4 o; o[0] = pack2(v[0], v[1]); o[1] = pack2(v[2], v[3]); o[2] = pack2(v[4], v[5]); o[3] = pack2(v[6], v[7]);
    *(u32x4*)(dst + (size_t)(tc * 64 + c) * dld + tr * 64 + r8) = o;
}
DEVI void tt4_load(f32x4 (&v)[8], const float* __restrict__ src, int C, int tr4, int tc) {
    const int tid = tidx();
#pragma unroll
    for (int i = 0; i < 8; ++i) v[i] = *(const f32x4*)(src + (size_t)(tr4 * 256 + (tid >> 4) + 32 * i) * C + tc * 64 + (tid & 15) * 4);
}
DEVI void tt4_finish(const f32x4 (&v)[8], bf16_t* __restrict__ dst, int dld, int tr4, int tc, float* sm) {
    const int tid = tidx();
    asm volatile("s_waitcnt lgkmcnt(0)" ::: "memory"); __builtin_amdgcn_s_barrier(); asm volatile("" ::: "memory");
#pragma unroll
    for (int i = 0; i < 8; ++i) { float* d = sm + ((tid >> 4) + 32 * i) * 65 + (tid & 15) * 4; d[0] = v[i][0]; d[1] = v[i][1]; d[2] = v[i][2]; d[3] = v[i][3]; }
    asm volatile("s_waitcnt lgkmcnt(0)" ::: "memory"); __builtin_amdgcn_s_barrier(); asm volatile("" ::: "memory");
}
DEVI void tt4_store(bf16_t* __restrict__ dst, int dld, int tr4, int tc, const float* sm) {
    const int tid = tidx();
    const int c = tid >> 3, r32 = (tid & 7) * 32;
#pragma unroll
    for (int j = 0; j < 4; ++j) {
        float w[8];
#pragma unroll
        for (int k = 0; k < 8; ++k) w[k] = sm[(r32 + j * 8 + k) * 65 + c];
        u32x4 o; o[0] = pack2(w[0], w[1]); o[1] = pack2(w[2], w[3]); o[2] = pack2(w[4], w[5]); o[3] = pack2(w[6], w[7]);
        *(u32x4*)(dst + (size_t)(tc * 64 + c) * dld + tr4 * 256 + r32 + j * 8) = o;
    }
}
DEVI void transpose_tile4(const float* __restrict__ src, bf16_t* __restrict__ dst, int R, int C, int tr4, int tc, float* sm, int dld = 0) {
    if (dld == 0) dld = R;
    f32x4 v[8];
    tt4_load(v, src, C, tr4, tc);
    tt4_finish(v, dst, dld, tr4, tc, sm);
    tt4_store(dst, dld, tr4, tc, sm);
}

constexpr int GLD = 72;
struct IdRows { int base; DEVI int operator()(int r) const { return base + r; } };
struct GatherRows { const int* list; int n; DEVI int operator()(int r) const { return r < n ? list[r] : 0; } };

template <int MF, class RowMap>
DEVI void gemm_accum(f32x4 (&acc)[MF][4], const bf16_t* __restrict__ A, int lda, RowMap rowmap,
                     const bf16_t* __restrict__ Bt, int ldb, int K, bf16_t* sm) {
    bf16_t* sA = sm; bf16_t* sB = sm + MF * 64 * GLD;
    const int tid = tidx(), lane = tid & 63, wid = tid >> 6, wr = wid >> 1, wc = wid & 1, fr = lane & 15, fq = lane >> 4;
    const int lrow = tid >> 3, kc = tid & 7;
    const bf16_t* ap[MF]; const bf16_t* bp[2];
#pragma unroll
    for (int i = 0; i < MF; ++i) ap[i] = A + (size_t)rowmap(lrow + 64 * i) * lda + kc * 8;
#pragma unroll
    for (int i = 0; i < 2; ++i) bp[i] = Bt + (size_t)(lrow + 64 * i) * ldb + kc * 8;
    u32x4 ra[MF], rb[2];
#pragma unroll
    for (int i = 0; i < MF; ++i) ra[i] = *(const u32x4*)(ap[i]);
#pragma unroll
    for (int i = 0; i < 2; ++i) rb[i] = *(const u32x4*)(bp[i]);
    const int nk = K >> 6;
    for (int kt = 0; kt < nk; ++kt) {
        __syncthreads();
#pragma unroll
        for (int i = 0; i < MF; ++i) *(u32x4*)(sA + (lrow + 64 * i) * GLD + kc * 8) = ra[i];
#pragma unroll
        for (int i = 0; i < 2; ++i) *(u32x4*)(sB + (lrow + 64 * i) * GLD + kc * 8) = rb[i];
        __syncthreads();
        if (kt + 1 < nk) {
#pragma unroll
            for (int i = 0; i < MF; ++i) ra[i] = *(const u32x4*)(ap[i] + (kt + 1) * 64);
#pragma unroll
            for (int i = 0; i < 2; ++i) rb[i] = *(const u32x4*)(bp[i] + (kt + 1) * 64);
        }
#pragma unroll
        for (int kk = 0; kk < 2; ++kk) {
            bf16x8 af[MF], bfr[4];
#pragma unroll
            for (int m = 0; m < MF; ++m) af[m] = *(const bf16x8*)(sA + (wr * (MF * 16) + m * 16 + fr) * GLD + kk * 32 + fq * 8);
#pragma unroll
            for (int n = 0; n < 4; ++n) bfr[n] = *(const bf16x8*)(sB + (wc * 64 + n * 16 + fr) * GLD + kk * 32 + fq * 8);
#pragma unroll
            for (int m = 0; m < MF; ++m)
#pragma unroll
                for (int n = 0; n < 4; ++n) acc[m][n] = __builtin_amdgcn_mfma_f32_16x16x32_bf16(bfr[n], af[m], acc[m][n], 0, 0, 0);
        }
    }
}
template <int MF> DEVI void acc_zero(f32x4 (&acc)[MF][4]) {
#pragma unroll
    for (int m = 0; m < MF; ++m)
#pragma unroll
        for (int n = 0; n < 4; ++n) acc[m][n] = (f32x4){0.f, 0.f, 0.f, 0.f};
}
template <int MF, class F> DEVI void epi1(const f32x4 (&acc)[MF][4], F f) {
    const int lane = tidx() & 63, wid = tidx() >> 6, wr = wid >> 1, wc = wid & 1, fr = lane & 15, fq = lane >> 4;
#pragma unroll
    for (int m = 0; m < MF; ++m)
#pragma unroll
        for (int n = 0; n < 4; ++n) f(wr * (MF * 16) + m * 16 + fr, wc * 64 + n * 16 + fq * 4, acc[m][n]);
}
template <int MF, class F> DEVI void epi2(const f32x4 (&a1)[MF][4], const f32x4 (&a2)[MF][4], F f) {
    const int lane = tidx() & 63, wid = tidx() >> 6, wr = wid >> 1, wc = wid & 1, fr = lane & 15, fq = lane >> 4;
#pragma unroll
    for (int m = 0; m < MF; ++m)
#pragma unroll
        for (int n = 0; n < 4; ++n) f(wr * (MF * 16) + m * 16 + fr, wc * 64 + n * 16 + fq * 4, a1[m][n], a2[m][n]);
}


#define PG_LAS __attribute__((address_space(3)))
constexpr int PBK = 64, PHALF = 128, PHTB = PHALF * PBK * 2, PSTAGE = 8 * PHTB;
DEVI int pg_lds_byte(int r, int c) { const int st = (r >> 4) * 2 + (c >> 5), rr = r & 15, cc = c & 31, ob = rr * 64 + cc * 2; return st * 1024 + (ob ^ (((ob >> 9) & 1) << 5)); }
DEVI void pg_stage_rc(int b, int& R, int& C) { const int st = b / 1024, sb = b % 1024, swz = sb ^ (((sb >> 9) & 1) << 5); R = (st >> 1) * 16 + swz / 64; C = (st & 1) * 32 + (swz % 64) / 2; }
DEVI int pg_perm32(int rho) { const int n = rho >> 4, i = rho & 15; return 8 * (i >> 2) + 4 * n + (i & 3); }
struct PUnit { const char* A; const char* Bt; const int* rows; int nrows, lda, pm, pn, x0, x1; };
template <class Epi, class Sched>
DEVI void pgemm(PG_LAS unsigned char* lds, int ldb, int K, const Sched& S, const Epi& E) {
    int tid = tidx();
    const int wid = __builtin_amdgcn_readfirstlane(tid >> 6), lane = tid & 63, wr = wid >> 2, wc = wid & 3, fr = lane & 15, fq = lane >> 4;
    const int nt = K / PBK;
    unsigned voffB[2];
#pragma unroll
    for (int i = 0; i < 2; ++i) { int R, C; pg_stage_rc(tid * 16 + i * 8192, R, C); const int Rb = Epi::PERM ? ((R & ~31) + pg_perm32(R & 31)) : R; voffB[i] = (unsigned)(Rb * ldb + C) * 2u; }
    const size_t kstep = (size_t)(PBK * 2);
    const size_t hstepB = (size_t)PHALF * ldb * 2;
    const unsigned ldsw = (unsigned)wid * 1024u;
    const int aoff = pg_lds_byte(wr * 64 + fr, fq * 8), boff = pg_lds_byte(wc * 32 + fr, fq * 8);
#define PG_SA(b, h) (((b) * 2 + (h)) * PHTB)
#define PG_SB(b, h) ((4 + (b) * 2 + (h)) * PHTB)
#define PG_STAGE(bufoff, gbase, voff) do { _Pragma("unroll") for (int _i = 0; _i < 2; ++_i) \
        __builtin_amdgcn_global_load_lds((const unsigned*)((const char*)(gbase) + (voff)[_i]), (PG_LAS unsigned*)(lds + (bufoff) + ldsw + _i * 8192), 16, 0, 0); } while (0)
#define PG_LDA(dst, b, h) do { _Pragma("unroll") for (int m = 0; m < 4; ++m) _Pragma("unroll") for (int k = 0; k < 2; ++k) dst[m][k] = *(const PG_LAS bf16x8*)(lds + PG_SA(b, h) + aoff + m * 2048 + k * 1024); } while (0)
#define PG_LDB(dst, b, h) do { _Pragma("unroll") for (int n = 0; n < 2; ++n) _Pragma("unroll") for (int k = 0; k < 2; ++k) dst[n][k] = *(const PG_LAS bf16x8*)(lds + PG_SB(b, h) + boff + n * 2048 + k * 1024); } while (0)
#define PG_MMA(ai, bj, At, Bt) do { __builtin_amdgcn_s_setprio(1); _Pragma("unroll") for (int m = 0; m < 4; ++m) _Pragma("unroll") for (int n = 0; n < 2; ++n) _Pragma("unroll") for (int k = 0; k < 2; ++k) \
        acc[ai][bj][m][n] = __builtin_amdgcn_mfma_f32_16x16x32_bf16(Bt[n][k], At[m][k], acc[ai][bj][m][n], 0, 0, 0); __builtin_amdgcn_s_setprio(0); } while (0)
#define PG_WAIT_V(n) asm volatile("s_waitcnt vmcnt(" #n ")" ::: "memory")
#define PG_WAIT_L(n) asm volatile("s_waitcnt lgkmcnt(" #n ")" ::: "memory")
#define PG_BAR __builtin_amdgcn_s_barrier()
#define PG_SCHED __builtin_amdgcn_sched_barrier(0)
#define PG_VOFFA(dst, u) do { _Pragma("unroll") for (int _h = 0; _h < 2; ++_h) _Pragma("unroll") for (int _i = 0; _i < 2; ++_i) { int _R, _C; pg_stage_rc(tid * 16 + _i * 8192, _R, _C); const int _r = _h * 128 + _R; \
        int _ix = _r; if constexpr (Sched::GATHER) { if ((u).rows) _ix = (_r < (u).nrows ? (u).rows[_r] : 0); } dst[_h][_i] = (unsigned)(_ix * (u).lda + _C) * 2u; } } while (0)
    PUnit cur, nxt; int ui = 0;
    if (!S.next(0, cur)) return;
    f32x4 acc[2][2][4][2];
    bf16x8 At[4][2], B0[2][2], B1[2][2];
    unsigned vA[2][2];
    PG_VOFFA(vA, cur);
    const char* cA = cur.A; const char* cB = cur.Bt;
    PG_STAGE(PG_SB(0, 0), cB, voffB); PG_STAGE(PG_SA(0, 0), cA, vA[0]); PG_STAGE(PG_SB(0, 1), cB + hstepB, voffB); PG_STAGE(PG_SA(0, 1), cA, vA[1]);
    if (wr == 1) PG_BAR;
    PG_WAIT_V(4); PG_BAR;
    PG_STAGE(PG_SB(1, 0), cB + kstep, voffB); PG_STAGE(PG_SA(1, 0), cA + kstep, vA[0]); PG_STAGE(PG_SB(1, 1), cB + hstepB + kstep, voffB);
    PG_WAIT_V(6); PG_BAR;
#pragma unroll
    for (int a = 0; a < 2; ++a)
#pragma unroll
        for (int b = 0; b < 2; ++b)
#pragma unroll
            for (int m = 0; m < 4; ++m)
#pragma unroll
                for (int n = 0; n < 2; ++n) acc[a][b][m][n] = (f32x4){0.f, 0.f, 0.f, 0.f};
    for (;;) {
        const bool has_next = S.next(ui + 1, nxt);
        const char* nA = has_next ? nxt.A : cA; const char* nB = has_next ? nxt.Bt : cB;
#pragma unroll 1
        for (int t = 0; t < nt; t += 2) {
            const bool last = (t == nt - 2);
            const char* a1 = cA + (size_t)(t + 1) * kstep;
            const char* a2 = last ? nA : cA + (size_t)(t + 2) * kstep; const char* b2 = last ? nB : cB + (size_t)(t + 2) * kstep;
            const char* a3 = a2 + kstep; const char* b3 = b2 + kstep;
            PG_LDB(B0, 0, 0); PG_SCHED; PG_LDA(At, 0, 0); PG_STAGE(PG_SA(1, 1), a1, vA[1]);
            if (last && has_next) PG_VOFFA(vA, nxt);
            PG_WAIT_L(8); PG_BAR; PG_WAIT_L(0); PG_MMA(0, 0, At, B0); PG_BAR; PG_SCHED;
            PG_LDB(B1, 0, 1); PG_STAGE(PG_SB(0, 0), b2, voffB);
            PG_BAR; PG_WAIT_L(0); PG_MMA(0, 1, At, B1); PG_BAR;
            PG_LDA(At, 0, 1); PG_STAGE(PG_SA(0, 0), a2, vA[0]);
            PG_BAR; PG_WAIT_L(0); PG_MMA(1, 0, At, B0); PG_BAR; PG_SCHED;
            PG_STAGE(PG_SB(0, 1), b2 + hstepB, voffB);
            PG_WAIT_V(6); PG_BAR; PG_MMA(1, 1, At, B1); PG_BAR;
            PG_LDB(B0, 1, 0); PG_SCHED; PG_LDA(At, 1, 0); PG_STAGE(PG_SA(0, 1), a2, vA[1]);
            PG_WAIT_L(8); PG_BAR; PG_WAIT_L(0); PG_MMA(0, 0, At, B0); PG_BAR; PG_SCHED;
            PG_LDB(B1, 1, 1); PG_STAGE(PG_SB(1, 0), b3, voffB);
            PG_BAR; PG_WAIT_L(0); PG_MMA(0, 1, At, B1); PG_BAR;
            PG_LDA(At, 1, 1); PG_STAGE(PG_SA(1, 0), a3, vA[0]);
            PG_BAR; PG_WAIT_L(0); PG_MMA(1, 0, At, B0); PG_BAR; PG_SCHED;
            PG_STAGE(PG_SB(1, 1), b3 + hstepB, voffB);
            PG_WAIT_V(6); PG_BAR; PG_MMA(1, 1, At, B1); PG_BAR;
        }
        E(acc, cur, wr, wc, fr, fq);
        if (!has_next) break;
#pragma unroll
        for (int a = 0; a < 2; ++a)
#pragma unroll
            for (int b = 0; b < 2; ++b)
#pragma unroll
                for (int m = 0; m < 4; ++m)
#pragma unroll
                    for (int n = 0; n < 2; ++n) acc[a][b][m][n] = (f32x4){0.f, 0.f, 0.f, 0.f};
        cur = nxt; cA = nA; cB = nB; ++ui;
    }
    PG_WAIT_V(0);
    if (wr == 0) PG_BAR;
    PG_BAR;
#undef PG_SA
#undef PG_SB
#undef PG_STAGE
#undef PG_LDA
#undef PG_LDB
#undef PG_MMA
#undef PG_WAIT_V
#undef PG_WAIT_L
#undef PG_BAR
#undef PG_SCHED
#undef PG_VOFFA
}
struct TileOrder {
    static constexpr bool GATHER = false;
    const bf16_t* A; const bf16_t* Bt; int lda, ldb, nM, nN, nwg, G, c;
    DEVI void init(const bf16_t* A_, int lda_, const bf16_t* Bt_, int ldb_, int M, int N) { A = A_; Bt = Bt_; lda = lda_; ldb = ldb_; nM = M / 256; nN = N / 256; nwg = nM * nN; G = gridDim.x; c = blockIdx.x; }
    DEVI bool next(int i, PUnit& u) const {
        const long L = (long)i * G + c; if (L >= nwg) return false;
        int wgid = (int)L; { const int q = nwg / 8, r = nwg % 8, xcd = wgid % 8, off = wgid / 8; wgid = (xcd < r ? xcd * (q + 1) : r * (q + 1) + (xcd - r) * q) + off; }
        const int nig = 8 * nN, gid = wgid / nig, fm = gid * 8, gsz = (nM - fm) < 8 ? (nM - fm) : 8;
        u.pm = fm + ((wgid % nig) % gsz); u.pn = (wgid % nig) / gsz;
        u.A = (const char*)(A + (size_t)u.pm * 256 * lda); u.Bt = (const char*)(Bt + (size_t)u.pn * 256 * ldb); u.rows = nullptr; u.nrows = 256; u.lda = lda; u.x0 = 0; u.x1 = 0;
        return true;
    }
};

DEVI void phase_prep(const Params& p, unsigned char* smem) {
    float* sm = (float*)smem;
    bf16_t* xb = (bf16_t*)(p.ws + WS_XB); bf16_t* pb = (bf16_t*)(p.ws + WS_PB);
    constexpr int T_X = 1024, T_P = 256, T_WIN = 4 * 92, T_WA = 8 * 16, T_WB = 8 * 16, T_WO = 4 * 16, T_WPE = 1 * 16, T_WPG = 4 * 16;
    constexpr int T_LORA = 8 + 8 + 16;
    constexpr int TOTAL = T_X + T_P + T_WIN + T_WA + T_WB + T_WO + T_WPE + T_WPG + T_LORA;
    for (int t = blockIdx.x; t < TOTAL; t += gridDim.x) {
        int u = t;
        if (u < T_X) { cvt_tile4(p.in[0], xb, u); continue; } u -= T_X;
        if (u < T_P) { cvt_tile4(p.in[1], pb, u); continue; } u -= T_P;
        if (u < T_WIN) { transpose_tile4(p.in[2], (bf16_t*)(p.ws + WS_WINT), 1024, NIN, u / 92, u % 92, sm); continue; } u -= T_WIN;
        if (u < T_WA + T_WB) {
            const int sb = u >= T_WA, uu = sb ? u - T_WA : u, tr = uu / 16, tc = uu % 16;
            bf16_t* wc = (bf16_t*)(p.ws + WS_WCAT);
            transpose_tile(p.in[sb ? 17 : 14], wc + (size_t)((tc >> 1) * 256 + sb * 128 - (tc >> 1) * 128) * 1024 + sb * 512, 512, 1024, tr, tc, sm, 1024);
            const int tid = tidx(), rr = tid >> 3, k8 = (tid & 7) * 8;
            *(u32x4*)(wc + (size_t)((tc >> 1) * 256 + sb * 128 + (tc & 1) * 64 + rr) * 1024 + (1 - sb) * 512 + tr * 64 + k8) = (u32x4){0u, 0u, 0u, 0u};
            continue;
        } u -= T_WA + T_WB;
        if (u < T_WO) { transpose_tile4(p.in[18], (bf16_t*)(p.ws + WS_WOT), 1024, 1024, u / 16, u % 16, sm); continue; } u -= T_WO;
        if (u < T_WPE) { transpose_tile4(p.in[30], (bf16_t*)(p.ws + WS_WPET), 256, 1024, 0, u, sm); continue; } u -= T_WPE;
        if (u < T_WPG) { transpose_tile4(p.in[31], (bf16_t*)(p.ws + WS_WPGT), 1024, 1024, u / 16, u % 16, sm); continue; } u -= T_WPG;
        if (u < 8) transpose_tile(p.in[5], (bf16_t*)(p.ws + WS_LORA), 64, 512, 0, u, sm);
        else if (u < 16) transpose_tile(p.in[7], (bf16_t*)(p.ws + WS_LORA) + 512 * 64, 64, 512, 0, u - 8, sm);
        else transpose_tile(p.in[8], (bf16_t*)(p.ws + WS_LORA) + 2 * 512 * 64, 128, 512, (u - 16) >> 3, (u - 16) & 7, sm);
    }
    if (blockIdx.x == 0 && tidx() < 32) ((int*)(p.ws + WS_CNT))[tidx() * CNT_STRIDE] = 0;
    if (blockIdx.x >= 2 && blockIdx.x < 20) {
        const int idx = (blockIdx.x - 2) * 512 + tidx(), u = idx >> 10, col = idx & 1023;
        ((f32x4*)(p.ws + WS_WR))[idx] = (u == 0) ? *(const f32x4*)(p.in[21] + (size_t)col * 4) : *(const f32x4*)(p.in[23] + (size_t)col * 32 + (u - 1) * 4);
    }
}

DEVI u32x4 pk8(f32x4 a, f32x4 b) { u32x4 o; o[0] = pack2(a[0], a[1]); o[1] = pack2(a[2], a[3]); o[2] = pack2(b[0], b[1]); o[3] = pack2(b[2], b[3]); return o; }
struct EpiInproj {
    static constexpr bool PERM = true; unsigned char* ws;
    DEVI void operator()(const f32x4 (&acc)[2][2][4][2], const PUnit& u, int wr, int wc, int fr, int fq) const {
        bf16_t* dst; int ld;
        if (u.pn < 7) { dst = (bf16_t*)(ws + WS_PRW) + u.pn * 256; ld = NRW; }
        else if (u.pn < 15) { dst = (bf16_t*)(ws + WS_PHG) + (u.pn - 7) * 256; ld = NHG; }
        else { dst = (bf16_t*)(ws + WS_PGT) + (u.pn - 15) * 256; ld = NHG; }
        const int row0 = u.pm * 256 + wr * 64 + fr;
#pragma unroll
        for (int ai = 0; ai < 2; ++ai)
#pragma unroll
            for (int m = 0; m < 4; ++m) {
                bf16_t* rowp = dst + (size_t)(row0 + ai * 128 + m * 16) * ld + wc * 32 + 8 * fq;
#pragma unroll
                for (int bj = 0; bj < 2; ++bj) *(u32x4*)(rowp + bj * 128) = pk8(acc[ai][bj][m][0], acc[ai][bj][m][1]);
            }
    }
};
DEVI void phase_inproj(const Params& p, unsigned char* smem) {
    TileOrder S; S.init((const bf16_t*)(p.ws + WS_XB), 1024, (const bf16_t*)(p.ws + WS_WINT), 1024, NTOK, NIN);
    pgemm((PG_LAS unsigned char*)smem, 1024, 1024, S, EpiInproj{p.ws});
}

template <int MT, int NTL, int KS>
DEVI void mma_lds(f32x4 (&acc)[MT][NTL], const bf16_t* sA, int lda, const bf16_t* sB, int ldb) {
    const int lane = tidx() & 63, fr = lane & 15, fq = lane >> 4;
#pragma unroll
    for (int ks = 0; ks < KS; ++ks) {
        bf16x8 af[MT], bfr[NTL];
#pragma unroll
        for (int m = 0; m < MT; ++m) af[m] = *(const bf16x8*)(sA + (m * 16 + fr) * lda + ks * 32 + fq * 8);
#pragma unroll
        for (int n = 0; n < NTL; ++n) bfr[n] = *(const bf16x8*)(sB + (n * 16 + fr) * ldb + ks * 32 + fq * 8);
#pragma unroll
        for (int m = 0; m < MT; ++m)
#pragma unroll
            for (int n = 0; n < NTL; ++n) acc[m][n] = __builtin_amdgcn_mfma_f32_16x16x32_bf16(bfr[n], af[m], acc[m][n], 0, 0, 0);
    }
}
template <int MT, int NTL> DEVI void accz(f32x4 (&acc)[MT][NTL]) {
#pragma unroll
    for (int m = 0; m < MT; ++m)
#pragma unroll
        for (int n = 0; n < NTL; ++n) acc[m][n] = (f32x4){0.f, 0.f, 0.f, 0.f};
}


DEVI bf16_t* prep_arr(const Params& p, int i) { return i < 4 ? (bf16_t*)(p.ws + WS_PREP + (size_t)i * 16 * MiB) : (bf16_t*)((unsigned char*)p.out + (size_t)(i - 4) * 16 * MiB); }
template <int KS>
DEVI void mma_gb(f32x4 (&acc)[1][4], const bf16_t* sA, int lda, const bf16_t* gB, int ldb) {
    const int lane = tidx() & 63, fr = lane & 15, fq = lane >> 4;
#pragma unroll
    for (int ks = 0; ks < KS; ++ks) {
        if (ks & 1) asm volatile("" ::: "memory");
        const bf16x8 af = *(const bf16x8*)(sA + fr * lda + ks * 32 + fq * 8);
#pragma unroll
        for (int n = 0; n < 4; ++n) {
            const bf16x8 bfr = *(const bf16x8*)(gB + (size_t)((n >> 1) * 32 + pg_perm32((n & 1) * 16 + fr)) * ldb + ks * 32 + fq * 8);
            acc[0][n] = __builtin_amdgcn_mfma_f32_16x16x32_bf16(bfr, af, acc[0][n], 0, 0, 0);
        }
    }
}
DEVI void phase_rwkv_prep(const Params& p, unsigned char* smem) {
    const bf16_t* proj = (const bf16_t*)(p.ws + WS_PRW);
    const float* mu = p.in[3];
    const bf16_t* WupT = (const bf16_t*)(p.ws + WS_LORA); const bf16_t* AupT = WupT + 512 * 64; const bf16_t* GupT = AupT + 512 * 64;
    bf16_t* oR = prep_arr(p, 0); bf16_t* oK = prep_arr(p, 1); bf16_t* oV = prep_arr(p, 2); bf16_t* oW = prep_arr(p, 3);
    bf16_t* oKK = prep_arr(p, 4); bf16_t* oA = prep_arr(p, 5); bf16_t* oG = prep_arr(p, 6);
    bf16_t* sLin = (bf16_t*)smem;
    for (int tile = blockIdx.x; tile < NTOK / 64; tile += gridDim.x) {
        const int tid = tidx(), lane = tid & 63, wid = tid >> 6, fr = lane & 15, fq = lane >> 4, rb = wid & 3, hd = wid >> 2;
        const int t0 = tile * 64;
        __syncthreads();
        {
            const int c8 = (tid & 31) * 8;
            const f32x4 m0 = *(const f32x4*)(mu + C_WD + c8), m1 = *(const f32x4*)(mu + C_WD + c8 + 4);
            u32x4 cu[4], pv[4];
#pragma unroll
            for (int i = 0; i < 4; ++i) {
                const int tt = (tid >> 5) + 16 * i, t = t0 + tt;
                cu[i] = *(const u32x4*)(proj + (size_t)t * NRW + C_WD + c8);
                pv[i] = (u32x4){0u, 0u, 0u, 0u};
                if (t % SEQ != 0) pv[i] = *(const u32x4*)(proj + (size_t)(t - 1) * NRW + C_WD + c8);
            }
#pragma unroll
            for (int i = 0; i < 4; ++i) {
                float o[8];
#pragma unroll
                for (int k = 0; k < 8; ++k) {
                    const float c = (k & 1) ? __uint_as_float(cu[i][k >> 1] & 0xffff0000u) : __uint_as_float(cu[i][k >> 1] << 16);
                    const float pr = (k & 1) ? __uint_as_float(pv[i][k >> 1] & 0xffff0000u) : __uint_as_float(pv[i][k >> 1] << 16);
                    const float u = c + (pr - c) * (k < 4 ? m0[k & 3] : m1[k & 3]);
                    o[k] = c8 < 64 ? (1.f - 2.f * __builtin_amdgcn_rcpf(__expf(2.f * u) + 1.f)) : (c8 < 128 ? u : sigm(u));
                }
                u32x4 pk; pk[0] = pack2(o[0], o[1]); pk[1] = pack2(o[2], o[3]); pk[2] = pack2(o[4], o[5]); pk[3] = pack2(o[6], o[7]);
                *(u32x4*)(sLin + ((tid >> 5) + 16 * i) * 264 + c8) = pk;
            }
        }
        __syncthreads();
        const int t = t0 + rb * 16 + fr; const bool first = (t % SEQ == 0);
        const bf16_t* row = proj + (size_t)t * NRW; const bf16_t* prow = first ? row : row - NRW;
        u32x4 ld_k[2], ld_pk[2], ld_r[2], ld_v[2], ld_pr[2], ld_pv[2];
#pragma unroll
        for (int g = 0; g < 2; ++g) {
            const int c = (hd * 4) * 64 + g * 32 + fq * 8;
            ld_k[g] = *(const u32x4*)(row + C_K + c); ld_pk[g] = *(const u32x4*)(prow + C_K + c);
            ld_r[g] = *(const u32x4*)(row + c); ld_v[g] = *(const u32x4*)(row + C_V + c); ld_pr[g] = *(const u32x4*)(prow + c); ld_pv[g] = *(const u32x4*)(prow + C_V + c);
        }
#pragma unroll 1
        for (int hh = 0; hh < 4; ++hh) {
            const int head = hd * 4 + hh;
            f32x4 aw[1][4], aa[1][4], ag[1][4]; accz(aw); accz(aa); accz(ag);
            {
                const bf16_t* linA = sLin + (rb * 16 + fr) * 264 + fq * 8;
                const bf16_t* gw = WupT + (size_t)head * 64 * 64 + fq * 8; const bf16_t* ga = AupT + (size_t)head * 64 * 64 + fq * 8; const bf16_t* gg = GupT + (size_t)head * 64 * 128 + fq * 8;
                int wrow[4];
#pragma unroll
                for (int n = 0; n < 4; ++n) wrow[n] = (n >> 1) * 32 + pg_perm32((n & 1) * 16 + fr);
                bf16x8 f0[2][4], f1[2][4];
#pragma unroll
                for (int ks = 0; ks < 2; ++ks)
#pragma unroll
                    for (int n = 0; n < 4; ++n) { f0[ks][n] = *(const bf16x8*)(gw + (size_t)wrow[n] * 64 + ks * 32); f1[ks][n] = *(const bf16x8*)(ga + (size_t)wrow[n] * 64 + ks * 32); }
#pragma unroll
                for (int ks = 0; ks < 2; ++ks) { const bf16x8 af = *(const bf16x8*)(linA + ks * 32);
#pragma unroll
                    for (int n = 0; n < 4; ++n) aw[0][n] = __builtin_amdgcn_mfma_f32_16x16x32_bf16(f0[ks][n], af, aw[0][n], 0, 0, 0); }
#pragma unroll
                for (int ks = 0; ks < 2; ++ks)
#pragma unroll
                    for (int n = 0; n < 4; ++n) f0[ks][n] = *(const bf16x8*)(gg + (size_t)wrow[n] * 128 + ks * 32);
#pragma unroll
                for (int ks = 0; ks < 2; ++ks) { const bf16x8 af = *(const bf16x8*)(linA + 64 + ks * 32);
#pragma unroll
                    for (int n = 0; n < 4; ++n) aa[0][n] = __builtin_amdgcn_mfma_f32_16x16x32_bf16(f1[ks][n], af, aa[0][n], 0, 0, 0); }
#pragma unroll
                for (int ks = 0; ks < 2; ++ks)
#pragma unroll
                    for (int n = 0; n < 4; ++n) f1[ks][n] = *(const bf16x8*)(gg + (size_t)wrow[n] * 128 + (ks + 2) * 32);
#pragma unroll
                for (int ks = 0; ks < 2; ++ks) { const bf16x8 af = *(const bf16x8*)(linA + 128 + ks * 32);
#pragma unroll
                    for (int n = 0; n < 4; ++n) ag[0][n] = __builtin_amdgcn_mfma_f32_16x16x32_bf16(f0[ks][n], af, ag[0][n], 0, 0, 0); }
#pragma unroll
                for (int ks = 0; ks < 2; ++ks) { const bf16x8 af = *(const bf16x8*)(linA + 128 + (ks + 2) * 32);
#pragma unroll
                    for (int n = 0; n < 4; ++n) ag[0][n] = __builtin_amdgcn_mfma_f32_16x16x32_bf16(f1[ks][n], af, ag[0][n], 0, 0, 0); }
            }
            float kl[2][8];
            float ss = 0.f;
#pragma unroll
            for (int g = 0; g < 2; ++g) {
                const int c = head * 64 + g * 32 + fq * 8;
                const u32x4 k8 = ld_k[g], p8 = ld_pk[g];
                const f32x4 mk0 = *(const f32x4*)(mu + C_K + c), mk1 = *(const f32x4*)(mu + C_K + c + 4), kc0 = *(const f32x4*)(p.in[9] + c), kc1 = *(const f32x4*)(p.in[9] + c + 4);
#pragma unroll
                for (int x = 0; x < 8; ++x) {
                    const float kc = (x & 1) ? __uint_as_float(k8[x >> 1] & 0xffff0000u) : __uint_as_float(k8[x >> 1] << 16);
                    const float pk = first ? 0.f : ((x & 1) ? __uint_as_float(p8[x >> 1] & 0xffff0000u) : __uint_as_float(p8[x >> 1] << 16));
                    const float k = kc + (pk - kc) * (x < 4 ? mk0[x & 3] : mk1[x & 3]);
                    kl[g][x] = k; const float kk = k * (x < 4 ? kc0[x & 3] : kc1[x & 3]); ss += kk * kk;
                }
            }
            ss += __shfl_xor(ss, 16, 64); ss += __shfl_xor(ss, 32, 64);
            const float inv = __builtin_amdgcn_rcpf(fmaxf(__builtin_amdgcn_sqrtf(ss), 1e-12f));
            if (hh < 3) {
#pragma unroll
                for (int g = 0; g < 2; ++g) { const int cn = (head + 1) * 64 + g * 32 + fq * 8; ld_k[g] = *(const u32x4*)(row + C_K + cn); ld_pk[g] = *(const u32x4*)(prow + C_K + cn); }
            }
#pragma unroll
            for (int g = 0; g < 2; ++g) {
                if (g == 1) asm volatile("" ::: "memory");
                const int c = head * 64 + g * 32 + fq * 8;
                const u32x4 r8 = ld_r[g], v8 = ld_v[g], pr8 = ld_pr[g], pv8 = ld_pv[g];
                if (hh < 3) { const int cn = (head + 1) * 64 + g * 32 + fq * 8;
                    ld_r[g] = *(const u32x4*)(row + cn); ld_v[g] = *(const u32x4*)(row + C_V + cn); ld_pr[g] = *(const u32x4*)(prow + cn); ld_pv[g] = *(const u32x4*)(prow + C_V + cn); }
                float rr[8], vv[8], lw[8], av[8], kp[8], kkn[8], gg[8];
#pragma unroll
                for (int hx = 0; hx < 2; ++hx) {
                    const int cc = c + hx * 4;
                    const f32x4 mr = *(const f32x4*)(mu + cc), mv = *(const f32x4*)(mu + C_V + cc);
                    const f32x4 w0 = *(const f32x4*)(p.in[4] + cc), a0 = *(const f32x4*)(p.in[6] + cc), kkc = *(const f32x4*)(p.in[9] + cc), kac = *(const f32x4*)(p.in[10] + cc);
#pragma unroll
                    for (int q = 0; q < 4; ++q) {
                        const int x = hx * 4 + q;
                        const float rc = (x & 1) ? __uint_as_float(r8[x >> 1] & 0xffff0000u) : __uint_as_float(r8[x >> 1] << 16);
                        const float vc = (x & 1) ? __uint_as_float(v8[x >> 1] & 0xffff0000u) : __uint_as_float(v8[x >> 1] << 16);
                        const float prx = first ? 0.f : ((x & 1) ? __uint_as_float(pr8[x >> 1] & 0xffff0000u) : __uint_as_float(pr8[x >> 1] << 16));
                        const float pvx = first ? 0.f : ((x & 1) ? __uint_as_float(pv8[x >> 1] & 0xffff0000u) : __uint_as_float(pv8[x >> 1] << 16));
                        rr[x] = rc + (prx - rc) * mr[q]; vv[x] = vc + (pvx - vc) * mv[q];
                        const float z = -(w0[q] + aw[0][g * 2 + hx][q]);
                        const float sp = z > 20.f ? z : __logf(1.f + __expf(z));
                        lw[x] = -__expf(-sp - 0.5f);
                        const float a = sigm(a0[q] + aa[0][g * 2 + hx][q]);
                        av[x] = a; kkn[x] = kl[g][x] * kkc[q] * inv; kp[x] = kl[g][x] * (1.f + (a - 1.f) * kac[q]); gg[x] = ag[0][g * 2 + hx][q];
                    }
                }
                const size_t o = (size_t)t * 512 + c;
#define ST8(dst, a) do { u32x4 _o; _o[0] = pack2(a[0], a[1]); _o[1] = pack2(a[2], a[3]); _o[2] = pack2(a[4], a[5]); _o[3] = pack2(a[6], a[7]); *(u32x4*)((dst) + o) = _o; } while (0)
                ST8(oR, rr); ST8(oK, kp); ST8(oV, vv); ST8(oW, lw); ST8(oKK, kkn); ST8(oA, av); ST8(oG, gg);
#undef ST8
            }
        }
    }
}

DEVI void scan_rwkv_naive(const Params& p, unsigned char* smem, int blk) {
    const int tid = tidx(), lane = tid & 63, wid = tid >> 6;
    const int unit = blk * 8 + wid, b = unit >> 3, h = unit & 7, c = h * 64 + lane;
    float* sw = (float*)smem + wid * (4 * 7 * 64);
    float* srk = (float*)smem + 8 * (4 * 7 * 64) + wid * 64;
    const bf16_t* iR = prep_arr(p, 0); const bf16_t* iK = prep_arr(p, 1); const bf16_t* iV = prep_arr(p, 2); const bf16_t* iW = prep_arr(p, 3);
    const bf16_t* iKK = prep_arr(p, 4); const bf16_t* iA = prep_arr(p, 5); const bf16_t* iG = prep_arr(p, 6);
    bf16_t* ya = (bf16_t*)(p.ws + WS_YA);
    srk[lane] = p.in[11][c];
    const float gnw = p.in[12][c], gnb = p.in[13][c];
    float S[64];
#pragma unroll
    for (int j = 0; j < 64; ++j) S[j] = 0.f;
    for (int t0 = 0; t0 < SEQ; t0 += 4) {
        __syncthreads();
#pragma unroll
        for (int s = 0; s < 4; ++s) {
            const size_t o = (size_t)(b * SEQ + t0 + s) * 512 + c;
            const float r = bf2f(iR[o]), k = bf2f(iK[o]), w = __expf(bf2f(iW[o])), kk = bf2f(iKK[o]), a = bf2f(iA[o]);
            float* d = sw + s * 7 * 64 + lane;
            d[0] = r; d[64] = k; d[128] = w; d[192] = -kk; d[256] = kk * a; d[320] = bf2f(iV[o]); d[384] = bf2f(iG[o]);
        }
        __syncthreads();
#pragma unroll 1
        for (int s = 0; s < 4; ++s) {
            const f32x4* vr = (const f32x4*)(sw + s * 7 * 64);
            const f32x4* vk = vr + 16; const f32x4* vw = vr + 32; const f32x4* va = vr + 48; const f32x4* vb = vr + 64;
            const float v = sw[s * 7 * 64 + 320 + lane], g = sw[s * 7 * 64 + 384 + lane];
            float sa = 0.f;
#pragma unroll
            for (int j4 = 0; j4 < 16; ++j4) { const f32x4 a4 = va[j4];
#pragma unroll
                for (int q = 0; q < 4; ++q) sa += S[j4 * 4 + q] * a4[q]; }
            float y = 0.f, bon = 0.f;
#pragma unroll
            for (int j4 = 0; j4 < 16; ++j4) {
                const f32x4 w4 = vw[j4], b4 = vb[j4], k4 = vk[j4], r4 = vr[j4], rk4 = ((const f32x4*)srk)[j4];
#pragma unroll
                for (int q = 0; q < 4; ++q) {
                    const float sn = S[j4 * 4 + q] * w4[q] + sa * b4[q] + v * k4[q];
                    S[j4 * 4 + q] = sn; y += sn * r4[q]; bon += r4[q] * k4[q] * rk4[q];
                }
            }
            const float mean = wave_sum(y) * (1.f / 64.f);
            const float d = y - mean;
            const float var = wave_sum(d * d) * (1.f / 64.f);
            const float outv = (d * rsqrtf(var + GN_EPS) * gnw + gnb + bon * v) * g;
            ya[(size_t)(b * SEQ + t0 + s) * 512 + c] = f2bf(outv);
        }
    }
}
DEVI void scan_hgrn_naive(const Params& p, unsigned char* smem, int blk) {
    const int tid = tidx(), lane = tid & 63, ul = tid >> 7, v = tid & 127, wiu = (tid >> 6) & 1;
    const int unit = blk * 4 + ul, b = unit >> 2, h = unit & 3, c = h * 128 + v;
    float* su = (float*)smem + ul * (4 * 5 * 128);
    float* spart = (float*)smem + 4 * (4 * 5 * 128) + ul * 8;
    const bf16_t* proj = (const bf16_t*)(p.ws + WS_PHG);
    bf16_t* yb = (bf16_t*)(p.ws + WS_YB);
    const float l0 = p.in[15][c], l1 = p.in[15][512 + c];
    const float lb = 1.f / (1.f + __expf(l1 - l0));
    const float nw = p.in[16][c];
    float S[128];
#pragma unroll
    for (int e = 0; e < 128; ++e) S[e] = 0.f;
    for (int t0 = 0; t0 < SEQ; t0 += 4) {
        __syncthreads();
#pragma unroll
        for (int s = 0; s < 4; ++s) {
            const bf16_t* row = proj + (size_t)(b * SEQ + t0 + s) * NHG;
            const float z = bf2f(row[H_F + c]), qr = bf2f(row[H_Q + c]);
            const float sg = sigm(z);
            float* d = su + s * 5 * 128 + v;
            d[0] = lb + (1.f - lb) * sg; d[128] = (1.f - lb) * (1.f - sg); d[256] = qr * sigm(qr); d[384] = bf2f(row[H_I + c]); d[512] = bf2f(row[H_OG + c]);
        }
        __syncthreads();
        float os[4];
#pragma unroll
        for (int s = 0; s < 4; ++s) {
            const f32x4* vf = (const f32x4*)(su + s * 5 * 128); const f32x4* vk = vf + 32; const f32x4* vq = vf + 64;
            const float vin = su[s * 5 * 128 + 384 + v];
            float o = 0.f;
#pragma unroll
            for (int e4 = 0; e4 < 32; ++e4) {
                const f32x4 f4 = vf[e4], k4 = vk[e4], q4 = vq[e4];
#pragma unroll
                for (int q = 0; q < 4; ++q) { const float sn = f4[q] * S[e4 * 4 + q] + k4[q] * vin; S[e4 * 4 + q] = sn; o += q4[q] * sn; }
            }
            os[s] = o;
            const float ss = wave_sum(o * o);
            if (lane == 0) spart[s * 2 + wiu] = ss;
        }
        __syncthreads();
#pragma unroll
        for (int s = 0; s < 4; ++s) {
            const float tot = spart[s * 2] + spart[s * 2 + 1];
            const float og = su[s * 5 * 128 + 512 + v];
            yb[(size_t)(b * SEQ + t0 + s) * 512 + c] = f2bf(os[s] * rsqrtf(tot * (1.f / 128.f) + RMS_EPS) * nw * sigm(og));
        }
    }
}

DEVI bf16_t* kv_ptr(const Params& p, int unit) {
    return unit < 768 ? (bf16_t*)(p.ws + WS_PRW + 32 * MiB) + (size_t)unit * 16384 : (bf16_t*)((unsigned char*)p.out + 48 * MiB) + (size_t)(unit - 768) * 16384;
}
constexpr int H1_LDS = 74240;
DEVI void h1_issue(const Params& p, int pair, u32x4 (&pre)[12]) {
    const int tid = tidx(), hb = tid >> 8, lt = tid & 255, unit = pair * 2 + hb;
    const int c = unit & 63, bh = unit >> 6, h = bh & 3, b = bh >> 2, t0 = b * SEQ + c * 64;
    const bf16_t* phg = (const bf16_t*)(p.ws + WS_PHG);
#pragma unroll
    for (int i = 0; i < 4; ++i) {
        const int idx = lt + 256 * i, t = idx >> 4, ch = idx & 15;
        const bf16_t* row = phg + (size_t)(t0 + t) * NHG + h * 128 + ch * 8;
        pre[i * 3] = *(const u32x4*)(row + H_F); pre[i * 3 + 1] = *(const u32x4*)(row + H_Q); pre[i * 3 + 2] = *(const u32x4*)(row + H_I);
    }
}
DEVI void r1_issue(const Params& p, int pair, u32x4 (&pre)[12]) {
    const int tid = tidx(), hb = tid >> 8, lt = tid & 255, unit = pair * 2 + hb;
    const int c = unit & 63, bh = unit >> 6, h = bh & 7, b = bh >> 3, t0 = b * SEQ + c * 64, cb = h * 64;
#pragma unroll
    for (int i = 0; i < 2; ++i) {
        const int idx = lt + 256 * i, t = idx >> 3, ch = idx & 7; const size_t o = (size_t)(t0 + t) * 512 + cb + ch * 8;
        pre[i * 6] = *(const u32x4*)(prep_arr(p, 4) + o); pre[i * 6 + 1] = *(const u32x4*)(prep_arr(p, 5) + o); pre[i * 6 + 2] = *(const u32x4*)(prep_arr(p, 1) + o);
        pre[i * 6 + 3] = *(const u32x4*)(prep_arr(p, 3) + o); pre[i * 6 + 4] = *(const u32x4*)(prep_arr(p, 0) + o); pre[i * 6 + 5] = *(const u32x4*)(prep_arr(p, 2) + o);
    }
}
DEVI void next_issue(const Params& p, int kind, int pair, u32x4 (&pre)[12]) { if (kind == 1) r1_issue(p, pair, pre); else if (kind == 2) h1_issue(p, pair, pre); }
DEVI void hgrn_h1(const Params& p, unsigned char* smem, int pair, u32x4 (&pre)[12], int nkind, int npair) {
    const int tid = tidx(), hb = tid >> 8, lt = tid & 255, lw = lt >> 6, lane = tid & 63, fr = lane & 15, fq = lane >> 4;
    const int unit = pair * 2 + hb;
    const int c = unit & 63, bh = unit >> 6, h = bh & 3, b = bh >> 2, t0 = b * SEQ + c * 64;
    bf16_t* phg = (bf16_t*)(p.ws + WS_PHG);
    unsigned char* base = smem + hb * H1_LDS;
    bf16_t* sZ = (bf16_t*)base; bf16_t* sQ = sZ + 64 * 136; bf16_t* sKtT = sQ + 64 * 136; bf16_t* sVT = sKtT + 128 * 72; float* sG = (float*)(sVT + 128 * 72); float* sTot = sG + 128;
    __syncthreads();
#pragma unroll
    for (int i = 0; i < 4; ++i) {
        const int idx = lt + 256 * i, t = idx >> 4, ch = idx & 15;
        *(u32x4*)(sZ + t * 136 + ch * 8) = pre[i * 3];
        *(u32x4*)(sQ + t * 136 + ch * 8) = pre[i * 3 + 1];
        const u32x4 vv = pre[i * 3 + 2];
#pragma unroll
        for (int k = 0; k < 8; ++k) {
            const int j = (k + ch) & 7; const unsigned w = (j & 2) ? ((j & 4) ? vv[3] : vv[1]) : ((j & 4) ? vv[2] : vv[0]);
            sVT[(ch * 8 + j) * 72 + t] = (bf16_t)((j & 1) ? (w >> 16) : (w & 0xffffu));
        }
    }
    __syncthreads();
    const int e = lt & 127, th = lt >> 7, col = h * 128 + e;
    const float l0 = p.in[15][col], l1 = p.in[15][512 + col];
    const float lb = 1.f / (1.f + __expf(l1 - l0));
    float bs[32], kv[32];
    {
        float run = 0.f;
#pragma unroll
        for (int i = 0; i < 32; ++i) {
            const float z = bf2f(sZ[(th * 32 + i) * 136 + e]);
            const float sg = sigm(z), f = lb + (1.f - lb) * sg;
            kv[i] = (1.f - lb) * (1.f - sg);
            run += __logf(f); bs[i] = run;
        }
        sTot[th * 128 + e] = run;
    }
    __syncthreads();
    {
        const float off = th ? sTot[e] : 0.f;
        u32x4 pk[4];
#pragma unroll
        for (int i = 0; i < 32; i += 2) {
            const float b0 = off + bs[i], b1 = off + bs[i + 1];
            const float e0 = __expf(b0), e1 = __expf(b1);
            const float q0 = bf2f(sQ[(th * 32 + i) * 136 + e]), q1 = bf2f(sQ[(th * 32 + i + 1) * 136 + e]);
            const bf16_t kt0 = f2bf(kv[i] * __builtin_amdgcn_rcpf(e0)), kt1 = f2bf(kv[i + 1] * __builtin_amdgcn_rcpf(e1));
            const bf16_t qt0 = f2bf(q0 * sigm(q0) * e0), qt1 = f2bf(q1 * sigm(q1) * e1);
            pk[i >> 3][(i >> 1) & 3] = (unsigned)kt0 | ((unsigned)kt1 << 16);
            bf16_t* r0 = phg + (size_t)(t0 + th * 32 + i) * NHG + col; bf16_t* r1 = r0 + NHG;
            r0[H_F] = kt0; r0[H_Q] = qt0; r1[H_F] = kt1; r1[H_Q] = qt1;
        }
#pragma unroll
        for (int k = 0; k < 4; ++k) *(u32x4*)(sKtT + e * 72 + th * 32 + k * 8) = pk[k];
        if (th == 1) { const float G = __expf(off + bs[31]); sG[e] = G; ((float*)(p.ws + WS_GBUF))[(size_t)unit * 128 + e] = G; }
    }
    __syncthreads();
    next_issue(p, nkind, npair, pre);
    f32x4 acc[2][8]; accz(acc);
    mma_lds<2, 8, 2>(acc, sVT + lw * 32 * 72, 72, sKtT, 72);
    bf16_t* kvp = kv_ptr(p, unit);
#pragma unroll
    for (int m = 0; m < 2; ++m)
#pragma unroll
        for (int n = 0; n < 8; ++n) {
            const f32x4 g4 = *(const f32x4*)(sG + n * 16 + fq * 4);
            st_bf4(kvp + (size_t)(lw * 32 + m * 16 + fr) * 128 + n * 16 + fq * 4, acc[m][n] * g4);
        }
}
DEVI void hgrn_h2(const Params& p, int item) {
    const int bh = item >> 12, rem = item & 4095, off = (rem >> 5) * 128 + (rem & 31) * 4, eo = (rem & 31) * 4;
    const float* gbuf = (const float*)(p.ws + WS_GBUF);
    float S[4] = {0.f, 0.f, 0.f, 0.f};
    for (int c0 = 0; c0 < 64; c0 += 8) {
        u32x2 kv[8]; f32x4 g[8];
#pragma unroll
        for (int i = 0; i < 8; ++i) {
            const int unit = bh * 64 + c0 + i;
            kv[i] = *(const u32x2*)(kv_ptr(p, unit) + off);
            g[i] = *(const f32x4*)(gbuf + (size_t)unit * 128 + eo);
        }
#pragma unroll
        for (int i = 0; i < 8; ++i) {
            S[0] = g[i][0] * S[0] + __uint_as_float(kv[i][0] << 16); S[1] = g[i][1] * S[1] + __uint_as_float(kv[i][0] & 0xffff0000u);
            S[2] = g[i][2] * S[2] + __uint_as_float(kv[i][1] << 16); S[3] = g[i][3] * S[3] + __uint_as_float(kv[i][1] & 0xffff0000u);
            u32x2 o; o[0] = pack2(S[0], S[1]); o[1] = pack2(S[2], S[3]);
            *(u32x2*)(kv_ptr(p, bh * 64 + c0 + i) + off) = o;
        }
    }
}
DEVI void hgrn_h3(const Params& p, unsigned char* smem, int unit) {
    const int tid = tidx(), wid = tid >> 6, lane = tid & 63, fr = lane & 15, fq = lane >> 4;
    const int c = unit & 63, bh = unit >> 6, h = bh & 3, b = bh >> 2, t0 = b * SEQ + c * 64;
    bf16_t* phg = (bf16_t*)(p.ws + WS_PHG);
    bf16_t* sQt = (bf16_t*)smem; bf16_t* sKt = sQt + 64 * 136; bf16_t* sVT = sKt + 64 * 136; bf16_t* sS0 = sVT + 128 * 72; bf16_t* sAtt = sS0 + 128 * 136;
    float* sO = (float*)sS0;
    __syncthreads();
#pragma unroll
    for (int i = 0; i < 2; ++i) {
        const int idx = tid + 512 * i, t = idx >> 4, ch = idx & 15;
        const bf16_t* row = phg + (size_t)(t0 + t) * NHG + h * 128 + ch * 8;
        *(u32x4*)(sKt + t * 136 + ch * 8) = *(const u32x4*)(row + H_F);
        *(u32x4*)(sQt + t * 136 + ch * 8) = *(const u32x4*)(row + H_Q);
        const u32x4 vv = *(const u32x4*)(row + H_I);
#pragma unroll
        for (int k = 0; k < 8; ++k) {
            const int j = (k + ch) & 7; const unsigned w = (j & 2) ? ((j & 4) ? vv[3] : vv[1]) : ((j & 4) ? vv[2] : vv[0]);
            sVT[(ch * 8 + j) * 72 + t] = (bf16_t)((j & 1) ? (w >> 16) : (w & 0xffffu));
        }
    }
    {
        const bf16_t* s0 = c > 0 ? kv_ptr(p, unit - 1) : nullptr;
#pragma unroll
        for (int i = 0; i < 4; ++i) {
            const int idx = tid + 512 * i, v = idx >> 4, ch = idx & 15;
            u32x4 x = (u32x4){0u, 0u, 0u, 0u};
            if (c > 0) x = *(const u32x4*)(s0 + v * 128 + ch * 8);
            *(u32x4*)(sS0 + v * 136 + ch * 8) = x;
        }
    }
    __syncthreads();
    const int rb = wid >> 1, ch2 = wid & 1, t = rb * 16 + fr;
    {
        f32x4 at[1][2]; accz(at);
        mma_lds<1, 2, 4>(at, sQt + rb * 16 * 136, 136, sKt + ch2 * 32 * 136, 136);
#pragma unroll
        for (int n = 0; n < 2; ++n) {
            const int s0i = ch2 * 32 + n * 16 + fq * 4;
            f32x4 m;
#pragma unroll
            for (int x = 0; x < 4; ++x) m[x] = (s0i + x <= t) ? at[0][n][x] : 0.f;
            st_bf4(sAtt + t * 72 + s0i, m);
        }
    }
    f32x4 ao[1][4]; accz(ao);
    mma_lds<1, 4, 4>(ao, sQt + rb * 16 * 136, 136, sS0 + ch2 * 64 * 136, 136);
    __syncthreads();
    mma_lds<1, 4, 2>(ao, sAtt + rb * 16 * 72, 72, sVT + ch2 * 64 * 72, 72);
#pragma unroll
    for (int n = 0; n < 4; ++n) *(f32x4*)(sO + t * 132 + ch2 * 64 + n * 16 + fq * 4) = ao[0][n];
    __syncthreads();
    {
        const int te = tid >> 3, v0 = (tid & 7) * 16;
        f32x4 o[4]; float ss = 0.f;
#pragma unroll
        for (int k = 0; k < 4; ++k) { o[k] = *(const f32x4*)(sO + te * 132 + v0 + k * 4); ss += o[k][0] * o[k][0] + o[k][1] * o[k][1] + o[k][2] * o[k][2] + o[k][3] * o[k][3]; }
        ss += __shfl_xor(ss, 1, 64); ss += __shfl_xor(ss, 2, 64); ss += __shfl_xor(ss, 4, 64);
        const float rstd = rsqrtf(ss * (1.f / 128.f) + RMS_EPS);
        bf16_t* row = phg + (size_t)(t0 + te) * NHG + h * 128 + v0;
        const float* nw = p.in[16] + h * 128 + v0;
#pragma unroll
        for (int k = 0; k < 4; ++k) {
            const f32x4 og = ld_bf4(row + H_OG + k * 4), w4 = *(const f32x4*)(nw + k * 4);
            f32x4 r;
#pragma unroll
            for (int x = 0; x < 4; ++x) r[x] = o[k][x] * rstd * w4[x] * sigm(og[x]);
            st_bf4((bf16_t*)(p.ws + WS_YAB) + (size_t)(t0 + te) * 1024 + 512 + h * 128 + v0 + k * 4, r);
        }
    }
}


constexpr int R1_LDS = 81152;
DEVI void rwkv_r1(const Params& p, unsigned char* smem, int pair, u32x4 (&pre)[12], int nkind, int npair) {
    const int tid = tidx(), hb = tid >> 8, lt = tid & 255, lw = lt >> 6, lane = tid & 63, fr = lane & 15, fq = lane >> 4;
    const int unit = pair * 2 + hb;
    const int c = unit & 63, bh = unit >> 6, h = bh & 7, b = bh >> 3, t0 = b * SEQ + c * 64, cb = h * 64;
    bf16_t* aR = prep_arr(p, 0); bf16_t* aK = prep_arr(p, 1); bf16_t* aV = prep_arr(p, 2); bf16_t* aW = prep_arr(p, 3);
    bf16_t* aKK = prep_arr(p, 4); bf16_t* aA = prep_arr(p, 5);
    unsigned char* base = smem + hb * R1_LDS;
    float* sAab = (float*)base; float* sWC = sAab + 64 * 64;
    bf16_t* sAt = (bf16_t*)(sWC + 64); bf16_t* sBt = sAt + 64 * 72; bf16_t* sKt = sBt + 64 * 72; bf16_t* sBtT = sKt + 64 * 72; bf16_t* sKtT = sBtT + 64 * 72;
    bf16_t* sVT = sKtT + 64 * 72; bf16_t* sAak = sVT + 64 * 72;
    float* sP = (float*)sBt;
    bf16_t* sLW = (bf16_t*)sAab; bf16_t* sR = sBtT; float* sTot = (float*)sKtT;
    bf16_t* sX1T = sAt; bf16_t* sUT = sAak;
    __syncthreads();
#pragma unroll
    for (int i = 0; i < 2; ++i) {
        const int idx = lt + 256 * i, t = idx >> 3, ch = idx & 7; const int lo = t * 72 + ch * 8;
        *(u32x4*)(sAt + lo) = pre[i * 6];
        *(u32x4*)(sBt + lo) = pre[i * 6 + 1];
        *(u32x4*)(sKt + lo) = pre[i * 6 + 2];
        *(u32x4*)(sLW + lo) = pre[i * 6 + 3];
        *(u32x4*)(sR + lo) = pre[i * 6 + 4];
        const u32x4 vv = pre[i * 6 + 5];
#pragma unroll
        for (int k = 0; k < 8; ++k) {
            const int j = (k + ch) & 7; const unsigned w = (j & 2) ? ((j & 4) ? vv[3] : vv[1]) : ((j & 4) ? vv[2] : vv[0]);
            sVT[(ch * 8 + j) * 72 + t] = (bf16_t)((j & 1) ? (w >> 16) : (w & 0xffffu));
        }
    }
    __syncthreads();
    const int j = lt & 63, tq = lt >> 6;
    float ls[16];
    {
        float run = 0.f;
#pragma unroll
        for (int i = 0; i < 16; ++i) { run += bf2f(sLW[(tq * 16 + i) * 72 + j]); ls[i] = run; }
        sTot[tq * 64 + j] = run;
    }
    __syncthreads();
    {
        float off = 0.f;
#pragma unroll
        for (int k = 0; k < 3; ++k) off += (k < tq) ? sTot[k * 64 + j] : 0.f;
        float kkv[16], av[16], kp[16], rv[16];
#pragma unroll
        for (int i = 0; i < 16; ++i) { const int lo = (tq * 16 + i) * 72 + j; kkv[i] = bf2f(sAt[lo]); av[i] = bf2f(sBt[lo]); kp[i] = bf2f(sKt[lo]); rv[i] = bf2f(sR[lo]); }
        __syncthreads();
        u32x4 pb[2], pkk[2];
        float eprev = __expf(off);
#pragma unroll
        for (int i = 0; i < 16; ++i) {
            const float ecur = __expf(off + ls[i]), einv = __builtin_amdgcn_rcpf(ecur);
            const bf16_t at = f2bf(-kkv[i] * eprev), bt = f2bf(kkv[i] * av[i] * einv), kt = f2bf(kp[i] * einv), rt = f2bf(rv[i] * ecur);
            eprev = ecur;
            const int lo = (tq * 16 + i) * 72 + j;
            sAt[lo] = at; sBt[lo] = bt; sKt[lo] = kt;
            if (i & 1) { pb[i >> 3][(i >> 1) & 3] |= (unsigned)bt << 16; pkk[i >> 3][(i >> 1) & 3] |= (unsigned)kt << 16; }
            else { pb[i >> 3][(i >> 1) & 3] = (unsigned)bt; pkk[i >> 3][(i >> 1) & 3] = (unsigned)kt; }
            const size_t o = (size_t)(t0 + tq * 16 + i) * 512 + cb + j;
            aR[o] = rt; aK[o] = kt; aKK[o] = bt;
        }
        *(u32x4*)(sBtT + j * 72 + tq * 16) = pb[0]; *(u32x4*)(sBtT + j * 72 + tq * 16 + 8) = pb[1];
        *(u32x4*)(sKtT + j * 72 + tq * 16) = pkk[0]; *(u32x4*)(sKtT + j * 72 + tq * 16 + 8) = pkk[1];
        if (tq == 3) sWC[j] = eprev;
    }
    __syncthreads();
    const int tr = lw * 16 + fr;
    {
        f32x4 ab[1][4], ak[1][4]; accz(ab); accz(ak);
        mma_lds<1, 4, 2>(ab, sAt + lw * 16 * 72, 72, sBt, 72);
        mma_lds<1, 4, 2>(ak, sAt + lw * 16 * 72, 72, sKt, 72);
#pragma unroll
        for (int n = 0; n < 4; ++n) {
            const int s0 = n * 16 + fq * 4;
            f32x4 m1, m2;
#pragma unroll
            for (int x = 0; x < 4; ++x) { const bool keep = (s0 + x) < tr; m1[x] = keep ? ab[0][n][x] : 0.f; m2[x] = keep ? ak[0][n][x] : 0.f; }
            *(f32x4*)(sAab + tr * 64 + s0) = m1;
            st_bf4(sAak + tr * 72 + s0, m2);
        }
    }
    __syncthreads();
    {
        f32x4 pp[1][4]; accz(pp);
        mma_lds<1, 4, 2>(pp, sAak + lw * 16 * 72, 72, sVT, 72);
#pragma unroll
        for (int n = 0; n < 4; ++n) *(f32x4*)(sP + tr * 64 + n * 16 + fq * 4) = pp[0][n];
    }
    __syncthreads();
    f32x2 x2[32];
    const bool solver = ((lt >> 7) == hb);
    const int sc = lt & 127;
    if (solver) {
        if (sc < 64) {
#pragma unroll
            for (int t = 0; t < 64; ++t) x2[t >> 1][t & 1] = bf2f(sAt[t * 72 + sc]);
        } else {
#pragma unroll
            for (int t = 0; t < 64; ++t) x2[t >> 1][t & 1] = sP[t * 64 + sc - 64];
        }
    }
    __syncthreads();
    next_issue(p, nkind, npair, pre);
    if (solver) {
#pragma unroll
        for (int t = 1; t < 64; ++t) {
            if (t >= 8) asm volatile("" : "+v"(x2[(t - 8) >> 1]) :: "memory"); else asm volatile("" ::: "memory");
            const f32x4* arow = (const f32x4*)(sAab + t * 64);
            f32x2 a0 = (f32x2){0.f, 0.f}, a1 = (f32x2){0.f, 0.f}, a2 = (f32x2){0.f, 0.f}, a3 = (f32x2){0.f, 0.f};
#pragma unroll
            for (int s4 = 0; s4 < (t + 3) / 4; ++s4) {
                const f32x4 a4 = arow[s4];
                if (s4 & 1) { a2 += (f32x2){a4[0], a4[1]} * x2[2 * s4]; a3 += (f32x2){a4[2], a4[3]} * x2[2 * s4 + 1]; }
                else { a0 += (f32x2){a4[0], a4[1]} * x2[2 * s4]; a1 += (f32x2){a4[2], a4[3]} * x2[2 * s4 + 1]; }
            }
            const f32x2 sm = (a0 + a1) + (a2 + a3);
            x2[t >> 1][t & 1] += sm[0] + sm[1];
        }
        const int col = sc & 63;
        bf16_t* srow = (sc < 64 ? sX1T : sUT) + col * 72;
        bf16_t* gdst = (sc < 64 ? aA : aW) + (size_t)t0 * 512 + cb + col;
#pragma unroll
        for (int t = 0; t < 64; t += 2) {
            const unsigned pk = pack2(x2[t >> 1][0], x2[t >> 1][1]);
            *(unsigned*)(srow + t) = pk;
            gdst[(size_t)t * 512] = (bf16_t)(pk & 0xffffu); gdst[(size_t)(t + 1) * 512] = (bf16_t)(pk >> 16);
        }
    }
    __syncthreads();
    {
        float* Mg = (float*)(p.ws + WS_PRW) + (size_t)unit * 4096; float* Ng = (float*)(p.ws + WS_XB) + (size_t)unit * 4096;
        f32x4 am[1][4]; accz(am);
        mma_lds<1, 4, 2>(am, sBtT + lw * 16 * 72, 72, sX1T, 72);
        const float wcj = sWC[tr];
#pragma unroll
        for (int n = 0; n < 4; ++n) {
            const int j0 = n * 16 + fq * 4;
            f32x4 o;
#pragma unroll
            for (int xx = 0; xx < 4; ++xx) {
                const float mv = am[0][n][xx] * wcj;
                if ((j0 + xx) == tr) { Mg[2048 + tr] = mv + wcj; o[xx] = 0.f; } else o[xx] = mv;
            }
            st_bf4((bf16_t*)Mg + tr * 64 + j0, o);
        }
        f32x4 an[1][4]; accz(an);
        mma_lds<1, 4, 2>(an, sUT + lw * 16 * 72, 72, sBtT, 72);
        mma_lds<1, 4, 2>(an, sVT + lw * 16 * 72, 72, sKtT, 72);
#pragma unroll
        for (int n = 0; n < 4; ++n) {
            const int j0 = n * 16 + fq * 4;
            const f32x4 w4 = *(const f32x4*)(sWC + j0);
            *(f32x4*)(Ng + tr * 64 + j0) = an[0][n] * w4;
        }
    }
}
DEVI void rwkv_r2(const Params& p, unsigned char* smem, int grp) {
    const int tid = tidx(), lane = tid & 63, jb = tid >> 6, q = lane >> 4, cl = lane & 15;
    const int bh = grp >> 2, ib = grp & 3;
    f32x4* zb = (f32x4*)smem;
    if (jb >= 4) {
        float* Zs = (float*)(p.ws + WS_XB) + (size_t)bh * 64 * 4096 + (ib * 16 + cl) * 64 + (jb - 4) * 16 + 4 * q;
        for (int c = 0; c < 64; ++c) {
            __builtin_amdgcn_s_barrier(); asm volatile("" ::: "memory");
            *(f32x4*)(Zs + (size_t)c * 4096) = zb[((c & 1) * 4 + (jb - 4)) * 64 + lane];
            asm volatile("s_waitcnt lgkmcnt(0)" ::: "memory");
        }
        return;
    }
    const float* Mu = (const float*)(p.ws + WS_PRW) + (size_t)bh * 64 * 4096;
    const bf16_t* Mb = (const bf16_t*)Mu + (jb * 16 + cl) * 64 + 4 * q;
    const float* Db = Mu + 2048 + jb * 16 + cl;
    const bool ondiag = ((cl >> 2) == q);
    float* Nb = (float*)(p.ws + WS_XB) + (size_t)bh * 64 * 4096 + (ib * 16 + cl) * 64 + jb * 16 + 4 * q;
    f32x4 z[4];
#pragma unroll
    for (int kb = 0; kb < 4; ++kb) z[kb] = (f32x4){0.f, 0.f, 0.f, 0.f};
    u32x2 mq[8][4]; float dq[8]; f32x4 nq[8];
#pragma unroll
    for (int i = 0; i < 8; ++i) {
#pragma unroll
        for (int kb = 0; kb < 4; ++kb) mq[i][kb] = *(const u32x2*)(Mb + (size_t)i * 8192 + kb * 16);
        dq[i] = Db[(size_t)i * 4096];
        nq[i] = *(const f32x4*)(Nb + (size_t)i * 4096);
    }
#define R2_STEP(I, C) do { \
        f32x4 acc = nq[I], acc2 = (f32x4){0.f, 0.f, 0.f, 0.f}; f32x4 mf[4]; \
        _Pragma("unroll") for (int kb = 0; kb < 4; ++kb) { mf[kb][0] = __uint_as_float(mq[I][kb][0] << 16); mf[kb][1] = __uint_as_float(mq[I][kb][0] & 0xffff0000u); mf[kb][2] = __uint_as_float(mq[I][kb][1] << 16); mf[kb][3] = __uint_as_float(mq[I][kb][1] & 0xffff0000u); } \
        if (ondiag) { _Pragma("unroll") for (int kb = 0; kb < 4; ++kb) _Pragma("unroll") for (int ks = 0; ks < 4; ++ks) if (kb == jb && ks == (cl & 3)) mf[kb][ks] = dq[I]; } \
        _Pragma("unroll") for (int ks = 0; ks < 4; ++ks) { \
            acc = __builtin_amdgcn_mfma_f32_16x16x4f32(mf[0][ks], z[0][ks], acc, 0, 0, 0); acc2 = __builtin_amdgcn_mfma_f32_16x16x4f32(mf[1][ks], z[1][ks], acc2, 0, 0, 0); \
            acc = __builtin_amdgcn_mfma_f32_16x16x4f32(mf[2][ks], z[2][ks], acc, 0, 0, 0); acc2 = __builtin_amdgcn_mfma_f32_16x16x4f32(mf[3][ks], z[3][ks], acc2, 0, 0, 0); } \
        acc += acc2; \
        const int cn = (C) + 8 < 64 ? (C) + 8 : 63; \
        _Pragma("unroll") for (int kb = 0; kb < 4; ++kb) mq[I][kb] = *(const u32x2*)(Mb + (size_t)cn * 8192 + kb * 16); \
        dq[I] = Db[(size_t)cn * 4096]; \
        nq[I] = *(const f32x4*)(Nb + (size_t)cn * 4096); \
        zb[(((C) & 1) * 4 + jb) * 64 + lane] = acc; \
        asm volatile("s_waitcnt lgkmcnt(0)" ::: "memory"); __builtin_amdgcn_s_barrier(); asm volatile("" ::: "memory");     \
        _Pragma("unroll") for (int kb = 0; kb < 4; ++kb) z[kb] = zb[(((C) & 1) * 4 + kb) * 64 + lane]; \
    } while (0)
    for (int c = 0; c < 64; c += 8) { R2_STEP(0, c); R2_STEP(1, c + 1); R2_STEP(2, c + 2); R2_STEP(3, c + 3); R2_STEP(4, c + 4); R2_STEP(5, c + 5); R2_STEP(6, c + 6); R2_STEP(7, c + 7); }
#undef R2_STEP
}
constexpr int R3_LDS = 6 * 64 * 72 * 2;
DEVI void rwkv_r3(const Params& p, unsigned char* smem, int unit0) {
    const int tid = tidx(), hb = tid >> 8, lt = tid & 255, lw = lt >> 6, lane = tid & 63, fr = lane & 15, fq = lane >> 4;
    const int unit = unit0 + hb;
    const int c = unit & 63, bh = unit >> 6, h = bh & 7, b = bh >> 3, t0 = b * SEQ + c * 64, cb = h * 64;
    const bf16_t* aR = prep_arr(p, 0); const bf16_t* aK = prep_arr(p, 1); const bf16_t* aV = prep_arr(p, 2); const bf16_t* aU = prep_arr(p, 3);
    const bf16_t* aB = prep_arr(p, 4); const bf16_t* aX = prep_arr(p, 5); const bf16_t* aG = prep_arr(p, 6);
    bf16_t* sRt = (bf16_t*)(smem + hb * R3_LDS); bf16_t* sKt = sRt + 64 * 72; bf16_t* sVT = sKt + 64 * 72; bf16_t* sBt = sVT + 64 * 72; bf16_t* sX1 = sBt + 64 * 72; bf16_t* sZ0 = sX1 + 64 * 72;
    bf16_t* sUT = sBt; bf16_t* sArb = sX1; bf16_t* sArk = sZ0;
    float* sY = (float*)sBt;
    __syncthreads();
#pragma unroll
    for (int i = 0; i < 2; ++i) {
        const int idx = lt + 256 * i, t = idx >> 3, ch = idx & 7; const size_t o = (size_t)(t0 + t) * 512 + cb + ch * 8; const int lo = t * 72 + ch * 8;
        *(u32x4*)(sRt + lo) = *(const u32x4*)(aR + o);
        *(u32x4*)(sBt + lo) = *(const u32x4*)(aB + o);
        *(u32x4*)(sKt + lo) = *(const u32x4*)(aK + o);
        *(u32x4*)(sX1 + lo) = *(const u32x4*)(aX + o);
        const u32x4 vv = *(const u32x4*)(aV + o);
#pragma unroll
        for (int k = 0; k < 8; ++k) {
            const int j = (k + ch) & 7; const unsigned w = (j & 2) ? ((j & 4) ? vv[3] : vv[1]) : ((j & 4) ? vv[2] : vv[0]);
            sVT[(ch * 8 + j) * 72 + t] = (bf16_t)((j & 1) ? (w >> 16) : (w & 0xffffu));
        }
        u32x4 zz = (u32x4){0u, 0u, 0u, 0u};
        if (c > 0) {
            const float* Z = (const float*)(p.ws + WS_XB) + (size_t)(unit - 1) * 4096 + t * 64 + ch * 8;
            const f32x4 z0 = *(const f32x4*)Z, z1 = *(const f32x4*)(Z + 4);
            zz[0] = pack2(z0[0], z0[1]); zz[1] = pack2(z0[2], z0[3]); zz[2] = pack2(z1[0], z1[1]); zz[3] = pack2(z1[2], z1[3]);
        }
        *(u32x4*)(sZ0 + lo) = zz;
    }
    __syncthreads();
    const int tr = lw * 16 + fr;
    f32x4 ay[1][4], au[1][4], a1[1][4], a2[1][4]; accz(ay); accz(au); accz(a1); accz(a2);
    mma_lds<1, 4, 2>(au, sX1 + lw * 16 * 72, 72, sZ0, 72);
    mma_lds<1, 4, 2>(a1, sRt + lw * 16 * 72, 72, sBt, 72);
    mma_lds<1, 4, 2>(a2, sRt + lw * 16 * 72, 72, sKt, 72);
    mma_lds<1, 4, 2>(ay, sRt + lw * 16 * 72, 72, sZ0, 72);
    __syncthreads();
    u32x2 ulr[4];
#pragma unroll
    for (int n = 0; n < 4; ++n) ulr[n] = *(const u32x2*)(aU + (size_t)(t0 + tr) * 512 + cb + n * 16 + fq * 4);
#pragma unroll
    for (int n = 0; n < 4; ++n) {
        const int i0 = n * 16 + fq * 4;
        f32x4 ul; ul[0] = __uint_as_float(ulr[n][0] << 16); ul[1] = __uint_as_float(ulr[n][0] & 0xffff0000u); ul[2] = __uint_as_float(ulr[n][1] << 16); ul[3] = __uint_as_float(ulr[n][1] & 0xffff0000u);
#pragma unroll
        for (int x = 0; x < 4; ++x) sUT[(i0 + x) * 72 + tr] = f2bf(au[0][n][x] + ul[x]);
        f32x4 m1, m2;
#pragma unroll
        for (int x = 0; x < 4; ++x) { const bool keep = (i0 + x) <= tr; m1[x] = keep ? a1[0][n][x] : 0.f; m2[x] = keep ? a2[0][n][x] : 0.f; }
        st_bf4(sArb + tr * 72 + i0, m1); st_bf4(sArk + tr * 72 + i0, m2);
    }
    __syncthreads();
    mma_lds<1, 4, 2>(ay, sArb + lw * 16 * 72, 72, sUT, 72);
    mma_lds<1, 4, 2>(ay, sArk + lw * 16 * 72, 72, sVT, 72);
    __syncthreads();
#pragma unroll
    for (int n = 0; n < 4; ++n) *(f32x4*)(sY + tr * 68 + n * 16 + fq * 4) = ay[0][n];
    __syncthreads();
    {
        const int te = lt >> 2, i0 = (lt & 3) * 16;
        float s = 0.f, bon = 0.f;
        f32x4 y4[4];
        const float* rk = p.in[11] + cb + i0;
#pragma unroll
        for (int k = 0; k < 4; ++k) { y4[k] = *(const f32x4*)(sY + te * 68 + i0 + k * 4); s += y4[k][0] + y4[k][1] + y4[k][2] + y4[k][3]; }
#pragma unroll
        for (int k = 0; k < 16; ++k) bon += bf2f(sRt[te * 72 + i0 + k]) * bf2f(sKt[te * 72 + i0 + k]) * rk[k];
        s += __shfl_xor(s, 1, 64); s += __shfl_xor(s, 2, 64);
        bon += __shfl_xor(bon, 1, 64); bon += __shfl_xor(bon, 2, 64);
        const float mean = s * (1.f / 64.f);
        float s2 = 0.f;
#pragma unroll
        for (int k = 0; k < 16; ++k) { const float d = y4[k >> 2][k & 3] - mean; s2 += d * d; }
        s2 += __shfl_xor(s2, 1, 64); s2 += __shfl_xor(s2, 2, 64);
        const float rstd = rsqrtf(s2 * (1.f / 64.f) + GN_EPS);
        const size_t o = (size_t)(t0 + te) * 512 + cb + i0;
        const float* gw = p.in[12] + cb + i0; const float* gb = p.in[13] + cb + i0;
#pragma unroll
        for (int hh = 0; hh < 2; ++hh) {
            const u32x4 gg = *(const u32x4*)(aG + o + hh * 8);
            float r[8];
#pragma unroll
            for (int k = 0; k < 8; ++k) {
                const int kk = hh * 8 + k;
                const float g = (k & 1) ? __uint_as_float(gg[k >> 1] & 0xffff0000u) : __uint_as_float(gg[k >> 1] << 16);
                const float v = bf2f(sVT[(i0 + kk) * 72 + te]);
                r[k] = ((y4[kk >> 2][kk & 3] - mean) * rstd * gw[kk] + gb[kk] + bon * v) * g;
            }
            u32x4 ov; ov[0] = pack2(r[0], r[1]); ov[1] = pack2(r[2], r[3]); ov[2] = pack2(r[4], r[5]); ov[3] = pack2(r[6], r[7]);
            *(u32x4*)((bf16_t*)(p.ws + WS_YAB) + (size_t)(t0 + te) * 1024 + cb + i0 + hh * 8) = ov;
        }
    }
}

DEVI void phase_scans_naive(const Params& p, unsigned char* smem) {
    if (blockIdx.x < 4) scan_rwkv_naive(p, smem, blockIdx.x);
    else if (blockIdx.x < 8) scan_hgrn_naive(p, smem, blockIdx.x - 4);
}
DEVI void phase_3a(const Params& p, unsigned char* smem) {
    u32x4 pre[12];
    int u = blockIdx.x;
    if (u < 1536) { if (u < 1024) r1_issue(p, u, pre); else h1_issue(p, u - 1024, pre); }
    for (; u < 1536; u += gridDim.x) {
        const int un = u + gridDim.x, nkind = un < 1536 ? (un < 1024 ? 1 : 2) : 0, npair = un < 1024 ? un : un - 1024;
        if (u < 1024) rwkv_r1(p, smem, u, pre, nkind, npair); else hgrn_h1(p, smem, u - 1024, pre, nkind, npair);
    }
}
DEVI void phase_3b(const Params& p, unsigned char* smem) {
    if (blockIdx.x < 128) { const int x = blockIdx.x & 7, k = blockIdx.x >> 3; rwkv_r2(p, smem, ((x + 8 * (k >> 2)) << 2) | (k & 3)); }
    else hgrn_h2(p, (blockIdx.x - 128) * 512 + tidx());
}
DEVI void phase_3c(const Params& p, unsigned char* smem) {
    for (int u = blockIdx.x; u < 2048; u += gridDim.x) { if (u < 1024) rwkv_r3(p, smem, u * 2); else hgrn_h3(p, smem, u - 1024); }
}

struct EpiMerge {
    static constexpr bool PERM = true; const bf16_t* pgt; bf16_t* merged;
    DEVI void operator()(const f32x4 (&acc)[2][2][4][2], const PUnit& u, int wr, int wc, int fr, int fq) const {
        const int row0 = u.pm * 256 + wr * 64 + fr, col = u.pn * 128 + wc * 32 + 8 * fq;
#pragma unroll
        for (int ai = 0; ai < 2; ++ai) {
            u32x4 ga[4], gb[4];
#pragma unroll
            for (int m = 0; m < 4; ++m) { const size_t row = row0 + ai * 128 + m * 16; ga[m] = *(const u32x4*)(pgt + row * NHG + col); gb[m] = *(const u32x4*)(pgt + row * NHG + 1024 + col); }
#pragma unroll
            for (int m = 0; m < 4; ++m) {
                const size_t row = row0 + ai * 128 + m * 16;
                f32x4 o0, o1;
#pragma unroll
                for (int q = 0; q < 4; ++q) {
                    const float a0 = (q & 1) ? __uint_as_float(ga[m][q >> 1] & 0xffff0000u) : __uint_as_float(ga[m][q >> 1] << 16), a1 = (q & 1) ? __uint_as_float(ga[m][2 + (q >> 1)] & 0xffff0000u) : __uint_as_float(ga[m][2 + (q >> 1)] << 16);
                    const float b0 = (q & 1) ? __uint_as_float(gb[m][q >> 1] & 0xffff0000u) : __uint_as_float(gb[m][q >> 1] << 16), b1 = (q & 1) ? __uint_as_float(gb[m][2 + (q >> 1)] & 0xffff0000u) : __uint_as_float(gb[m][2 + (q >> 1)] << 16);
                    o0[q] = sigm(a0) * acc[ai][0][m][0][q] + sigm(b0) * acc[ai][1][m][0][q];
                    o1[q] = sigm(a1) * acc[ai][0][m][1][q] + sigm(b1) * acc[ai][1][m][1][q];
                }
                *(u32x4*)(merged + row * 1024 + col) = pk8(o0, o1);
            }
        }
    }
};
DEVI void phase_merge(const Params& p, unsigned char* smem) {
    TileOrder S; S.init((const bf16_t*)(p.ws + WS_YAB), 1024, (const bf16_t*)(p.ws + WS_WCAT), 1024, NTOK, 2048);
    pgemm((PG_LAS unsigned char*)smem, 1024, 1024, S, EpiMerge{(const bf16_t*)(p.ws + WS_PGT), (bf16_t*)(p.ws + WS_MERGED)});
}

struct EpiWo {
    static constexpr bool PERM = false; const float* x; float* x1pre;
    DEVI void operator()(const f32x4 (&acc)[2][2][4][2], const PUnit& u, int wr, int wc, int fr, int fq) const {
        const int row0 = u.pm * 256 + wr * 64 + fr, col0 = u.pn * 256 + wc * 32 + 4 * fq;
#pragma unroll
        for (int ai = 0; ai < 2; ++ai)
#pragma unroll
            for (int mh = 0; mh < 2; ++mh) {
                f32x4 xv[2][2][2];
#pragma unroll
                for (int mm = 0; mm < 2; ++mm)
#pragma unroll
                    for (int bj = 0; bj < 2; ++bj)
#pragma unroll
                        for (int n = 0; n < 2; ++n) xv[mm][bj][n] = *(const f32x4*)(x + (size_t)(row0 + ai * 128 + (mh * 2 + mm) * 16) * 1024 + col0 + bj * 128 + n * 16);
#pragma unroll
                for (int mm = 0; mm < 2; ++mm)
#pragma unroll
                    for (int bj = 0; bj < 2; ++bj)
#pragma unroll
                        for (int n = 0; n < 2; ++n) {
                            const size_t o = (size_t)(row0 + ai * 128 + (mh * 2 + mm) * 16) * 1024 + col0 + bj * 128 + n * 16;
                            *(f32x4*)(x1pre + o) = xv[mm][bj][n] * ALPHA + acc[ai][bj][mh * 2 + mm][n];
                        }
            }
    }
};
DEVI void phase_wo(const Params& p, unsigned char* smem) {
    {
        TileOrder S; S.init((const bf16_t*)(p.ws + WS_MERGED), 1024, (const bf16_t*)(p.ws + WS_WOT), 1024, NTOK, 1024);
        pgemm((PG_LAS unsigned char*)smem, 1024, 1024, S, EpiWo{p.in[0], p.out});
    }
    constexpr int T_W = 1024;
    struct Job { const float* src; bf16_t* dst; int C, dld, kb, nb, w13; };
    auto job = [&](int t) {
        Job j; const int which = t / T_W, u = t - which * T_W, e = u >> 5, tt = u & 31;
        if (which < 2) { j.kb = tt >> 1; j.nb = tt & 1; j.C = 512; j.dld = 1024; j.w13 = 1;
            j.src = p.in[25 + which] + (size_t)e * 1024 * 512; j.dst = (bf16_t*)(p.ws + WS_W1T) + (size_t)e * 1024 * 1024 + (size_t)which * 128 * 1024; }
        else { j.kb = tt >> 2; j.nb = tt & 3; j.C = 1024; j.dld = 512; j.w13 = 0;
            j.src = p.in[27] + (size_t)e * 512 * 1024; j.dst = (bf16_t*)(p.ws + WS_W2T) + (size_t)e * 1024 * 512; }
        return j;
    };
    auto wload = [&](f32x4 (&v)[8], const Job& j) {
        const int tid = tidx();
#pragma unroll
        for (int i = 0; i < 8; ++i) v[i] = *(const f32x4*)(j.src + (size_t)(j.kb * 64 + (tid >> 6) + 8 * i) * j.C + j.nb * 256 + (tid & 63) * 4);
    };
    auto wfinish = [&](const f32x4 (&v)[8], const Job& j) {
        float* sm = (float*)smem; const int tid = tidx();
        asm volatile("s_waitcnt lgkmcnt(0)" ::: "memory"); __builtin_amdgcn_s_barrier(); asm volatile("" ::: "memory");
#pragma unroll
        for (int i = 0; i < 8; ++i) *(f32x4*)(sm + ((tid >> 6) + 8 * i) * 260 + (tid & 63) * 4) = v[i];
        asm volatile("s_waitcnt lgkmcnt(0)" ::: "memory"); __builtin_amdgcn_s_barrier(); asm volatile("" ::: "memory");
        const int n = tid >> 1, k32 = (tid & 1) * 32, ng = j.nb * 256 + n;
        const int drow = j.w13 ? ((ng >> 7) * 256 + (ng & 127)) : ng;
#pragma unroll
        for (int q = 0; q < 4; ++q) {
            float w[8];
#pragma unroll
            for (int k = 0; k < 8; ++k) w[k] = sm[(k32 + q * 8 + k) * 260 + n];
            u32x4 o; o[0] = pack2(w[0], w[1]); o[1] = pack2(w[2], w[3]); o[2] = pack2(w[4], w[5]); o[3] = pack2(w[6], w[7]);
            *(u32x4*)(j.dst + (size_t)drow * j.dld + j.kb * 64 + k32 + q * 8) = o;
        }
    };
    int t = blockIdx.x;
    if (t < 3 * T_W) {
        f32x4 va[8], vb[8];
        Job ja = job(t); wload(va, ja);
        for (;;) {
            const int tn = t + gridDim.x; const bool more = tn < 3 * T_W;
            Job jb = ja; if (more) { jb = job(tn); wload(vb, jb); }
            wfinish(va, ja);
            if (!more) break;
            t = tn + gridDim.x; const bool more2 = t < 3 * T_W;
            if (more2) { ja = job(t); wload(va, ja); }
            wfinish(vb, jb);
            if (!more2) break;
        }
    }
}

DEVI void phase_ln1_route(const Params& p, unsigned char* smem) {
    const float* x1pre = p.out; float* x1 = (float*)(p.ws + WS_X1); bf16_t* x1b = (bf16_t*)(p.ws + WS_X1B);
    const float* g = p.in[19]; const float* bta = p.in[20];
    const float* wg = p.in[21]; const float* bg = p.in[22]; const float* we = p.in[23]; const float* be = p.in[24];
    int* cnt = (int*)(p.ws + WS_CNT); int* slot = (int*)(p.ws + WS_SLOT); float* tw = (float*)(p.ws + WS_TW); int* list = (int*)(p.ws + WS_LIST);
    f32x4* sW = (f32x4*)smem;
    f32x4* sLog = (f32x4*)(smem + 49152);
    int* sLcnt = (int*)(smem + 49152 + 9216); int* sLbase = sLcnt + 32; int* sTok = sLbase + 32;
    for (int blk = blockIdx.x; blk < NTOK / 64; blk += gridDim.x) {
        int tid = tidx();
        const int lane = tid & 63, wid = tid >> 6, jt = lane >> 3, cg = lane & 7;
        __syncthreads();
        if (tid < 32) sLcnt[tid] = 0;
#pragma unroll 1
        for (int j = 0; j < 8; ++j) {
            const int tk = blk * 64 + wid * 8 + j;
            f32x4 xv[4]; float s = 0.f;
#pragma unroll
            for (int i = 0; i < 4; ++i) { xv[i] = *(const f32x4*)(x1pre + (size_t)tk * 1024 + i * 256 + lane * 4); s += xv[i][0] + xv[i][1] + xv[i][2] + xv[i][3]; }
            const float mean = wave_sum(s) * (1.f / 1024.f);
            float s2 = 0.f;
#pragma unroll
            for (int i = 0; i < 4; ++i)
#pragma unroll
                for (int q = 0; q < 4; ++q) { const float d = xv[i][q] - mean; s2 += d * d; }
            const float rstd = rsqrtf(wave_sum(s2) * (1.f / 1024.f) + LN_EPS);
#pragma unroll
            for (int i = 0; i < 4; ++i) {
                const int col = i * 256 + lane * 4;
                const f32x4 g4 = *(const f32x4*)(g + col), b4 = *(const f32x4*)(bta + col);
#pragma unroll
                for (int q = 0; q < 4; ++q) xv[i][q] = (xv[i][q] - mean) * rstd * g4[q] + b4[q];
                *(f32x4*)(x1 + (size_t)tk * 1024 + col) = xv[i];
                st_bf4(x1b + (size_t)tk * 1024 + col, xv[i]);
            }
        }
        const int tkb = blk * 64 + wid * 8 + jt;
        for (int ug = 0; ug < 3; ++ug) {
            __syncthreads();
#pragma unroll
            for (int r = 0; r < 6; ++r) {
                const int idx = tid + 512 * r, ul = idx >> 10, col = idx & 1023;
                sW[ul * 1024 + ((col & ~31) | ((col & 3) << 3) | ((col >> 2) & 7))] = ((const f32x4*)(p.ws + WS_WR))[ug * 3072 + idx];
            }
            __syncthreads();
            float a[12];
#pragma unroll
            for (int o = 0; o < 12; ++o) a[o] = 0.f;
#pragma unroll 2
            for (int kk = 0; kk < 32; ++kk) {
                const f32x4 y = *(const f32x4*)(x1 + (size_t)tkb * 1024 + kk * 32 + cg * 4);
#pragma unroll
                for (int q = 0; q < 4; ++q)
#pragma unroll
                    for (int ul = 0; ul < 3; ++ul) {
                        const f32x4 w4 = sW[ul * 1024 + kk * 32 + q * 8 + cg];
#pragma unroll
                        for (int o = 0; o < 4; ++o) a[ul * 4 + o] += y[q] * w4[o];
                    }
            }
#pragma unroll
            for (int o = 0; o < 12; ++o) a[o] = sum8(a[o]);
            if (cg == 0) {
                f32x4* dst = sLog + (wid * 8 + jt) * 9 + ug * 3;
                dst[0] = (f32x4){a[0], a[1], a[2], a[3]}; dst[1] = (f32x4){a[4], a[5], a[6], a[7]}; dst[2] = (f32x4){a[8], a[9], a[10], a[11]};
            }
        }
        if (cg == 0) {
            float lg[36];
#pragma unroll
            for (int u = 0; u < 9; ++u) { const f32x4 t4 = sLog[(wid * 8 + jt) * 9 + u]; lg[u * 4] = t4[0]; lg[u * 4 + 1] = t4[1]; lg[u * 4 + 2] = t4[2]; lg[u * 4 + 3] = t4[3]; }
            float gl[4];
#pragma unroll
            for (int q = 0; q < 4; ++q) gl[q] = lg[q] + bg[q];
            int gs = 0; float gm = gl[0];
#pragma unroll
            for (int q = 1; q < 4; ++q) if (gl[q] > gm) { gm = gl[q]; gs = q; }
            float gden = 0.f;
#pragma unroll
            for (int q = 0; q < 4; ++q) gden += __expf(gl[q] - gm);
            const float pg = 1.f / gden;
            float el[8];
#pragma unroll
            for (int jj = 0; jj < 8; ++jj) {
                const float v0 = lg[4 + jj] + be[jj], v1 = lg[12 + jj] + be[8 + jj], v2 = lg[20 + jj] + be[16 + jj], v3 = lg[28 + jj] + be[24 + jj];
                el[jj] = gs == 0 ? v0 : (gs == 1 ? v1 : (gs == 2 ? v2 : v3));
            }
            int i1 = 0; float m1 = el[0];
#pragma unroll
            for (int jj = 1; jj < 8; ++jj) if (el[jj] > m1) { m1 = el[jj]; i1 = jj; }
            int i2 = -1; float m2 = -3.0e38f;
#pragma unroll
            for (int jj = 0; jj < 8; ++jj) if (jj != i1 && el[jj] > m2) { m2 = el[jj]; i2 = jj; }
            const float ex = __expf(m2 - m1);
            const float p1 = 1.f / (1.f + ex), p2 = ex / (1.f + ex);
            const int e1 = gs * 8 + i1, e2 = gs * 8 + i2;
            const int r1 = atomicAdd(sLcnt + e1, 1), r2 = atomicAdd(sLcnt + e2, 1);
            int* rec = sTok + (wid * 8 + jt) * 4;
            rec[0] = (e1 << 16) | r1; rec[1] = (e2 << 16) | r2; rec[2] = __float_as_int(pg * p1); rec[3] = __float_as_int(pg * p2);
        }
        __syncthreads();
        if (tid < 32) { const int n = sLcnt[tid]; sLbase[tid] = n ? atomicAdd(cnt + tid * CNT_STRIDE, n) : 0; }
        __syncthreads();
        if (tid < 64) {
            const int tk = blk * 64 + tid; const int* rec = sTok + tid * 4;
            const int e1 = rec[0] >> 16, e2 = rec[1] >> 16;
            const int pos1 = sLbase[e1] + (rec[0] & 0xffff), pos2 = sLbase[e2] + (rec[1] & 0xffff);
            list[(size_t)e1 * NTOK + pos1] = tk; list[(size_t)e2 * NTOK + pos2] = tk;
            slot[tk * 2] = (e1 << 16) | pos1; slot[tk * 2 + 1] = (e2 << 16) | pos2;
            tw[tk * 2] = __int_as_float(rec[2]); tw[tk * 2 + 1] = __int_as_float(rec[3]);
        }
    }
}

DEVI void moe_find(const int* cnt, int rti, int& e, int& rt, int& rowbase, int& nrows) {
    int rt0 = 0; rowbase = 0; e = 0;
    for (; e < NEXP - 1; ++e) { const int nt = (cnt[e * CNT_STRIDE] + 255) >> 8; if (rti < rt0 + nt) break; rt0 += nt; rowbase += nt * 256; }
    rt = rti - rt0; nrows = cnt[e * CNT_STRIDE] - rt * 256; nrows = nrows > 256 ? 256 : nrows;
    e = __builtin_amdgcn_readfirstlane(e); rt = __builtin_amdgcn_readfirstlane(rt); rowbase = __builtin_amdgcn_readfirstlane(rowbase); nrows = __builtin_amdgcn_readfirstlane(nrows);
}
DEVI int moe_total_rt(const int* cnt) { int s = 0; for (int e = 0; e < NEXP; ++e) s += (cnt[e * CNT_STRIDE] + 255) >> 8; return __builtin_amdgcn_readfirstlane(s); }
constexpr int MOE_TAB_MAX = 192;
constexpr int MOE_TAB_OFF = 131072 + 1024;
struct MoeTab { int e, rt, rowbase, nrows; };
DEVI const MoeTab* moe_build_table(const int* cnt, unsigned char* smem) {
    int* sCnt = (int*)(smem + 131072); MoeTab* tab = (MoeTab*)(smem + MOE_TAB_OFF);
    const int tid = tidx();
    __syncthreads();
    if (tid < NEXP) sCnt[tid] = cnt[tid * CNT_STRIDE];
    __syncthreads();
    if (tid <= MOE_TAB_MAX) {
        int e = 0, rt0 = 0, rowbase = 0, total = 0;
        for (int i = 0; i < NEXP; ++i) total += (sCnt[i] + 255) >> 8;
        if (tid == MOE_TAB_MAX) { tab[tid].e = total; tab[tid].rt = 0; tab[tid].rowbase = 0; tab[tid].nrows = 0; }
        else {
            for (; e < NEXP - 1; ++e) { const int nt = (sCnt[e] + 255) >> 8; if (tid < rt0 + nt) break; rt0 += nt; rowbase += nt * 256; }
            int nrows = sCnt[e] - (tid - rt0) * 256; nrows = nrows > 256 ? 256 : nrows;
            tab[tid].e = e; tab[tid].rt = tid - rt0; tab[tid].rowbase = rowbase; tab[tid].nrows = nrows;
        }
    }
    __syncthreads();
    return tab;
}
DEVI void moe_lookup(const MoeTab* tab, int rti, int& e, int& rt, int& rowbase, int& nrows) {
    const MoeTab t = tab[rti];
    e = __builtin_amdgcn_readfirstlane(t.e); rt = __builtin_amdgcn_readfirstlane(t.rt); rowbase = __builtin_amdgcn_readfirstlane(t.rowbase); nrows = __builtin_amdgcn_readfirstlane(t.nrows);
}
struct EpiFinal {
    static constexpr bool PERM = false; const bf16_t* x2b; bf16_t* pe; float* out; int pass;
    DEVI void operator()(const f32x4 (&acc)[2][2][4][2], const PUnit& u, int wr, int wc, int fr, int fq) const {
        const int row0 = u.pm * 256 + wr * 64 + fr, col0 = u.pn * 256 + wc * 32 + 4 * fq;
#pragma unroll
        for (int ai = 0; ai < 2; ++ai)
#pragma unroll
            for (int mh = 0; mh < 2; ++mh) {
                u32x2 pv[2][2][2], xv[2][2][2];
#pragma unroll
                for (int mm = 0; mm < 2; ++mm)
#pragma unroll
                    for (int bj = 0; bj < 2; ++bj)
#pragma unroll
                        for (int n = 0; n < 2; ++n) {
                            const size_t o = (size_t)(row0 + ai * 128 + (mh * 2 + mm) * 16) * 1024 + col0 + bj * 128 + n * 16;
                            pv[mm][bj][n] = *(const u32x2*)(pe + o); xv[mm][bj][n] = *(const u32x2*)(x2b + o);
                        }
#pragma unroll
                for (int mm = 0; mm < 2; ++mm)
#pragma unroll
                    for (int bj = 0; bj < 2; ++bj)
#pragma unroll
                        for (int n = 0; n < 2; ++n) {
                            const size_t o = (size_t)(row0 + ai * 128 + (mh * 2 + mm) * 16) * 1024 + col0 + bj * 128 + n * 16;
                            const f32x4 a = acc[ai][bj][mh * 2 + mm][n];
                            f32x4 r;
                            r[0] = __uint_as_float(xv[mm][bj][n][0] << 16) + sigm(a[0]) * __uint_as_float(pv[mm][bj][n][0] << 16);
                            r[1] = __uint_as_float(xv[mm][bj][n][0] & 0xffff0000u) + sigm(a[1]) * __uint_as_float(pv[mm][bj][n][0] & 0xffff0000u);
                            r[2] = __uint_as_float(xv[mm][bj][n][1] << 16) + sigm(a[2]) * __uint_as_float(pv[mm][bj][n][1] << 16);
                            r[3] = __uint_as_float(xv[mm][bj][n][1] & 0xffff0000u) + sigm(a[3]) * __uint_as_float(pv[mm][bj][n][1] & 0xffff0000u);
                            *(f32x4*)(out + o) = r;
                        }
            }
    }
};
struct EpiPe {
    static constexpr bool PERM = true; bf16_t* pe;
    DEVI void operator()(const f32x4 (&acc)[2][2][4][2], const PUnit& u, int wr, int wc, int fr, int fq) const {
#pragma unroll
        for (int ai = 0; ai < 2; ++ai)
#pragma unroll
            for (int m = 0; m < 4; ++m) {
                bf16_t* rowp = pe + (size_t)(u.pm * 256 + ai * 128 + wr * 64 + m * 16 + fr) * 1024 + u.pn * 256 + wc * 32 + 8 * fq;
#pragma unroll
                for (int bj = 0; bj < 2; ++bj) *(u32x4*)(rowp + bj * 128) = pk8(acc[ai][bj][m][0], acc[ai][bj][m][1]);
            }
    }
};
struct PeOrder {
    static constexpr bool GATHER = false;
    const bf16_t* pb; const bf16_t* WpeT; int nbusy, G, c;
    DEVI bool next(int i, PUnit& u) const {
        if (c < nbusy) return false;
        const int t = i * (G - nbusy) + (c - nbusy); if (t >= 256) return false;
        u.pm = t >> 2; u.pn = t & 3; u.A = (const char*)(pb + (size_t)u.pm * 256 * 256); u.lda = 256; u.rows = nullptr; u.nrows = 256;
        u.Bt = (const char*)(WpeT + (size_t)u.pn * 256 * 256); u.x0 = 0; u.x1 = 0;
        return true;
    }
};
struct Moe1Order {
    static constexpr bool GATHER = true;
    const MoeTab* tab; const int* list; const bf16_t* x1b; const bf16_t* W13; int total, G, c;
    DEVI bool next(int i, PUnit& u) const {
        const int t = i * G + c; if (t >= total) return false;
        int e, rt, rowbase, nrows; moe_lookup(tab, t >> 2, e, rt, rowbase, nrows);
        u.pm = 0; u.pn = t & 3; u.A = (const char*)x1b; u.lda = 1024; u.rows = list + (size_t)e * NTOK + rt * 256; u.nrows = nrows;
        u.Bt = (const char*)(W13 + ((size_t)e * 1024 + (t & 3) * 256) * 1024); u.x0 = rowbase + rt * 256; u.x1 = e;
        return true;
    }
};
struct EpiMoe1 {
    static constexpr bool PERM = true; bf16_t* hbuf;
    DEVI void operator()(const f32x4 (&acc)[2][2][4][2], const PUnit& u, int wr, int wc, int fr, int fq) const {
#pragma unroll
        for (int ai = 0; ai < 2; ++ai)
#pragma unroll
            for (int m = 0; m < 4; ++m) {
                f32x4 o0, o1;
#pragma unroll
                for (int q = 0; q < 4; ++q) {
                    const float a0 = acc[ai][0][m][0][q], a1 = acc[ai][0][m][1][q];
                    o0[q] = a0 * sigm(a0) * acc[ai][1][m][0][q]; o1[q] = a1 * sigm(a1) * acc[ai][1][m][1][q];
                }
                *(u32x4*)(hbuf + (size_t)(u.x0 + ai * 128 + wr * 64 + m * 16 + fr) * 512 + u.pn * 128 + wc * 32 + 8 * fq) = pk8(o0, o1);
            }
    }
};
DEVI void phase_moe1(const Params& p, unsigned char* smem) {
    const MoeTab* tab = moe_build_table((const int*)(p.ws + WS_CNT), smem);
    const int total = __builtin_amdgcn_readfirstlane(tab[MOE_TAB_MAX].e) * 4;
    Moe1Order S{tab, (const int*)(p.ws + WS_LIST), (const bf16_t*)(p.ws + WS_X1B), (const bf16_t*)(p.ws + WS_W1T), total, (int)gridDim.x, (int)blockIdx.x};
    pgemm((PG_LAS unsigned char*)smem, 1024, 1024, S, EpiMoe1{(bf16_t*)p.out});
}
struct Moe2Order {
    static constexpr bool GATHER = false;
    const MoeTab* tab; const bf16_t* hbuf; const bf16_t* W2T; int total, G, c;
    DEVI bool next(int i, PUnit& u) const {
        const int t = i * G + c; if (t >= total) return false;
        int e, rt, rowbase, nrows; moe_lookup(tab, t >> 2, e, rt, rowbase, nrows);
        u.pm = 0; u.pn = t & 3; u.A = (const char*)(hbuf + (size_t)(rowbase + rt * 256) * 512); u.lda = 512; u.rows = nullptr; u.nrows = 256;
        u.Bt = (const char*)(W2T + ((size_t)e * 1024 + (t & 3) * 256) * 512); u.x0 = rowbase + rt * 256; u.x1 = e;
        return true;
    }
};
struct EpiMoe2 {
    static constexpr bool PERM = true; bf16_t* y;
    DEVI void operator()(const f32x4 (&acc)[2][2][4][2], const PUnit& u, int wr, int wc, int fr, int fq) const {
#pragma unroll
        for (int ai = 0; ai < 2; ++ai)
#pragma unroll
            for (int m = 0; m < 4; ++m) {
                bf16_t* rowp = y + (size_t)(u.x0 + ai * 128 + wr * 64 + m * 16 + fr) * 1024 + u.pn * 256 + wc * 32 + 8 * fq;
#pragma unroll
                for (int bj = 0; bj < 2; ++bj) *(u32x4*)(rowp + bj * 128) = pk8(acc[ai][bj][m][0], acc[ai][bj][m][1]);
            }
    }
};
DEVI void phase_moe2(const Params& p, unsigned char* smem) {
    const MoeTab* tab = moe_build_table((const int*)(p.ws + WS_CNT), smem);
    const int total = __builtin_amdgcn_readfirstlane(tab[MOE_TAB_MAX].e) * 4;
    {
        int nbusy = total - 2 * (int)gridDim.x; nbusy = nbusy < 0 ? 0 : (nbusy > (int)gridDim.x / 2 ? (int)gridDim.x / 2 : nbusy);
        if ((int)blockIdx.x >= nbusy) {
            TileOrder P; P.init((const bf16_t*)(p.ws + WS_PB), 256, (const bf16_t*)(p.ws + WS_WPET), 256, NTOK, 1024);
            P.G = (int)gridDim.x - nbusy; P.c = (int)blockIdx.x - nbusy;
            pgemm((PG_LAS unsigned char*)smem, 256, 256, P, EpiPe{(bf16_t*)(p.ws + WS_PE)});
        }
    }
    Moe2Order S{tab, (const bf16_t*)p.out, (const bf16_t*)(p.ws + WS_W2T), total, (int)gridDim.x, (int)blockIdx.x};
    pgemm((PG_LAS unsigned char*)smem, 512, 512, S, EpiMoe2{(bf16_t*)(p.ws + WS_Y)});
}

DEVI void phase_ln2(const Params& p, unsigned char* smem) {
    bf16_t* x2b = (bf16_t*)(p.ws + WS_X1B);
    const bf16_t* y = (const bf16_t*)(p.ws + WS_Y);
    const int* cnt = (const int*)(p.ws + WS_CNT); const int* slot = (const int*)(p.ws + WS_SLOT); const float* tw = (const float*)(p.ws + WS_TW);
    const float* g = p.in[28]; const float* bta = p.in[29];
    const int lane = tidx() & 63, wid = tidx() >> 6;
    int* sRB = (int*)smem;
    __syncthreads();
    int* sC = sRB + 64;
    if (tidx() < NEXP) sC[tidx()] = cnt[tidx() * CNT_STRIDE];
    __syncthreads();
    if (tidx() < NEXP) { int rb = 0; for (int e = 0; e < NEXP; ++e) { if (e < (int)tidx()) rb += ((sC[e] + 255) >> 8) << 8; } sRB[tidx()] = rb; }
    __syncthreads();
    for (int tk = (blockIdx.x * 8 + wid) * 2; tk < NTOK; tk += gridDim.x * 16) {
        int sl[2][2]; float wv[2][2];
#pragma unroll
        for (int j = 0; j < 2; ++j) { sl[j][0] = slot[(tk + j) * 2]; sl[j][1] = slot[(tk + j) * 2 + 1]; wv[j][0] = tw[(tk + j) * 2]; wv[j][1] = tw[(tk + j) * 2 + 1]; }
        f32x4 xa[2][4]; u32x2 ya[2][4], yb[2][4];
#pragma unroll
        for (int j = 0; j < 2; ++j) {
            const size_t r0 = (size_t)(sRB[sl[j][0] >> 16] + (sl[j][0] & 0xffff)), r1 = (size_t)(sRB[sl[j][1] >> 16] + (sl[j][1] & 0xffff));
#pragma unroll
            for (int i = 0; i < 4; ++i) {
                const int col = i * 256 + lane * 4;
                xa[j][i] = ld_bf4(x2b + (size_t)(tk + j) * 1024 + col);
                ya[j][i] = *(const u32x2*)(y + r0 * 1024 + col); yb[j][i] = *(const u32x2*)(y + r1 * 1024 + col);
            }
        }
#pragma unroll
        for (int j = 0; j < 2; ++j) {
            f32x4 xv[4]; float s = 0.f;
#pragma unroll
            for (int i = 0; i < 4; ++i) {
                f32x4 y0, y1;
                y0[0] = __uint_as_float(ya[j][i][0] << 16); y0[1] = __uint_as_float(ya[j][i][0] & 0xffff0000u); y0[2] = __uint_as_float(ya[j][i][1] << 16); y0[3] = __uint_as_float(ya[j][i][1] & 0xffff0000u);
                y1[0] = __uint_as_float(yb[j][i][0] << 16); y1[1] = __uint_as_float(yb[j][i][0] & 0xffff0000u); y1[2] = __uint_as_float(yb[j][i][1] << 16); y1[3] = __uint_as_float(yb[j][i][1] & 0xffff0000u);
                xv[i] = xa[j][i] * ALPHA + y0 * wv[j][0] + y1 * wv[j][1];
                s += xv[i][0] + xv[i][1] + xv[i][2] + xv[i][3];
            }
            const float mean = wave_sum(s) * (1.f / 1024.f);
            float s2 = 0.f;
#pragma unroll
            for (int i = 0; i < 4; ++i)
#pragma unroll
                for (int q = 0; q < 4; ++q) { const float d = xv[i][q] - mean; s2 += d * d; }
            const float rstd = rsqrtf(wave_sum(s2) * (1.f / 1024.f) + LN_EPS);
#pragma unroll
            for (int i = 0; i < 4; ++i) {
                const int col = i * 256 + lane * 4;
                const f32x4 g4 = *(const f32x4*)(g + col), b4 = *(const f32x4*)(bta + col);
                f32x4 o;
#pragma unroll
                for (int q = 0; q < 4; ++q) o[q] = (xv[i][q] - mean) * rstd * g4[q] + b4[q];
                st_bf4(x2b + (size_t)(tk + j) * 1024 + col, o);
            }
        }
    }
}

DEVI void phase_final(const Params& p, unsigned char* smem) {
    const bf16_t* x2b = (const bf16_t*)(p.ws + WS_X1B); bf16_t* pe = (bf16_t*)(p.ws + WS_PE);
    TileOrder S; S.init(x2b, 1024, (const bf16_t*)(p.ws + WS_WPGT), 1024, NTOK, 1024);
    pgemm((PG_LAS unsigned char*)smem, 1024, 1024, S, EpiFinal{x2b, pe, p.out, 1});
}

#define XB_TMO      128
#define XB_XCNT(j)  (256  + 64 * (j))
#define XB_XSUB(j)  (1280 + 64 * (j))
#define XB_XGEN(j)  (2304 + 64 * (j))
#define XB_TOP      3328
#define XB_TOPGEN   3392
#define XCD_BAR_WORDS 3456
#define XB_SPIN_CAP (1u << 22)
#define LAS __attribute__((address_space(3)))
DEVI unsigned xb_ld(unsigned* p) { return __hip_atomic_load(p, __ATOMIC_RELAXED, __HIP_MEMORY_SCOPE_AGENT); }
DEVI unsigned xb_add(unsigned* p, unsigned v) { return __hip_atomic_fetch_add(p, v, __ATOMIC_RELAXED, __HIP_MEMORY_SCOPE_AGENT); }
DEVI unsigned xb_xcc_id() { return (unsigned)__builtin_amdgcn_s_getreg((3 << 11) | 20) & 0xFu; }
#define XB_SPIN(cond, bar) do { unsigned _sp = 0; while (cond) { __builtin_amdgcn_s_sleep(1); \
    if ((++_sp & 255u) == 0u) { if (xb_ld(&(bar)[XB_TMO])) break; if (_sp > XB_SPIN_CAP) { atomicAdd(&(bar)[XB_TMO], 1u); break; } } } } while (0)
struct XcdBarrier { unsigned* bar; unsigned x; volatile LAS unsigned* st; };
DEVI XcdBarrier xcd_barrier_post(unsigned* bar, volatile LAS unsigned* st) {
    XcdBarrier b; b.bar = bar; b.x = xb_xcc_id(); b.st = st;
    if (tidx() == 0) (void)xb_add(&bar[XB_XCNT(b.x)], 1u);
    return b;
}
DEVI void xcd_barrier_complete(unsigned* bar, unsigned x, unsigned& nloc, unsigned& nx) {
    const unsigned G = gridDim.x * gridDim.y * gridDim.z;
    unsigned sum, cnt, mine, sp = 0u;
    for (;;) {
        sum = 0u; cnt = 0u; mine = 0u;
#pragma unroll
        for (unsigned j = 0; j < 16; ++j) { const unsigned c = xb_ld(&bar[XB_XCNT(j)]); sum += c; cnt += (c > 0u) ? 1u : 0u; mine = (j == x) ? c : mine; }
        if (sum == G) break;
        __builtin_amdgcn_s_sleep(1);
        if ((++sp & 255u) == 0u) { if (xb_ld(&bar[XB_TMO])) break; if (sp > XB_SPIN_CAP) { atomicAdd(&bar[XB_TMO], 1u); break; } }
    }
    nloc = mine > 0u ? mine : 1u; nx = cnt > 0u ? cnt : 1u;
}
DEVI void xcd_barrier(const XcdBarrier& b) {
    asm volatile("s_waitcnt vmcnt(0)" ::: "memory");
    __syncthreads();
    if (tidx() == 0) {
        unsigned* bar = b.bar;
        __builtin_amdgcn_s_waitcnt(0);
        unsigned nloc = b.st[0], nx = b.st[1];
        if (nloc == 0u) { xcd_barrier_complete(bar, b.x, nloc, nx); b.st[0] = nloc; b.st[1] = nx; }
        const unsigned old = xb_add(&bar[XB_XSUB(b.x)], 1u);
        const unsigned gen = old / nloc;
        if (old + 1u == (gen + 1u) * nloc) {
            __builtin_amdgcn_fence(__ATOMIC_RELEASE, "agent");
            asm volatile("s_waitcnt vmcnt(0)" ::: "memory");
            const unsigned og = xb_add(&bar[XB_TOP], 1u);
            const unsigned tg = og / nx;
            if (og + 1u == (tg + 1u) * nx) xb_add(&bar[XB_TOPGEN], 1u);
            else XB_SPIN(xb_ld(&bar[XB_TOPGEN]) == tg, bar);
            __builtin_amdgcn_fence(__ATOMIC_ACQUIRE, "agent");
            xb_add(&bar[XB_XGEN(b.x)], 1u);
            asm volatile("s_waitcnt vmcnt(0)" ::: "memory");
        } else {
            XB_SPIN(xb_ld(&bar[XB_XGEN(b.x)]) == gen, bar);
            __builtin_amdgcn_fence(__ATOMIC_ACQUIRE, "agent");
            asm volatile("s_waitcnt vmcnt(0)" ::: "memory");
        }
    }
    __syncthreads();
}

extern __shared__ __attribute__((aligned(16))) unsigned char dyn_smem[];
#ifndef PROBE_PHASE
#define PROBE_PHASE -1
#endif
#define STAMP(k) do { if (PROBE_PHASE >= 0 && blockIdx.x == 0 && tidx() == 0) ts[k] = __builtin_amdgcn_s_memrealtime(); } while (0)
__global__ void __launch_bounds__(NT) k_mega(Params p) {
    volatile LAS unsigned* st = (volatile LAS unsigned*)(dyn_smem + LDS_BYTES - 16);
    if (tidx() == 0) { st[0] = 0u; st[1] = 0u; st[2] = 0u; st[3] = 0u; }
    __syncthreads();
    const XcdBarrier gb = xcd_barrier_post((unsigned*)(p.ws + WS_BAR), st);
    unsigned long long* ts = (unsigned long long*)(p.ws + WS_BAR + 32768);
#if PROBE_PHASE >= 0
    xcd_barrier(gb); STAMP(0);
#endif
    phase_prep(p, dyn_smem); xcd_barrier(gb); STAMP(1);
    phase_inproj(p, dyn_smem); xcd_barrier(gb); STAMP(2);
    phase_rwkv_prep(p, dyn_smem); xcd_barrier(gb); STAMP(3);
    phase_3a(p, dyn_smem); xcd_barrier(gb); STAMP(4);
    phase_3b(p, dyn_smem); xcd_barrier(gb); STAMP(5);
    phase_3c(p, dyn_smem); xcd_barrier(gb); STAMP(6);
    phase_merge(p, dyn_smem); xcd_barrier(gb); STAMP(7);
    phase_wo(p, dyn_smem); xcd_barrier(gb); STAMP(8);
    phase_ln1_route(p, dyn_smem); xcd_barrier(gb); STAMP(9);
    phase_moe1(p, dyn_smem); xcd_barrier(gb); STAMP(10);
    phase_moe2(p, dyn_smem); xcd_barrier(gb); STAMP(11);
    phase_ln2(p, dyn_smem); xcd_barrier(gb); STAMP(12);
    phase_final(p, dyn_smem);
#if PROBE_PHASE >= 0
    xcd_barrier(gb); STAMP(13);
    if (blockIdx.x == 0 && tidx() == 0) {
        const unsigned long long d = (ts[PROBE_PHASE + 1] - ts[PROBE_PHASE]) * 4ull, t0 = __builtin_amdgcn_s_memrealtime();
        while (__builtin_amdgcn_s_memrealtime() - t0 < d) __builtin_amdgcn_s_sleep(8);
    }
#endif
}

extern "C" void kernel_launch(void* const* d_in, const int* in_sizes, int n_in, void* d_out, int out_size, void* d_ws, size_t ws_size, hipStream_t stream) {
    static int grid = 0;
    if (grid == 0) {
        if (n_in != 32 || out_size != NTOK * DM || ws_size < WS_END) { fprintf(stderr, "kernel_launch: unexpected shapes (n_in %d out %d ws %zu, need %zu)\n", n_in, out_size, ws_size, (size_t)WS_END); grid = -1; return; }
        int dev = 0, cus = 0, per_cu = 0;
        hipGetDevice(&dev); hipDeviceGetAttribute(&cus, hipDeviceAttributeMultiprocessorCount, dev);
        hipFuncSetAttribute((const void*)k_mega, hipFuncAttributeMaxDynamicSharedMemorySize, LDS_BYTES);
        hipOccupancyMaxActiveBlocksPerMultiprocessor(&per_cu, (const void*)k_mega, NT, LDS_BYTES);
        if (per_cu < 1) { fprintf(stderr, "kernel_launch: occupancy query says %d blocks per CU\n", per_cu); grid = -1; return; }
        if (cus < 256) { fprintf(stderr, "kernel_launch: %d CUs reported; this kernel's phase maps are built for a 256-workgroup grid (one per CU of a 256-CU device)\n", cus); grid = -1; return; }
        grid = 256;
        (void)hipGetLastError();
    }
    if (grid < 0) return;
    Params p{};
    for (int i = 0; i < 32; ++i) p.in[i] = (const float*)d_in[i];
    p.out = (float*)d_out; p.ws = (unsigned char*)d_ws;
    (void)hipMemsetAsync((char*)d_ws + WS_BAR, 0, XCD_BAR_WORDS * 4, stream);
    void* args[] = {&p};
    hipError_t e = hipLaunchCooperativeKernel((const void*)k_mega, dim3(grid), dim3(NT), args, LDS_BYTES, stream);
    if (e != hipSuccess) fprintf(stderr, "cooperative launch failed: %s (grid %d)\n", hipGetErrorString(e), grid);
}
```

```cpp
#include <hip/hip_runtime.h>
#include <hip/hip_cooperative_groups.h>
#include <cstdio>
#include <cstdint>
namespace cg = cooperative_groups;


typedef unsigned short bf16_t;
typedef short bf16x8 __attribute__((ext_vector_type(8)));
typedef float f32x4 __attribute__((ext_vector_type(4)));
typedef unsigned u32x4 __attribute__((ext_vector_type(4)));
typedef unsigned u32x2 __attribute__((ext_vector_type(2)));
typedef float f32x2 __attribute__((ext_vector_type(2)));
#define DEVI __device__ __forceinline__
DEVI int tidx() { int t = threadIdx.x; asm volatile("" : "+v"(t)); return t; }

constexpr int NT = 512;
constexpr int NTOK = 16384, DM = 1024, SEQ = 4096, NIN = 5888, PLE = 256;
constexpr int C_K = 512, C_V = 1024, C_WD = 1536, NRW = 1792, NHG = 2048;
constexpr int H_Q = 0, H_F = 512, H_I = 1024, H_OG = 1536;
constexpr int NEXP = 32;
constexpr float ALPHA = 1.189207115002721f;
constexpr float LN_EPS = 1e-5f, RMS_EPS = 1e-6f, GN_EPS = 64e-5f;
constexpr int LDS_BYTES = 163840;

constexpr size_t MiB = 1048576;
constexpr size_t WS_WAT = 0, WS_WBT = 1 * MiB, WS_WOT = 2 * MiB, WS_WPGT = 4 * MiB, WS_WPET = 6 * MiB;
constexpr size_t WS_CNT = 6 * MiB + 512 * 1024;
constexpr int CNT_STRIDE = 64;
constexpr size_t WS_SLOT = WS_CNT + 8192;
constexpr size_t WS_TW = WS_SLOT + (size_t)NTOK * 2 * 4;
constexpr size_t WS_LIST = WS_TW + (size_t)NTOK * 2 * 4;
constexpr size_t WS_BAR = 9 * MiB + 768 * 1024;
constexpr size_t WS_GBUF = 9 * MiB;
constexpr size_t WS_WR = 10 * MiB + 768 * 1024;
constexpr size_t WS_LORA = 10 * MiB;
constexpr size_t WS_PB = 12 * MiB;
constexpr size_t WS_PRW = 20 * MiB;
constexpr size_t WS_PHG = 76 * MiB;
constexpr size_t WS_PGT = 140 * MiB;
constexpr size_t WS_W1T = 20 * MiB, WS_W3T = 52 * MiB, WS_W2T = 84 * MiB;
constexpr size_t WS_Y = 116 * MiB;
constexpr size_t WS_XB = 204 * MiB;
constexpr size_t WS_YA = 204 * MiB, WS_YB = 220 * MiB;
constexpr size_t WS_YAB = 20 * MiB;
constexpr size_t WS_X1B = 204 * MiB;
constexpr size_t WS_WINT = 236 * MiB;
constexpr size_t WS_PREP = 236 * MiB;
constexpr size_t WS_MERGED = 236 * MiB;
constexpr size_t WS_X1 = 236 * MiB;
constexpr size_t WS_PE = 236 * MiB;
constexpr size_t WS_WCAT = 300 * MiB;
constexpr size_t WS_END = 304 * MiB;
constexpr int YROWS = 40960;

struct Params { const float* in[32]; float* out; unsigned char* ws; };

DEVI float bf2f(bf16_t h) { return __uint_as_float(((unsigned)h) << 16); }
DEVI unsigned pack2(float a, float b) { unsigned r; asm volatile("v_cvt_pk_bf16_f32 %0, %1, %2" : "=v"(r) : "v"(a), "v"(b)); return r; }
DEVI bf16_t f2bf(float f) { return (bf16_t)(pack2(f, f) & 0xffffu); }
DEVI float sigm(float x) { return __builtin_amdgcn_rcpf(1.f + __expf(-x)); }
DEVI float wave_sum(float v) {
#pragma unroll
    for (int o = 32; o > 0; o >>= 1) v += __shfl_xor(v, o, 64);
    return v;
}
template <int CTRL> DEVI float dpp_mov(float v) { return __int_as_float(__builtin_amdgcn_update_dpp(0, __float_as_int(v), CTRL, 0xf, 0xf, true)); }
DEVI float sum8(float v) { v += dpp_mov<0xB1>(v); v += dpp_mov<0x4E>(v); v += dpp_mov<0x141>(v); return v; }
DEVI f32x4 ld_bf4(const bf16_t* p) { u32x2 u = *(const u32x2*)p; f32x4 r; r[0] = __uint_as_float(u[0] << 16); r[1] = __uint_as_float(u[0] & 0xffff0000u); r[2] = __uint_as_float(u[1] << 16); r[3] = __uint_as_float(u[1] & 0xffff0000u); return r; }
DEVI void st_bf4(bf16_t* p, f32x4 v) { u32x2 o; o[0] = pack2(v[0], v[1]); o[1] = pack2(v[2], v[3]); *(u32x2*)p = o; }

DEVI void st_wt(void* p, u32x4 v) { asm volatile("global_store_dwordx4 %0, %1, off sc1\n\ts_nop 1" :: "v"(p), "v"(v) : "memory"); }
DEVI void cvt_tile4(const float* __restrict__ src, bf16_t* __restrict__ dst, int tile4) {
    const size_t base = (size_t)tile4 * 16384 + tidx() * 8;
    f32x4 a[4], b[4];
#pragma unroll
    for (int i = 0; i < 4; ++i) { a[i] = __builtin_nontemporal_load((const f32x4*)(src + base + i * 4096)); b[i] = __builtin_nontemporal_load((const f32x4*)(src + base + i * 4096 + 4)); }
#pragma unroll
    for (int i = 0; i < 4; ++i) {
        u32x4 o; o[0] = pack2(a[i][0], a[i][1]); o[1] = pack2(a[i][2], a[i][3]); o[2] = pack2(b[i][0], b[i][1]); o[3] = pack2(b[i][2], b[i][3]);
        *(u32x4*)(dst + base + i * 4096) = o;
    }
}
DEVI void transpose_tile(const float* __restrict__ src, bf16_t* __restrict__ dst, int R, int C, int tr, int tc, float* sm, int dld = 0) {
    if (dld == 0) dld = R;
    const int tid = tidx();
    __syncthreads();
#pragma unroll
    for (int i = 0; i < 2; ++i) {
        const int r = (tid >> 4) + 32 * i, c4 = (tid & 15) * 4;
        const f32x4 v = *(const f32x4*)(src + (size_t)(tr * 64 + r) * C + tc * 64 + c4);
        float* d = sm + r * 65 + c4; d[0] = v[0]; d[1] = v[1]; d[2] = v[2]; d[3] = v[3];
    }
    __syncthreads();
    const int c = tid >> 3, r8 = (tid & 7) * 8;
    float v[8];
#pragma unroll
    for (int k = 0; k < 8; ++k) v[k] = sm[(r8 + k) * 65 + c];
    u32x4 o; o[0] = pack2(v[0], v[1]); o[1] = pack2(v[2], v[3]); o[2] = pack2(v[4], v[5]); o[3] = pack2(v[6], v[7]);
    *(u32x4*)(dst + (size_t)(tc * 64 + c) * dld + tr * 64 + r8) = o;
}
DEVI void tt4_load(f32x4 (&v)[8], const float* __restrict__ src, int C, int tr4, int tc) {
    const int tid = tidx();
#pragma unroll
    for (int i = 0; i < 8; ++i) v[i] = __builtin_nontemporal_load((const f32x4*)(src + (size_t)(tr4 * 256 + (tid >> 4) + 32 * i) * C + tc * 64 + (tid & 15) * 4));
}
DEVI void tt4_finish(const f32x4 (&v)[8], bf16_t* __restrict__ dst, int dld, int tr4, int tc, float* sm) {
    const int tid = tidx();
    asm volatile("s_waitcnt lgkmcnt(0)" ::: "memory"); __builtin_amdgcn_s_barrier(); asm volatile("" ::: "memory");
#pragma unroll
    for (int i = 0; i < 8; ++i) { float* d = sm + ((tid >> 4) + 32 * i) * 65 + (tid & 15) * 4; d[0] = v[i][0]; d[1] = v[i][1]; d[2] = v[i][2]; d[3] = v[i][3]; }
    asm volatile("s_waitcnt lgkmcnt(0)" ::: "memory"); __builtin_amdgcn_s_barrier(); asm volatile("" ::: "memory");
}
DEVI void tt4_store(bf16_t* __restrict__ dst, int dld, int tr4, int tc, const float* sm) {
    const int tid = tidx();
    const int c = tid >> 3, r32 = (tid & 7) * 32;
#pragma unroll
    for (int j = 0; j < 4; ++j) {
        float w[8];
#pragma unroll
        for (int k = 0; k < 8; ++k) w[k] = sm[(r32 + j * 8 + k) * 65 + c];
        u32x4 o; o[0] = pack2(w[0], w[1]); o[1] = pack2(w[2], w[3]); o[2] = pack2(w[4], w[5]); o[3] = pack2(w[6], w[7]);
        *(u32x4*)(dst + (size_t)(tc * 64 + c) * dld + tr4 * 256 + r32 + j * 8) = o;
    }
}
DEVI void transpose_tile4(const float* __restrict__ src, bf16_t* __restrict__ dst, int R, int C, int tr4, int tc, float* sm, int dld = 0) {
    if (dld == 0) dld = R;
    f32x4 v[8];
    tt4_load(v, src, C, tr4, tc);
    tt4_finish(v, dst, dld, tr4, tc, sm);
    tt4_store(dst, dld, tr4, tc, sm);
}

constexpr int GLD = 72;
struct IdRows { int base; DEVI int operator()(int r) const { return base + r; } };
struct GatherRows { const int* list; int n; DEVI int operator()(int r) const { return r < n ? list[r] : 0; } };

template <int MF, class RowMap>
DEVI void gemm_accum(f32x4 (&acc)[MF][4], const bf16_t* __restrict__ A, int lda, RowMap rowmap,
                     const bf16_t* __restrict__ Bt, int ldb, int K, bf16_t* sm) {
    bf16_t* sA = sm; bf16_t* sB = sm + MF * 64 * GLD;
    const int tid = tidx(), lane = tid & 63, wid = tid >> 6, wr = wid >> 1, wc = wid & 1, fr = lane & 15, fq = lane >> 4;
    const int lrow = tid >> 3, kc = tid & 7;
    const bf16_t* ap[MF]; const bf16_t* bp[2];
#pragma unroll
    for (int i = 0; i < MF; ++i) ap[i] = A + (size_t)rowmap(lrow + 64 * i) * lda + kc * 8;
#pragma unroll
    for (int i = 0; i < 2; ++i) bp[i] = Bt + (size_t)(lrow + 64 * i) * ldb + kc * 8;
    u32x4 ra[MF], rb[2];
#pragma unroll
    for (int i = 0; i < MF; ++i) ra[i] = *(const u32x4*)(ap[i]);
#pragma unroll
    for (int i = 0; i < 2; ++i) rb[i] = *(const u32x4*)(bp[i]);
    const int nk = K >> 6;
    for (int kt = 0; kt < nk; ++kt) {
        __syncthreads();
#pragma unroll
        for (int i = 0; i < MF; ++i) *(u32x4*)(sA + (lrow + 64 * i) * GLD + kc * 8) = ra[i];
#pragma unroll
        for (int i = 0; i < 2; ++i) *(u32x4*)(sB + (lrow + 64 * i) * GLD + kc * 8) = rb[i];
        __syncthreads();
        if (kt + 1 < nk) {
#pragma unroll
            for (int i = 0; i < MF; ++i) ra[i] = *(const u32x4*)(ap[i] + (kt + 1) * 64);
#pragma unroll
            for (int i = 0; i < 2; ++i) rb[i] = *(const u32x4*)(bp[i] + (kt + 1) * 64);
        }
#pragma unroll
        for (int kk = 0; kk < 2; ++kk) {
            bf16x8 af[MF], bfr[4];
#pragma unroll
            for (int m = 0; m < MF; ++m) af[m] = *(const bf16x8*)(sA + (wr * (MF * 16) + m * 16 + fr) * GLD + kk * 32 + fq * 8);
#pragma unroll
            for (int n = 0; n < 4; ++n) bfr[n] = *(const bf16x8*)(sB + (wc * 64 + n * 16 + fr) * GLD + kk * 32 + fq * 8);
#pragma unroll
            for (int m = 0; m < MF; ++m)
#pragma unroll
                for (int n = 0; n < 4; ++n) acc[m][n] = __builtin_amdgcn_mfma_f32_16x16x32_bf16(bfr[n], af[m], acc[m][n], 0, 0, 0);
        }
    }
}
template <int MF> DEVI void acc_zero(f32x4 (&acc)[MF][4]) {
#pragma unroll
    for (int m = 0; m < MF; ++m)
#pragma unroll
        for (int n = 0; n < 4; ++n) acc[m][n] = (f32x4){0.f, 0.f, 0.f, 0.f};
}
template <int MF, class F> DEVI void epi1(const f32x4 (&acc)[MF][4], F f) {
    const int lane = tidx() & 63, wid = tidx() >> 6, wr = wid >> 1, wc = wid & 1, fr = lane & 15, fq = lane >> 4;
#pragma unroll
    for (int m = 0; m < MF; ++m)
#pragma unroll
        for (int n = 0; n < 4; ++n) f(wr * (MF * 16) + m * 16 + fr, wc * 64 + n * 16 + fq * 4, acc[m][n]);
}
template <int MF, class F> DEVI void epi2(const f32x4 (&a1)[MF][4], const f32x4 (&a2)[MF][4], F f) {
    const int lane = tidx() & 63, wid = tidx() >> 6, wr = wid >> 1, wc = wid & 1, fr = lane & 15, fq = lane >> 4;
#pragma unroll
    for (int m = 0; m < MF; ++m)
#pragma unroll
        for (int n = 0; n < 4; ++n) f(wr * (MF * 16) + m * 16 + fr, wc * 64 + n * 16 + fq * 4, a1[m][n], a2[m][n]);
}


#define PG_LAS __attribute__((address_space(3)))
constexpr int PBK = 64, PHALF = 128, PHTB = PHALF * PBK * 2, PSTAGE = 8 * PHTB;
DEVI int pg_lds_byte(int r, int c) { const int st = (r >> 4) * 2 + (c >> 5), rr = r & 15, cc = c & 31, ob = rr * 64 + cc * 2; return st * 1024 + (ob ^ (((ob >> 9) & 1) << 5)); }
DEVI void pg_stage_rc(int b, int& R, int& C) { const int st = b / 1024, sb = b % 1024, swz = sb ^ (((sb >> 9) & 1) << 5); R = (st >> 1) * 16 + swz / 64; C = (st & 1) * 32 + (swz % 64) / 2; }
DEVI int pg_perm32(int rho) { const int n = rho >> 4, i = rho & 15; return 8 * (i >> 2) + 4 * n + (i & 3); }
struct PUnit { const char* A; const char* Bt; const int* rows; int nrows, lda, pm, pn, x0, x1; };
template <class Epi, class Sched>
DEVI void pgemm(PG_LAS unsigned char* lds, int ldb, int K, const Sched& S, const Epi& E) {
    int tid = tidx();
    const int wid = __builtin_amdgcn_readfirstlane(tid >> 6), lane = tid & 63, wr = wid >> 2, wc = wid & 3, fr = lane & 15, fq = lane >> 4;
    const int nt = K / PBK;
    unsigned voffB[2];
#pragma unroll
    for (int i = 0; i < 2; ++i) { int R, C; pg_stage_rc(tid * 16 + i * 8192, R, C); const int Rb = Epi::PERM ? ((R & ~31) + pg_perm32(R & 31)) : R; voffB[i] = (unsigned)(Rb * ldb + C) * 2u; }
    const size_t kstep = (size_t)(PBK * 2);
    const size_t hstepB = (size_t)PHALF * ldb * 2;
    const unsigned ldsw = (unsigned)wid * 1024u;
    const int aoff = pg_lds_byte(wr * 64 + fr, fq * 8), boff = pg_lds_byte(wc * 32 + fr, fq * 8);
#define PG_SA(b, h) (((b) * 2 + (h)) * PHTB)
#define PG_SB(b, h) ((4 + (b) * 2 + (h)) * PHTB)
#define PG_STAGE(bufoff, gbase, voff) do { _Pragma("unroll") for (int _i = 0; _i < 2; ++_i) \
        __builtin_amdgcn_global_load_lds((const unsigned*)((const char*)(gbase) + (voff)[_i]), (PG_LAS unsigned*)(lds + (bufoff) + ldsw + _i * 8192), 16, 0, 0); } while (0)
#define PG_STAGE_A(bufoff, gbase, voff) do { _Pragma("unroll") for (int _i = 0; _i < 2; ++_i) \
        __builtin_amdgcn_global_load_lds((const unsigned*)((const char*)(gbase) + (voff)[_i]), (PG_LAS unsigned*)(lds + (bufoff) + ldsw + _i * 8192), 16, 0, Sched::DEP ? 16 : 0); } while (0)
#define PG_LDA(dst, b, h) do { _Pragma("unroll") for (int m = 0; m < 4; ++m) _Pragma("unroll") for (int k = 0; k < 2; ++k) dst[m][k] = *(const PG_LAS bf16x8*)(lds + PG_SA(b, h) + aoff + m * 2048 + k * 1024); } while (0)
#define PG_LDB(dst, b, h) do { _Pragma("unroll") for (int n = 0; n < 2; ++n) _Pragma("unroll") for (int k = 0; k < 2; ++k) dst[n][k] = *(const PG_LAS bf16x8*)(lds + PG_SB(b, h) + boff + n * 2048 + k * 1024); } while (0)
#define PG_MMA(ai, bj, At, Bt) do { __builtin_amdgcn_s_setprio(1); _Pragma("unroll") for (int m = 0; m < 4; ++m) _Pragma("unroll") for (int n = 0; n < 2; ++n) _Pragma("unroll") for (int k = 0; k < 2; ++k) \
        acc[ai][bj][m][n] = __builtin_amdgcn_mfma_f32_16x16x32_bf16(Bt[n][k], At[m][k], acc[ai][bj][m][n], 0, 0, 0); __builtin_amdgcn_s_setprio(0); } while (0)
#define PG_WAIT_V(n) asm volatile("s_waitcnt vmcnt(" #n ")" ::: "memory")
#define PG_WAIT_L(n) asm volatile("s_waitcnt lgkmcnt(" #n ")" ::: "memory")
#define PG_BAR __builtin_amdgcn_s_barrier()
#define PG_SCHED __builtin_amdgcn_sched_barrier(0)
#define PG_VOFFA(dst, u) do { _Pragma("unroll") for (int _h = 0; _h < 2; ++_h) _Pragma("unroll") for (int _i = 0; _i < 2; ++_i) { int _R, _C; pg_stage_rc(tid * 16 + _i * 8192, _R, _C); const int _r = _h * 128 + _R; \
        int _ix = _r; if constexpr (Sched::GATHER) { if ((u).rows) _ix = (_r < (u).nrows ? (u).rows[_r] : 0); } dst[_h][_i] = (unsigned)(_ix * (u).lda + _C) * 2u; } } while (0)
    PUnit cur, nxt; int ui = 0;
    if (!S.next(0, cur)) return;
    if constexpr (Sched::DEP) S.a_ready(cur, tid);
    f32x4 acc[2][2][4][2];
    bf16x8 At[4][2], B0[2][2], B1[2][2];
    unsigned vA[2][2];
    PG_VOFFA(vA, cur);
    const char* cA = cur.A; const char* cB = cur.Bt;
    PG_STAGE(PG_SB(0, 0), cB, voffB); PG_STAGE_A(PG_SA(0, 0), cA, vA[0]); PG_STAGE(PG_SB(0, 1), cB + hstepB, voffB); PG_STAGE_A(PG_SA(0, 1), cA, vA[1]);
    if (wr == 1) PG_BAR;
    PG_WAIT_V(4); PG_BAR;
    PG_STAGE(PG_SB(1, 0), cB + kstep, voffB); PG_STAGE_A(PG_SA(1, 0), cA + kstep, vA[0]); PG_STAGE(PG_SB(1, 1), cB + hstepB + kstep, voffB);
    PG_WAIT_V(6); PG_BAR;
#pragma unroll
    for (int a = 0; a < 2; ++a)
#pragma unroll
        for (int b = 0; b < 2; ++b)
#pragma unroll
            for (int m = 0; m < 4; ++m)
#pragma unroll
                for (int n = 0; n < 2; ++n) acc[a][b][m][n] = (f32x4){0.f, 0.f, 0.f, 0.f};
    for (;;) {
        const bool has_next = S.next(ui + 1, nxt);
        const char* nA = has_next ? nxt.A : cA; const char* nB = has_next ? nxt.Bt : cB;
#pragma unroll 1
        for (int t = 0; t < nt; t += 2) {
            if constexpr (Epi::MID) { if (t == (nt >> 1)) E.mid(acc, cur, wr, wc, fr, fq); }
            const bool last = (t == nt - 2);
            if constexpr (Sched::DEP) { if (last && has_next) S.a_ready(nxt, tid); }
            const char* a1 = cA + (size_t)(t + 1) * kstep;
            const char* a2 = last ? nA : cA + (size_t)(t + 2) * kstep; const char* b2 = last ? nB : cB + (size_t)(t + 2) * kstep;
            const char* a3 = a2 + kstep; const char* b3 = b2 + kstep;
            PG_LDB(B0, 0, 0); PG_SCHED; PG_LDA(At, 0, 0); PG_STAGE_A(PG_SA(1, 1), a1, vA[1]);
            if (last && has_next) PG_VOFFA(vA, nxt);
            PG_WAIT_L(8); PG_BAR; PG_WAIT_L(0); PG_MMA(0, 0, At, B0); PG_BAR; PG_SCHED;
            PG_LDB(B1, 0, 1); PG_STAGE(PG_SB(0, 0), b2, voffB);
            PG_BAR; PG_WAIT_L(0); PG_MMA(0, 1, At, B1); PG_BAR;
            PG_LDA(At, 0, 1); PG_STAGE_A(PG_SA(0, 0), a2, vA[0]);
            PG_BAR; PG_WAIT_L(0); PG_MMA(1, 0, At, B0); PG_BAR; PG_SCHED;
            PG_STAGE(PG_SB(0, 1), b2 + hstepB, voffB);
            PG_WAIT_V(6); PG_BAR; PG_MMA(1, 1, At, B1); PG_BAR;
            PG_LDB(B0, 1, 0); PG_SCHED; PG_LDA(At, 1, 0); PG_STAGE_A(PG_SA(0, 1), a2, vA[1]);
            PG_WAIT_L(8); PG_BAR; PG_WAIT_L(0); PG_MMA(0, 0, At, B0); PG_BAR; PG_SCHED;
            PG_LDB(B1, 1, 1); PG_STAGE(PG_SB(1, 0), b3, voffB);
            PG_BAR; PG_WAIT_L(0); PG_MMA(0, 1, At, B1); PG_BAR;
            PG_LDA(At, 1, 1); PG_STAGE_A(PG_SA(1, 0), a3, vA[0]);
            PG_BAR; PG_WAIT_L(0); PG_MMA(1, 0, At, B0); PG_BAR; PG_SCHED;
            PG_STAGE(PG_SB(1, 1), b3 + hstepB, voffB);
            PG_WAIT_V(6); PG_BAR; PG_MMA(1, 1, At, B1); PG_BAR;
        }
        E(acc, cur, wr, wc, fr, fq);
        if (!has_next) break;
#pragma unroll
        for (int a = 0; a < 2; ++a)
#pragma unroll
            for (int b = 0; b < 2; ++b)
#pragma unroll
                for (int m = 0; m < 4; ++m)
#pragma unroll
                    for (int n = 0; n < 2; ++n) acc[a][b][m][n] = (f32x4){0.f, 0.f, 0.f, 0.f};
        cur = nxt; cA = nA; cB = nB; ++ui;
    }
    PG_WAIT_V(0);
    if (wr == 0) PG_BAR;
    PG_BAR;
#undef PG_SA
#undef PG_SB
#undef PG_STAGE
#undef PG_STAGE_A
#undef PG_LDA
#undef PG_LDB
#undef PG_MMA
#undef PG_WAIT_V
#undef PG_WAIT_L
#undef PG_BAR
#undef PG_SCHED
#undef PG_VOFFA
}
struct TileOrder {
    static constexpr bool GATHER = false, DEP = false;
    const bf16_t* A; const bf16_t* Bt; int lda, ldb, nM, nN, nwg, G, c;
    DEVI void init(const bf16_t* A_, int lda_, const bf16_t* Bt_, int ldb_, int M, int N) { A = A_; Bt = Bt_; lda = lda_; ldb = ldb_; nM = M / 256; nN = N / 256; nwg = nM * nN; G = gridDim.x; c = blockIdx.x; }
    DEVI bool next(int i, PUnit& u) const {
        const long L = (long)i * G + c; if (L >= nwg) return false;
        int wgid = (int)L; { const int q = nwg / 8, r = nwg % 8, xcd = wgid % 8, off = wgid / 8; wgid = (xcd < r ? xcd * (q + 1) : r * (q + 1) + (xcd - r) * q) + off; }
        const int nig = 8 * nN, gid = wgid / nig, fm = gid * 8, gsz = (nM - fm) < 8 ? (nM - fm) : 8;
        u.pm = fm + ((wgid % nig) % gsz); u.pn = (wgid % nig) / gsz;
        u.A = (const char*)(A + (size_t)u.pm * 256 * lda); u.Bt = (const char*)(Bt + (size_t)u.pn * 256 * ldb); u.rows = nullptr; u.nrows = 256; u.lda = lda; u.x0 = 0; u.x1 = 0;
        return true;
    }
};

DEVI void phase_prep(const Params& p, unsigned char* smem) {
    float* sm = (float*)smem;
    bf16_t* xb = (bf16_t*)(p.ws + WS_XB); bf16_t* pb = (bf16_t*)(p.ws + WS_PB);
    constexpr int T_X = 1024, T_P = 256, T_WIN = 4 * 92, T_WA = 8 * 16, T_WB = 8 * 16, T_WO = 4 * 16, T_WPE = 1 * 16, T_WPG = 4 * 16;
    constexpr int T_LORA = 8 + 8 + 16;
    constexpr int TOTAL = T_X + T_WIN + T_WA + T_WB + T_WPE + T_LORA;
    (void)pb; (void)T_P; (void)T_WO; (void)T_WPG;
    for (int t = blockIdx.x; t < TOTAL; t += gridDim.x) {
        int u = t;
        if (u < T_X) { cvt_tile4(p.in[0], xb, u); continue; } u -= T_X;
        if (u < T_WIN) { transpose_tile4(p.in[2], (bf16_t*)(p.ws + WS_WINT), 1024, NIN, u / 92, u % 92, sm); continue; } u -= T_WIN;
        if (u < T_WA + T_WB) {
            const int sb = u >= T_WA, uu = sb ? u - T_WA : u, tr = uu / 16, tc = uu % 16;
            transpose_tile(p.in[sb ? 17 : 14], (bf16_t*)(p.ws + WS_WCAT) + sb * 512, 512, 1024, tr, tc, sm, 1024);
            continue;
        } u -= T_WA + T_WB;
        if (u < T_WPE) { transpose_tile4(p.in[30], (bf16_t*)(p.ws + WS_WPET), 256, 1024, 0, u, sm); continue; } u -= T_WPE;
        if (u < 8) transpose_tile(p.in[5], (bf16_t*)(p.ws + WS_LORA), 64, 512, 0, u, sm);
        else if (u < 16) transpose_tile(p.in[7], (bf16_t*)(p.ws + WS_LORA) + 512 * 64, 64, 512, 0, u - 8, sm);
        else transpose_tile(p.in[8], (bf16_t*)(p.ws + WS_LORA) + 2 * 512 * 64, 128, 512, (u - 16) >> 3, (u - 16) & 7, sm);
    }
    if (blockIdx.x == 0 && tidx() < 32) ((int*)(p.ws + WS_CNT))[tidx() * CNT_STRIDE] = 0;
    if (blockIdx.x >= 2 && blockIdx.x < 26) {
        const int idx = (blockIdx.x - 2) * 512 + tidx(), ln = idx & 63, hl = (idx >> 6) & 1, ks = (idx >> 7) & 3, wt = idx >> 9, t = wt % 3, w = wt / 3;
        const int n = 16 * t + (ln & 15), k = 128 * w + 32 * ks + 8 * (ln >> 4);
        float v[8];
#pragma unroll
        for (int j = 0; j < 8; ++j) v[j] = n < 4 ? p.in[21][(size_t)(k + j) * 4 + n] : (n < 36 ? p.in[23][(size_t)(k + j) * 32 + n - 4] : 0.f);
        u32x4 hi; hi[0] = pack2(v[0], v[1]); hi[1] = pack2(v[2], v[3]); hi[2] = pack2(v[4], v[5]); hi[3] = pack2(v[6], v[7]);
        u32x4 o = hi;
        if (hl) {
#pragma unroll
            for (int q = 0; q < 4; ++q) o[q] = pack2(v[2 * q] - __uint_as_float(hi[q] << 16), v[2 * q + 1] - __uint_as_float(hi[q] & 0xffff0000u));
        }
        ((u32x4*)(p.ws + WS_WR))[idx] = o;
    }
}

DEVI u32x4 pk8(f32x4 a, f32x4 b) { u32x4 o; o[0] = pack2(a[0], a[1]); o[1] = pack2(a[2], a[3]); o[2] = pack2(b[0], b[1]); o[3] = pack2(b[2], b[3]); return o; }
struct EpiInproj {
    static constexpr bool PERM = true, MID = false; unsigned char* ws;
    DEVI void operator()(const f32x4 (&acc)[2][2][4][2], const PUnit& u, int wr, int wc, int fr, int fq) const {
        bf16_t* dst; int ld;
        if (u.pn < 7) { dst = (bf16_t*)(ws + WS_PRW) + u.pn * 256; ld = NRW; }
        else if (u.pn < 15) { dst = (bf16_t*)(ws + WS_PHG) + (u.pn - 7) * 256; ld = NHG; }
        else { dst = (bf16_t*)(ws + WS_PGT) + (u.pn - 15) * 256; ld = NHG; }
        const int row0 = u.pm * 256 + wr * 64 + fr;
#pragma unroll
        for (int ai = 0; ai < 2; ++ai)
#pragma unroll
            for (int m = 0; m < 4; ++m) {
                bf16_t* rowp = dst + (size_t)(row0 + ai * 128 + m * 16) * ld + wc * 32 + 8 * fq;
#pragma unroll
                for (int bj = 0; bj < 2; ++bj) *(u32x4*)(rowp + bj * 128) = pk8(acc[ai][bj][m][0], acc[ai][bj][m][1]);
            }
    }
};
DEVI void phase_inproj(const Params& p, unsigned char* smem) {
    TileOrder S; S.init((const bf16_t*)(p.ws + WS_XB), 1024, (const bf16_t*)(p.ws + WS_WINT), 1024, NTOK, NIN);
    pgemm((PG_LAS unsigned char*)smem, 1024, 1024, S, EpiInproj{p.ws});
    if (blockIdx.x >= 192) {
        float* sm = (float*)smem;
        for (int d = (int)blockIdx.x - 192; d < 384; d += 64) {
            if (d < 256) cvt_tile4(p.in[1], (bf16_t*)(p.ws + WS_PB), d);
            else if (d < 320) transpose_tile4(p.in[18], (bf16_t*)(p.ws + WS_WOT), 1024, 1024, (d - 256) / 16, (d - 256) % 16, sm);
            else transpose_tile4(p.in[31], (bf16_t*)(p.ws + WS_WPGT), 1024, 1024, (d - 320) / 16, (d - 320) % 16, sm);
        }
    }
}

template <int MT, int NTL, int KS>
DEVI void mma_lds(f32x4 (&acc)[MT][NTL], const bf16_t* sA, int lda, const bf16_t* sB, int ldb) {
    const int lane = tidx() & 63, fr = lane & 15, fq = lane >> 4;
#pragma unroll
    for (int ks = 0; ks < KS; ++ks) {
        bf16x8 af[MT], bfr[NTL];
#pragma unroll
        for (int m = 0; m < MT; ++m) af[m] = *(const bf16x8*)(sA + (m * 16 + fr) * lda + ks * 32 + fq * 8);
#pragma unroll
        for (int n = 0; n < NTL; ++n) bfr[n] = *(const bf16x8*)(sB + (n * 16 + fr) * ldb + ks * 32 + fq * 8);
#pragma unroll
        for (int m = 0; m < MT; ++m)
#pragma unroll
            for (int n = 0; n < NTL; ++n) acc[m][n] = __builtin_amdgcn_mfma_f32_16x16x32_bf16(bfr[n], af[m], acc[m][n], 0, 0, 0);
    }
}
template <int MT, int NTL> DEVI void accz(f32x4 (&acc)[MT][NTL]) {
#pragma unroll
    for (int m = 0; m < MT; ++m)
#pragma unroll
        for (int n = 0; n < NTL; ++n) acc[m][n] = (f32x4){0.f, 0.f, 0.f, 0.f};
}


DEVI bf16_t* prep_arr(const Params& p, int i) { return i < 4 ? (bf16_t*)(p.ws + WS_PREP + (size_t)i * 16 * MiB) : (bf16_t*)((unsigned char*)p.out + (size_t)(i - 4) * 16 * MiB); }
template <int KS>
DEVI void mma_gb(f32x4 (&acc)[1][4], const bf16_t* sA, int lda, const bf16_t* gB, int ldb) {
    const int lane = tidx() & 63, fr = lane & 15, fq = lane >> 4;
#pragma unroll
    for (int ks = 0; ks < KS; ++ks) {
        if (ks & 1) asm volatile("" ::: "memory");
        const bf16x8 af = *(const bf16x8*)(sA + fr * lda + ks * 32 + fq * 8);
#pragma unroll
        for (int n = 0; n < 4; ++n) {
            const bf16x8 bfr = *(const bf16x8*)(gB + (size_t)((n >> 1) * 32 + pg_perm32((n & 1) * 16 + fr)) * ldb + ks * 32 + fq * 8);
            acc[0][n] = __builtin_amdgcn_mfma_f32_16x16x32_bf16(bfr, af, acc[0][n], 0, 0, 0);
        }
    }
}
DEVI void phase_rwkv_prep(const Params& p, unsigned char* smem) {
    const bf16_t* proj = (const bf16_t*)(p.ws + WS_PRW);
    const float* mu = p.in[3];
    const bf16_t* WupT = (const bf16_t*)(p.ws + WS_LORA); const bf16_t* AupT = WupT + 512 * 64; const bf16_t* GupT = AupT + 512 * 64;
    bf16_t* oR = prep_arr(p, 0); bf16_t* oK = prep_arr(p, 1); bf16_t* oV = prep_arr(p, 2); bf16_t* oW = prep_arr(p, 3);
    bf16_t* oKK = prep_arr(p, 4); bf16_t* oA = prep_arr(p, 5); bf16_t* oG = prep_arr(p, 6);
    bf16_t* sLin = (bf16_t*)smem;
    for (int tile = blockIdx.x; tile < NTOK / 64; tile += gridDim.x) {
        const int tid = tidx(), lane = tid & 63, wid = tid >> 6, fr = lane & 15, fq = lane >> 4, rb = wid & 3, hd = wid >> 2;
        const int t0 = tile * 64;
        __syncthreads();
        {
            float* sPar = (float*)(smem + 36864);
            const int t2 = tidx();
#pragma unroll
            for (int i = 0; i < 2; ++i) {
                const int idx = t2 + 512 * i;
                if (idx < 896) {
                    const int a = idx >> 7, off = (idx & 127) * 4;
                    const float* srcp = a == 0 ? mu : (a == 1 ? mu + C_K : (a == 2 ? mu + C_V : (a == 3 ? p.in[9] : (a == 4 ? p.in[4] : (a == 5 ? p.in[6] : p.in[10])))));
                    *(f32x4*)(sPar + a * 512 + off) = *(const f32x4*)(srcp + off);
                }
            }
        }
        {
            const int c8 = (tid & 31) * 8;
            const f32x4 m0 = *(const f32x4*)(mu + C_WD + c8), m1 = *(const f32x4*)(mu + C_WD + c8 + 4);
            u32x4 cu[4], pv[4];
#pragma unroll
            for (int i = 0; i < 4; ++i) {
                const int tt = (tid >> 5) + 16 * i, t = t0 + tt;
                cu[i] = *(const u32x4*)(proj + (size_t)t * NRW + C_WD + c8);
                pv[i] = (u32x4){0u, 0u, 0u, 0u};
                if (t % SEQ != 0) pv[i] = *(const u32x4*)(proj + (size_t)(t - 1) * NRW + C_WD + c8);
            }
#pragma unroll
            for (int i = 0; i < 4; ++i) {
                float o[8];
#pragma unroll
                for (int k = 0; k < 8; ++k) {
                    const float c = (k & 1) ? __uint_as_float(cu[i][k >> 1] & 0xffff0000u) : __uint_as_float(cu[i][k >> 1] << 16);
                    const float pr = (k & 1) ? __uint_as_float(pv[i][k >> 1] & 0xffff0000u) : __uint_as_float(pv[i][k >> 1] << 16);
                    const float u = c + (pr - c) * (k < 4 ? m0[k & 3] : m1[k & 3]);
                    o[k] = c8 < 64 ? (1.f - 2.f * __builtin_amdgcn_rcpf(__expf(2.f * u) + 1.f)) : (c8 < 128 ? u : sigm(u));
                }
                u32x4 pk; pk[0] = pack2(o[0], o[1]); pk[1] = pack2(o[2], o[3]); pk[2] = pack2(o[4], o[5]); pk[3] = pack2(o[6], o[7]);
                *(u32x4*)(sLin + ((tid >> 5) + 16 * i) * 264 + c8) = pk;
            }
        }
        __syncthreads();
        const int t = t0 + rb * 16 + fr; const bool first = (t % SEQ == 0);
        const bf16_t* row = proj + (size_t)t * NRW; const bf16_t* prow = first ? row : row - NRW;
        u32x4 ld_k[2], ld_pk[2], ld_r[2], ld_v[2], ld_pr[2], ld_pv[2];
#pragma unroll
        for (int g = 0; g < 2; ++g) {
            const int c = (hd * 4) * 64 + g * 32 + fq * 8;
            ld_k[g] = *(const u32x4*)(row + C_K + c); ld_pk[g] = *(const u32x4*)(prow + C_K + c);
            ld_r[g] = *(const u32x4*)(row + c); ld_v[g] = *(const u32x4*)(row + C_V + c); ld_pr[g] = *(const u32x4*)(prow + c); ld_pv[g] = *(const u32x4*)(prow + C_V + c);
        }
#pragma unroll 1
        for (int hh = 0; hh < 4; ++hh) {
            const int head = hd * 4 + hh;
            constexpr int HW = 64 * 72, HG = 64 * 136, HSZ = 2 * HW + HG;
            bf16_t* sWt = (bf16_t*)(smem + 51200);
            __syncthreads();
#pragma unroll
            for (int half = 0; half < 2; ++half) {
                u32x4 wv[4];
#pragma unroll
                for (int i = 0; i < 4; ++i) {
                    const int piece = tid + 512 * (half * 4 + i), sel = piece >> 11, pp = piece & 2047, hg = sel * 4 + hh;
                    const bf16_t* srcw;
                    if (pp < 512) srcw = WupT + (size_t)hg * 4096 + (pp >> 3) * 64 + (pp & 7) * 8;
                    else if (pp < 1024) srcw = AupT + (size_t)hg * 4096 + ((pp - 512) >> 3) * 64 + (pp & 7) * 8;
                    else srcw = GupT + (size_t)hg * 8192 + ((pp - 1024) >> 4) * 128 + (pp & 15) * 8;
                    wv[i] = *(const u32x4*)srcw;
                }
#pragma unroll
                for (int i = 0; i < 4; ++i) {
                    const int piece = tid + 512 * (half * 4 + i), sel = piece >> 11, pp = piece & 2047;
                    bf16_t* dstw;
                    if (pp < 512) dstw = sWt + sel * HSZ + (pp >> 3) * 72 + (pp & 7) * 8;
                    else if (pp < 1024) dstw = sWt + sel * HSZ + HW + ((pp - 512) >> 3) * 72 + (pp & 7) * 8;
                    else dstw = sWt + sel * HSZ + 2 * HW + ((pp - 1024) >> 4) * 136 + (pp & 15) * 8;
                    *(u32x4*)dstw = wv[i];
                }
                asm volatile("" ::: "memory");
            }
            __syncthreads();
            f32x4 aw[1][4], aa[1][4], ag[1][4]; accz(aw); accz(aa); accz(ag);
            {
                const bf16_t* linA = sLin + (rb * 16 + fr) * 264 + fq * 8;
                const bf16_t* hbw = sWt + hd * HSZ + fq * 8;
                int wrow[4];
#pragma unroll
                for (int n = 0; n < 4; ++n) wrow[n] = (n >> 1) * 32 + pg_perm32((n & 1) * 16 + fr);
#pragma unroll
                for (int ks = 0; ks < 2; ++ks) { const bf16x8 af = *(const bf16x8*)(linA + ks * 32);
#pragma unroll
                    for (int n = 0; n < 4; ++n) aw[0][n] = __builtin_amdgcn_mfma_f32_16x16x32_bf16(*(const bf16x8*)(hbw + wrow[n] * 72 + ks * 32), af, aw[0][n], 0, 0, 0); asm volatile("" ::: "memory"); }
#pragma unroll
                for (int ks = 0; ks < 2; ++ks) { const bf16x8 af = *(const bf16x8*)(linA + 64 + ks * 32);
#pragma unroll
                    for (int n = 0; n < 4; ++n) aa[0][n] = __builtin_amdgcn_mfma_f32_16x16x32_bf16(*(const bf16x8*)(hbw + HW + wrow[n] * 72 + ks * 32), af, aa[0][n], 0, 0, 0); asm volatile("" ::: "memory"); }
#pragma unroll
                for (int ks = 0; ks < 4; ++ks) { const bf16x8 af = *(const bf16x8*)(linA + 128 + ks * 32);
#pragma unroll
                    for (int n = 0; n < 4; ++n) ag[0][n] = __builtin_amdgcn_mfma_f32_16x16x32_bf16(*(const bf16x8*)(hbw + 2 * HW + wrow[n] * 136 + ks * 32), af, ag[0][n], 0, 0, 0); asm volatile("" ::: "memory"); }
            }
            float kl[2][8];
            float ss = 0.f;
#pragma unroll
            for (int g = 0; g < 2; ++g) {
                const int c = head * 64 + g * 32 + fq * 8;
                const u32x4 k8 = ld_k[g], p8 = ld_pk[g];
                const float* sPar = (const float*)(smem + 36864);
                const f32x4 mk0 = *(const f32x4*)(sPar + 512 + c), mk1 = *(const f32x4*)(sPar + 512 + c + 4), kc0 = *(const f32x4*)(sPar + 3 * 512 + c), kc1 = *(const f32x4*)(sPar + 3 * 512 + c + 4);
#pragma unroll
                for (int x = 0; x < 8; ++x) {
                    const float kc = (x & 1) ? __uint_as_float(k8[x >> 1] & 0xffff0000u) : __uint_as_float(k8[x >> 1] << 16);
                    const float pk = first ? 0.f : ((x & 1) ? __uint_as_float(p8[x >> 1] & 0xffff0000u) : __uint_as_float(p8[x >> 1] << 16));
                    const float k = kc + (pk - kc) * (x < 4 ? mk0[x & 3] : mk1[x & 3]);
                    kl[g][x] = k; const float kk = k * (x < 4 ? kc0[x & 3] : kc1[x & 3]); ss += kk * kk;
                }
            }
            ss += __shfl_xor(ss, 16, 64); ss += __shfl_xor(ss, 32, 64);
            const float inv = __builtin_amdgcn_rcpf(fmaxf(__builtin_amdgcn_sqrtf(ss), 1e-12f));
            if (hh < 3) {
#pragma unroll
                for (int g = 0; g < 2; ++g) { const int cn = (head + 1) * 64 + g * 32 + fq * 8; ld_k[g] = *(const u32x4*)(row + C_K + cn); ld_pk[g] = *(const u32x4*)(prow + C_K + cn); }
            }
#pragma unroll
            for (int g = 0; g < 2; ++g) {
                if (g == 1) asm volatile("" ::: "memory");
                const int c = head * 64 + g * 32 + fq * 8;
                const u32x4 r8 = ld_r[g], v8 = ld_v[g], pr8 = ld_pr[g], pv8 = ld_pv[g];
                if (hh < 3) { const int cn = (head + 1) * 64 + g * 32 + fq * 8;
                    ld_r[g] = *(const u32x4*)(row + cn); ld_v[g] = *(const u32x4*)(row + C_V + cn); ld_pr[g] = *(const u32x4*)(prow + cn); ld_pv[g] = *(const u32x4*)(prow + C_V + cn); }
                float rr[8], vv[8], lw[8], av[8], kp[8], kkn[8], gg[8];
#pragma unroll
                for (int hx = 0; hx < 2; ++hx) {
                    const int cc = c + hx * 4;
                    const float* sPar = (const float*)(smem + 36864);
                    const f32x4 mr = *(const f32x4*)(sPar + cc), mv = *(const f32x4*)(sPar + 2 * 512 + cc);
                    const f32x4 w0 = *(const f32x4*)(sPar + 4 * 512 + cc), a0 = *(const f32x4*)(sPar + 5 * 512 + cc), kkc = *(const f32x4*)(sPar + 3 * 512 + cc), kac = *(const f32x4*)(sPar + 6 * 512 + cc);
#pragma unroll
                    for (int q = 0; q < 4; ++q) {
                        const int x = hx * 4 + q;
                        const float rc = (x & 1) ? __uint_as_float(r8[x >> 1] & 0xffff0000u) : __uint_as_float(r8[x >> 1] << 16);
                        const float vc = (x & 1) ? __uint_as_float(v8[x >> 1] & 0xffff0000u) : __uint_as_float(v8[x >> 1] << 16);
                        const float prx = first ? 0.f : ((x & 1) ? __uint_as_float(pr8[x >> 1] & 0xffff0000u) : __uint_as_float(pr8[x >> 1] << 16));
                        const float pvx = first ? 0.f : ((x & 1) ? __uint_as_float(pv8[x >> 1] & 0xffff0000u) : __uint_as_float(pv8[x >> 1] << 16));
                        rr[x] = rc + (prx - rc) * mr[q]; vv[x] = vc + (pvx - vc) * mv[q];
                        const float z = -(w0[q] + aw[0][g * 2 + hx][q]);
                        const float sp = z > 20.f ? z : __logf(1.f + __expf(z));
                        lw[x] = -__expf(-sp - 0.5f);
                        const float a = sigm(a0[q] + aa[0][g * 2 + hx][q]);
                        av[x] = a; kkn[x] = kl[g][x] * kkc[q] * inv; kp[x] = kl[g][x] * (1.f + (a - 1.f) * kac[q]); gg[x] = ag[0][g * 2 + hx][q];
                    }
                }
                const size_t o = (size_t)t * 512 + c;
#define ST8(dst, a) do { u32x4 _o; _o[0] = pack2(a[0], a[1]); _o[1] = pack2(a[2], a[3]); _o[2] = pack2(a[4], a[5]); _o[3] = pack2(a[6], a[7]); *(u32x4*)((dst) + o) = _o; } while (0)
                ST8(oR, rr); ST8(oK, kp); ST8(oV, vv); ST8(oW, lw); ST8(oKK, kkn); ST8(oA, av); ST8(oG, gg);
#undef ST8
            }
        }
    }
}

DEVI void scan_rwkv_naive(const Params& p, unsigned char* smem, int blk) {
    const int tid = tidx(), lane = tid & 63, wid = tid >> 6;
    const int unit = blk * 8 + wid, b = unit >> 3, h = unit & 7, c = h * 64 + lane;
    float* sw = (float*)smem + wid * (4 * 7 * 64);
    float* srk = (float*)smem + 8 * (4 * 7 * 64) + wid * 64;
    const bf16_t* iR = prep_arr(p, 0); const bf16_t* iK = prep_arr(p, 1); const bf16_t* iV = prep_arr(p, 2); const bf16_t* iW = prep_arr(p, 3);
    const bf16_t* iKK = prep_arr(p, 4); const bf16_t* iA = prep_arr(p, 5); const bf16_t* iG = prep_arr(p, 6);
    bf16_t* ya = (bf16_t*)(p.ws + WS_YA);
    srk[lane] = p.in[11][c];
    const float gnw = p.in[12][c], gnb = p.in[13][c];
    float S[64];
#pragma unroll
    for (int j = 0; j < 64; ++j) S[j] = 0.f;
    for (int t0 = 0; t0 < SEQ; t0 += 4) {
        __syncthreads();
#pragma unroll
        for (int s = 0; s < 4; ++s) {
            const size_t o = (size_t)(b * SEQ + t0 + s) * 512 + c;
            const float r = bf2f(iR[o]), k = bf2f(iK[o]), w = __expf(bf2f(iW[o])), kk = bf2f(iKK[o]), a = bf2f(iA[o]);
            float* d = sw + s * 7 * 64 + lane;
            d[0] = r; d[64] = k; d[128] = w; d[192] = -kk; d[256] = kk * a; d[320] = bf2f(iV[o]); d[384] = bf2f(iG[o]);
        }
        __syncthreads();
#pragma unroll 1
        for (int s = 0; s < 4; ++s) {
            const f32x4* vr = (const f32x4*)(sw + s * 7 * 64);
            const f32x4* vk = vr + 16; const f32x4* vw = vr + 32; const f32x4* va = vr + 48; const f32x4* vb = vr + 64;
            const float v = sw[s * 7 * 64 + 320 + lane], g = sw[s * 7 * 64 + 384 + lane];
            float sa = 0.f;
#pragma unroll
            for (int j4 = 0; j4 < 16; ++j4) { const f32x4 a4 = va[j4];
#pragma unroll
                for (int q = 0; q < 4; ++q) sa += S[j4 * 4 + q] * a4[q]; }
            float y = 0.f, bon = 0.f;
#pragma unroll
            for (int j4 = 0; j4 < 16; ++j4) {
                const f32x4 w4 = vw[j4], b4 = vb[j4], k4 = vk[j4], r4 = vr[j4], rk4 = ((const f32x4*)srk)[j4];
#pragma unroll
                for (int q = 0; q < 4; ++q) {
                    const float sn = S[j4 * 4 + q] * w4[q] + sa * b4[q] + v * k4[q];
                    S[j4 * 4 + q] = sn; y += sn * r4[q]; bon += r4[q] * k4[q] * rk4[q];
                }
            }
            const float mean = wave_sum(y) * (1.f / 64.f);
            const float d = y - mean;
            const float var = wave_sum(d * d) * (1.f / 64.f);
            const float outv = (d * rsqrtf(var + GN_EPS) * gnw + gnb + bon * v) * g;
            ya[(size_t)(b * SEQ + t0 + s) * 512 + c] = f2bf(outv);
        }
    }
}
DEVI void scan_hgrn_naive(const Params& p, unsigned char* smem, int blk) {
    const int tid = tidx(), lane = tid & 63, ul = tid >> 7, v = tid & 127, wiu = (tid >> 6) & 1;
    const int unit = blk * 4 + ul, b = unit >> 2, h = unit & 3, c = h * 128 + v;
    float* su = (float*)smem + ul * (4 * 5 * 128);
    float* spart = (float*)smem + 4 * (4 * 5 * 128) + ul * 8;
    const bf16_t* proj = (const bf16_t*)(p.ws + WS_PHG);
    bf16_t* yb = (bf16_t*)(p.ws + WS_YB);
    const float l0 = p.in[15][c], l1 = p.in[15][512 + c];
    const float lb = 1.f / (1.f + __expf(l1 - l0));
    const float nw = p.in[16][c];
    float S[128];
#pragma unroll
    for (int e = 0; e < 128; ++e) S[e] = 0.f;
    for (int t0 = 0; t0 < SEQ; t0 += 4) {
        __syncthreads();
#pragma unroll
        for (int s = 0; s < 4; ++s) {
            const bf16_t* row = proj + (size_t)(b * SEQ + t0 + s) * NHG;
            const float z = bf2f(row[H_F + c]), qr = bf2f(row[H_Q + c]);
            const float sg = sigm(z);
            float* d = su + s * 5 * 128 + v;
            d[0] = lb + (1.f - lb) * sg; d[128] = (1.f - lb) * (1.f - sg); d[256] = qr * sigm(qr); d[384] = bf2f(row[H_I + c]); d[512] = bf2f(row[H_OG + c]);
        }
        __syncthreads();
        float os[4];
#pragma unroll
        for (int s = 0; s < 4; ++s) {
            const f32x4* vf = (const f32x4*)(su + s * 5 * 128); const f32x4* vk = vf + 32; const f32x4* vq = vf + 64;
            const float vin = su[s * 5 * 128 + 384 + v];
            float o = 0.f;
#pragma unroll
            for (int e4 = 0; e4 < 32; ++e4) {
                const f32x4 f4 = vf[e4], k4 = vk[e4], q4 = vq[e4];
#pragma unroll
                for (int q = 0; q < 4; ++q) { const float sn = f4[q] * S[e4 * 4 + q] + k4[q] * vin; S[e4 * 4 + q] = sn; o += q4[q] * sn; }
            }
            os[s] = o;
            const float ss = wave_sum(o * o);
            if (lane == 0) spart[s * 2 + wiu] = ss;
        }
        __syncthreads();
#pragma unroll
        for (int s = 0; s < 4; ++s) {
            const float tot = spart[s * 2] + spart[s * 2 + 1];
            const float og = su[s * 5 * 128 + 512 + v];
            yb[(size_t)(b * SEQ + t0 + s) * 512 + c] = f2bf(os[s] * rsqrtf(tot * (1.f / 128.f) + RMS_EPS) * nw * sigm(og));
        }
    }
}

DEVI bf16_t* kv_ptr(const Params& p, int unit) {
    return unit < 768 ? (bf16_t*)(p.ws + WS_PRW + 32 * MiB) + (size_t)unit * 16384 : (bf16_t*)((unsigned char*)p.out + 48 * MiB) + (size_t)(unit - 768) * 16384;
}
constexpr int H1_LDS = 74240;
DEVI void h1_issue(const Params& p, int pair, u32x4 (&pre)[12]) {
    const int tid = tidx(), hb = tid >> 8, lt = tid & 255, unit = pair * 2 + hb;
    const int c = unit & 63, bh = unit >> 6, h = bh & 3, b = bh >> 2, t0 = b * SEQ + c * 64;
    const bf16_t* phg = (const bf16_t*)(p.ws + WS_PHG);
#pragma unroll
    for (int i = 0; i < 4; ++i) {
        const int idx = lt + 256 * i, t = idx >> 4, ch = idx & 15;
        const bf16_t* row = phg + (size_t)(t0 + t) * NHG + h * 128 + ch * 8;
        pre[i * 3] = *(const u32x4*)(row + H_F); pre[i * 3 + 1] = *(const u32x4*)(row + H_Q); pre[i * 3 + 2] = *(const u32x4*)(row + H_I);
    }
}
DEVI void r1_issue(const Params& p, int pair, u32x4 (&pre)[12]) {
    const int tid = tidx(), hb = tid >> 8, lt = tid & 255, unit = pair * 2 + hb;
    const int c = unit & 63, bh = unit >> 6, h = bh & 7, b = bh >> 3, t0 = b * SEQ + c * 64, cb = h * 64;
#pragma unroll
    for (int i = 0; i < 2; ++i) {
        const int idx = lt + 256 * i, t = idx >> 3, ch = idx & 7; const size_t o = (size_t)(t0 + t) * 512 + cb + ch * 8;
        pre[i * 6] = *(const u32x4*)(prep_arr(p, 4) + o); pre[i * 6 + 1] = *(const u32x4*)(prep_arr(p, 5) + o); pre[i * 6 + 2] = *(const u32x4*)(prep_arr(p, 1) + o);
        pre[i * 6 + 3] = *(const u32x4*)(prep_arr(p, 3) + o); pre[i * 6 + 4] = *(const u32x4*)(prep_arr(p, 0) + o); pre[i * 6 + 5] = *(const u32x4*)(prep_arr(p, 2) + o);
    }
}
DEVI void next_issue(const Params& p, int kind, int pair, u32x4 (&pre)[12]) { if (kind == 1) r1_issue(p, pair, pre); else if (kind == 2) h1_issue(p, pair, pre); }
DEVI void hgrn_h1(const Params& p, unsigned char* smem, int pair, u32x4 (&pre)[12], int nkind, int npair) {
    const int tid = tidx(), hb = tid >> 8, lt = tid & 255, lw = lt >> 6, lane = tid & 63, fr = lane & 15, fq = lane >> 4;
    const int unit = pair * 2 + hb;
    const int c = unit & 63, bh = unit >> 6, h = bh & 3, b = bh >> 2, t0 = b * SEQ + c * 64;
    bf16_t* phg = (bf16_t*)(p.ws + WS_PHG);
    unsigned char* base = smem + hb * H1_LDS;
    bf16_t* sZ = (bf16_t*)base; bf16_t* sQ = sZ + 64 * 136; bf16_t* sKtT = sQ + 64 * 136; bf16_t* sVT = sKtT + 128 * 72; float* sG = (float*)(sVT + 128 * 72); float* sTot = sG + 128;
    __syncthreads();
#pragma unroll
    for (int i = 0; i < 4; ++i) {
        const int idx = lt + 256 * i, t = idx >> 4, ch = idx & 15;
        *(u32x4*)(sZ + t * 136 + ch * 8) = pre[i * 3];
        *(u32x4*)(sQ + t * 136 + ch * 8) = pre[i * 3 + 1];
        const u32x4 vv = pre[i * 3 + 2];
#pragma unroll
        for (int k = 0; k < 8; ++k) {
            const int j = (k + ch) & 7; const unsigned w = (j & 2) ? ((j & 4) ? vv[3] : vv[1]) : ((j & 4) ? vv[2] : vv[0]);
            sVT[(ch * 8 + j) * 72 + t] = (bf16_t)((j & 1) ? (w >> 16) : (w & 0xffffu));
        }
    }
    __syncthreads();
    const int e = lt & 127, th = lt >> 7, col = h * 128 + e;
    const float l0 = p.in[15][col], l1 = p.in[15][512 + col];
    const float lb = 1.f / (1.f + __expf(l1 - l0));
    float bs[32], kv[32];
    {
        float run = 0.f;
#pragma unroll
        for (int i = 0; i < 32; ++i) {
            const float z = bf2f(sZ[(th * 32 + i) * 136 + e]);
            const float sg = sigm(z), f = lb + (1.f - lb) * sg;
            kv[i] = (1.f - lb) * (1.f - sg);
            run += __logf(f); bs[i] = run;
        }
        sTot[th * 128 + e] = run;
    }
    __syncthreads();
    {
        const float off = th ? sTot[e] : 0.f;
        u32x4 pk[4];
#pragma unroll
        for (int i = 0; i < 32; i += 2) {
            const float b0 = off + bs[i], b1 = off + bs[i + 1];
            const float e0 = __expf(b0), e1 = __expf(b1);
            const float q0 = bf2f(sQ[(th * 32 + i) * 136 + e]), q1 = bf2f(sQ[(th * 32 + i + 1) * 136 + e]);
            const bf16_t kt0 = f2bf(kv[i] * __builtin_amdgcn_rcpf(e0)), kt1 = f2bf(kv[i + 1] * __builtin_amdgcn_rcpf(e1));
            const bf16_t qt0 = f2bf(q0 * sigm(q0) * e0), qt1 = f2bf(q1 * sigm(q1) * e1);
            pk[i >> 3][(i >> 1) & 3] = (unsigned)kt0 | ((unsigned)kt1 << 16);
            bf16_t* r0 = phg + (size_t)(t0 + th * 32 + i) * NHG + col; bf16_t* r1 = r0 + NHG;
            r0[H_F] = kt0; r0[H_Q] = qt0; r1[H_F] = kt1; r1[H_Q] = qt1;
        }
#pragma unroll
        for (int k = 0; k < 4; ++k) *(u32x4*)(sKtT + e * 72 + th * 32 + k * 8) = pk[k];
        if (th == 1) { const float G = __expf(off + bs[31]); sG[e] = G; ((float*)(p.ws + WS_GBUF))[(size_t)unit * 128 + e] = G; }
    }
    __syncthreads();
    next_issue(p, nkind, npair, pre);
    f32x4 acc[2][8]; accz(acc);
    mma_lds<2, 8, 2>(acc, sVT + lw * 32 * 72, 72, sKtT, 72);
    bf16_t* kvp = kv_ptr(p, unit);
#pragma unroll
    for (int m = 0; m < 2; ++m)
#pragma unroll
        for (int n = 0; n < 8; ++n) {
            const f32x4 g4 = *(const f32x4*)(sG + n * 16 + fq * 4);
            st_bf4(kvp + (size_t)(lw * 32 + m * 16 + fr) * 128 + n * 16 + fq * 4, acc[m][n] * g4);
        }
}
DEVI void hgrn_h2(const Params& p, unsigned char* smem, int jj) {
    const int tid = tidx(), bh = jj >> 3, rem = (jj & 7) * 512 + tid, eo = (rem & 31) * 4;
    const unsigned voff = (unsigned)((rem >> 5) * 128 + (rem & 31) * 4) * 2u;
    float* sG = (float*)smem;
    const f32x4* gsrc = (const f32x4*)((const float*)(p.ws + WS_GBUF) + (size_t)bh * 64 * 128);
    f32x4 gv[4];
#pragma unroll
    for (int i = 0; i < 4; ++i) gv[i] = gsrc[tid + 512 * i];
    char* base = (char*)kv_ptr(p, bh * 64);
    u32x2 kv[64];
#pragma unroll
    for (int c = 0; c < 64; ++c) kv[c] = *(const u32x2*)(base + (voff + (unsigned)c * 32768u));
    __syncthreads();
#pragma unroll
    for (int i = 0; i < 4; ++i) ((f32x4*)sG)[tid + 512 * i] = gv[i];
    __syncthreads();
    float S[4] = {0.f, 0.f, 0.f, 0.f};
#pragma unroll
    for (int c = 0; c < 64; ++c) {
        const f32x4 g = *(const f32x4*)(sG + c * 128 + eo);
        S[0] = g[0] * S[0] + __uint_as_float(kv[c][0] << 16); S[1] = g[1] * S[1] + __uint_as_float(kv[c][0] & 0xffff0000u);
        S[2] = g[2] * S[2] + __uint_as_float(kv[c][1] << 16); S[3] = g[3] * S[3] + __uint_as_float(kv[c][1] & 0xffff0000u);
        u32x2 o; o[0] = pack2(S[0], S[1]); o[1] = pack2(S[2], S[3]);
        __hip_atomic_store((unsigned long long*)(base + (voff + (unsigned)c * 32768u)), (unsigned long long)o[0] | ((unsigned long long)o[1] << 32), __ATOMIC_RELAXED, __HIP_MEMORY_SCOPE_AGENT);
    }
}
DEVI void h3_issue(const Params& p, int unit, u32x4 (&pre)[10]) {
    const int tid = tidx();
    const int c = unit & 63, bh = unit >> 6, h = bh & 3, b = bh >> 2, t0 = b * SEQ + c * 64;
    const bf16_t* phg = (const bf16_t*)(p.ws + WS_PHG);
#pragma unroll
    for (int i = 0; i < 2; ++i) {
        const int idx = tid + 512 * i, t = idx >> 4, ch = idx & 15;
        const bf16_t* row = phg + (size_t)(t0 + t) * NHG + h * 128 + ch * 8;
        pre[i * 3] = *(const u32x4*)(row + H_F); pre[i * 3 + 1] = *(const u32x4*)(row + H_Q); pre[i * 3 + 2] = *(const u32x4*)(row + H_I);
    }
    const bf16_t* s0 = kv_ptr(p, c > 0 ? unit - 1 : unit);
#pragma unroll
    for (int i = 0; i < 4; ++i) {
        const int idx = tid + 512 * i, v = idx >> 4, ch = idx & 15;
        pre[6 + i] = (u32x4){0u, 0u, 0u, 0u};
        if (c > 0) pre[6 + i] = *(const u32x4*)(s0 + v * 128 + ch * 8);
    }
}
#define H3_BAR() do { asm volatile("s_waitcnt lgkmcnt(0)" ::: "memory"); __builtin_amdgcn_s_barrier(); asm volatile("" ::: "memory"); } while (0)
DEVI void hgrn_h3(const Params& p, unsigned char* smem, int unit, u32x4 (&pre)[10], int nunit, bf16_t* ydst, int yld) {
    const int tid = tidx(), wid = tid >> 6, lane = tid & 63, fr = lane & 15, fq = lane >> 4;
    const int c = unit & 63, bh = unit >> 6, h = bh & 3, b = bh >> 2, t0 = b * SEQ + c * 64;
    bf16_t* phg = (bf16_t*)(p.ws + WS_PHG);
    bf16_t* sQt = (bf16_t*)smem; bf16_t* sKt = sQt + 64 * 136; bf16_t* sVT = sKt + 64 * 136; bf16_t* sS0 = sVT + 128 * 72; bf16_t* sAtt = sS0 + 128 * 136;
    float* sO = (float*)sS0;
    __syncthreads();
#pragma unroll
    for (int i = 0; i < 2; ++i) {
        const int idx = tid + 512 * i, t = idx >> 4, ch = idx & 15;
        *(u32x4*)(sKt + t * 136 + ch * 8) = pre[i * 3];
        *(u32x4*)(sQt + t * 136 + ch * 8) = pre[i * 3 + 1];
        const u32x4 vv = pre[i * 3 + 2];
#pragma unroll
        for (int k = 0; k < 8; ++k) {
            const int j = (k + ch) & 7; const unsigned w = (j & 2) ? ((j & 4) ? vv[3] : vv[1]) : ((j & 4) ? vv[2] : vv[0]);
            sVT[(ch * 8 + j) * 72 + t] = (bf16_t)((j & 1) ? (w >> 16) : (w & 0xffffu));
        }
    }
#pragma unroll
    for (int i = 0; i < 4; ++i) {
        const int idx = tid + 512 * i, v = idx >> 4, ch = idx & 15;
        *(u32x4*)(sS0 + v * 136 + ch * 8) = pre[6 + i];
    }
    H3_BAR();
    if (nunit >= 0) h3_issue(p, nunit, pre);
    const int rb = wid >> 1, ch2 = wid & 1, t = rb * 16 + fr;
    {
        f32x4 at[1][2]; accz(at);
        mma_lds<1, 2, 4>(at, sQt + rb * 16 * 136, 136, sKt + ch2 * 32 * 136, 136);
#pragma unroll
        for (int n = 0; n < 2; ++n) {
            const int s0i = ch2 * 32 + n * 16 + fq * 4;
            f32x4 m;
#pragma unroll
            for (int x = 0; x < 4; ++x) m[x] = (s0i + x <= t) ? at[0][n][x] : 0.f;
            st_bf4(sAtt + t * 72 + s0i, m);
        }
    }
    f32x4 ao[1][4]; accz(ao);
    mma_lds<1, 4, 4>(ao, sQt + rb * 16 * 136, 136, sS0 + ch2 * 64 * 136, 136);
    H3_BAR();
    mma_lds<1, 4, 2>(ao, sAtt + rb * 16 * 72, 72, sVT + ch2 * 64 * 72, 72);
#pragma unroll
    for (int n = 0; n < 4; ++n) *(f32x4*)(sO + t * 132 + ch2 * 64 + n * 16 + fq * 4) = ao[0][n];
    H3_BAR();
    {
        const int te = tid >> 3, v0 = (tid & 7) * 16;
        f32x4 o[4]; float ss = 0.f;
#pragma unroll
        for (int k = 0; k < 4; ++k) { o[k] = *(const f32x4*)(sO + te * 132 + v0 + k * 4); ss += o[k][0] * o[k][0] + o[k][1] * o[k][1] + o[k][2] * o[k][2] + o[k][3] * o[k][3]; }
        ss += __shfl_xor(ss, 1, 64); ss += __shfl_xor(ss, 2, 64); ss += __shfl_xor(ss, 4, 64);
        const float rstd = rsqrtf(ss * (1.f / 128.f) + RMS_EPS);
        bf16_t* row = phg + (size_t)(t0 + te) * NHG + h * 128 + v0;
        const float* nw = p.in[16] + h * 128 + v0;
#pragma unroll
        for (int k = 0; k < 4; ++k) {
            const f32x4 og = ld_bf4(row + H_OG + k * 4), w4 = *(const f32x4*)(nw + k * 4);
            f32x4 r;
#pragma unroll
            for (int x = 0; x < 4; ++x) r[x] = o[k][x] * rstd * w4[x] * sigm(og[x]);
            st_bf4(ydst + (size_t)(t0 + te) * yld + h * 128 + v0 + k * 4, r);
        }
    }
}


constexpr int R1_LDS = 81152;
DEVI void rwkv_r1(const Params& p, unsigned char* smem, int pair, u32x4 (&pre)[12], int nkind, int npair) {
    const int tid = tidx(), hb = tid >> 8, lt = tid & 255, lw = lt >> 6, lane = tid & 63, fr = lane & 15, fq = lane >> 4;
    const int unit = pair * 2 + hb;
    const int c = unit & 63, bh = unit >> 6, h = bh & 7, b = bh >> 3, t0 = b * SEQ + c * 64, cb = h * 64;
    bf16_t* aR = prep_arr(p, 0); bf16_t* aK = prep_arr(p, 1); bf16_t* aV = prep_arr(p, 2); bf16_t* aW = prep_arr(p, 3);
    bf16_t* aKK = prep_arr(p, 4); bf16_t* aA = prep_arr(p, 5);
    unsigned char* base = smem + hb * R1_LDS;
    float* sAab = (float*)base; float* sWC = sAab + 64 * 64;
    bf16_t* sAt = (bf16_t*)(sWC + 64); bf16_t* sBt = sAt + 64 * 72; bf16_t* sKt = sBt + 64 * 72; bf16_t* sBtT = sKt + 64 * 72; bf16_t* sKtT = sBtT + 64 * 72;
    bf16_t* sVT = sKtT + 64 * 72; bf16_t* sAak = sVT + 64 * 72;
    float* sP = (float*)sBt;
    bf16_t* sLW = (bf16_t*)sAab; bf16_t* sR = sBtT; float* sTot = (float*)sKtT;
    bf16_t* sX1T = sAt; bf16_t* sUT = sAak;
    __syncthreads();
#pragma unroll
    for (int i = 0; i < 2; ++i) {
        const int idx = lt + 256 * i, t = idx >> 3, ch = idx & 7; const int lo = t * 72 + ch * 8;
        *(u32x4*)(sAt + lo) = pre[i * 6];
        *(u32x4*)(sBt + lo) = pre[i * 6 + 1];
        *(u32x4*)(sKt + lo) = pre[i * 6 + 2];
        *(u32x4*)(sLW + lo) = pre[i * 6 + 3];
        *(u32x4*)(sR + lo) = pre[i * 6 + 4];
        const u32x4 vv = pre[i * 6 + 5];
#pragma unroll
        for (int k = 0; k < 8; ++k) {
            const int j = (k + ch) & 7; const unsigned w = (j & 2) ? ((j & 4) ? vv[3] : vv[1]) : ((j & 4) ? vv[2] : vv[0]);
            sVT[(ch * 8 + j) * 72 + t] = (bf16_t)((j & 1) ? (w >> 16) : (w & 0xffffu));
        }
    }
    __syncthreads();
    const int j = lt & 63, tq = lt >> 6;
    float ls[16];
    {
        float run = 0.f;
#pragma unroll
        for (int i = 0; i < 16; ++i) { run += bf2f(sLW[(tq * 16 + i) * 72 + j]); ls[i] = run; }
        sTot[tq * 64 + j] = run;
    }
    __syncthreads();
    {
        float off = 0.f;
#pragma unroll
        for (int k = 0; k < 3; ++k) off += (k < tq) ? sTot[k * 64 + j] : 0.f;
        float kkv[16], av[16], kp[16], rv[16];
#pragma unroll
        for (int i = 0; i < 16; ++i) { const int lo = (tq * 16 + i) * 72 + j; kkv[i] = bf2f(sAt[lo]); av[i] = bf2f(sBt[lo]); kp[i] = bf2f(sKt[lo]); rv[i] = bf2f(sR[lo]); }
        __syncthreads();
        u32x4 pb[2], pkk[2];
        float eprev = __expf(off);
#pragma unroll
        for (int i = 0; i < 16; ++i) {
            const float ecur = __expf(off + ls[i]), einv = __builtin_amdgcn_rcpf(ecur);
            const bf16_t at = f2bf(-kkv[i] * eprev), bt = f2bf(kkv[i] * av[i] * einv), kt = f2bf(kp[i] * einv), rt = f2bf(rv[i] * ecur);
            eprev = ecur;
            const int lo = (tq * 16 + i) * 72 + j;
            sAt[lo] = at; sBt[lo] = bt; sKt[lo] = kt;
            if (i & 1) { pb[i >> 3][(i >> 1) & 3] |= (unsigned)bt << 16; pkk[i >> 3][(i >> 1) & 3] |= (unsigned)kt << 16; }
            else { pb[i >> 3][(i >> 1) & 3] = (unsigned)bt; pkk[i >> 3][(i >> 1) & 3] = (unsigned)kt; }
            const size_t o = (size_t)(t0 + tq * 16 + i) * 512 + cb + j;
            aR[o] = rt; aK[o] = kt; aKK[o] = bt;
        }
        *(u32x4*)(sBtT + j * 72 + tq * 16) = pb[0]; *(u32x4*)(sBtT + j * 72 + tq * 16 + 8) = pb[1];
        *(u32x4*)(sKtT + j * 72 + tq * 16) = pkk[0]; *(u32x4*)(sKtT + j * 72 + tq * 16 + 8) = pkk[1];
        if (tq == 3) sWC[j] = eprev;
    }
    __syncthreads();
    const int tr = lw * 16 + fr;
    {
        f32x4 ab[1][4], ak[1][4]; accz(ab); accz(ak);
        mma_lds<1, 4, 2>(ab, sAt + lw * 16 * 72, 72, sBt, 72);
        mma_lds<1, 4, 2>(ak, sAt + lw * 16 * 72, 72, sKt, 72);
#pragma unroll
        for (int n = 0; n < 4; ++n) {
            const int s0 = n * 16 + fq * 4;
            f32x4 m1, m2;
#pragma unroll
            for (int x = 0; x < 4; ++x) { const bool keep = (s0 + x) < tr; m1[x] = keep ? ab[0][n][x] : 0.f; m2[x] = keep ? ak[0][n][x] : 0.f; }
            *(f32x4*)(sAab + tr * 64 + s0) = m1;
            st_bf4(sAak + tr * 72 + s0, m2);
        }
    }
    __syncthreads();
    {
        f32x4 pp[1][4]; accz(pp);
        mma_lds<1, 4, 2>(pp, sAak + lw * 16 * 72, 72, sVT, 72);
#pragma unroll
        for (int n = 0; n < 4; ++n) *(f32x4*)(sP + tr * 64 + n * 16 + fq * 4) = pp[0][n];
    }
    __syncthreads();
    f32x4 xs[2][4];
    {
        const int ct0 = lw * 2;
#pragma unroll
        for (int u = 0; u < 2; ++u) {
            const int ct = ct0 + u;
#pragma unroll
            for (int i = 0; i < 4; ++i)
#pragma unroll
                for (int x = 0; x < 4; ++x) {
                    const int r = 16 * i + 4 * fq + x;
                    xs[u][i][x] = (lw < 2) ? bf2f(sAt[r * 72 + 16 * ct + fr]) : sP[r * 64 + 16 * (ct - 4) + fr];
                }
        }
    }
    float tcol[16];
    if (lw == 0) {
        const int tb = fq, tc = fr;
#pragma unroll
        for (int r = 0; r < 16; ++r) {
            float a = (r == tc) ? 1.f : 0.f;
            const float* arow = sAab + (16 * tb + r) * 64 + 16 * tb;
#pragma unroll
            for (int sI = 0; sI < r; ++sI) a += arow[sI] * tcol[sI];
            tcol[r] = a;
        }
    }
    __syncthreads();
    next_issue(p, nkind, npair, pre);
    float* sT = sP;
    if (lw == 0) {
#pragma unroll
        for (int r = 0; r < 16; ++r) sT[(16 * fq + r) * 16 + fr] = tcol[r];
    }
    __syncthreads();
#pragma unroll
    for (int i = 0; i < 4; ++i) {
#pragma unroll
        for (int j = 0; j < 4; ++j) {
            if (j < i) {
                const f32x4 af = *(const f32x4*)(sAab + (16 * i + fr) * 64 + 16 * j + 4 * fq);
#pragma unroll
                for (int ks = 0; ks < 4; ++ks)
#pragma unroll
                    for (int u = 0; u < 2; ++u) xs[u][i] = __builtin_amdgcn_mfma_f32_16x16x4f32(af[ks], xs[u][j][ks], xs[u][i], 0, 0, 0);
            }
        }
        const f32x4 tf = *(const f32x4*)(sT + (16 * i + fr) * 16 + 4 * fq);
        f32x4 xo[2];
#pragma unroll
        for (int u = 0; u < 2; ++u) xo[u] = (f32x4){0.f, 0.f, 0.f, 0.f};
#pragma unroll
        for (int ks = 0; ks < 4; ++ks)
#pragma unroll
            for (int u = 0; u < 2; ++u) xo[u] = __builtin_amdgcn_mfma_f32_16x16x4f32(tf[ks], xs[u][i][ks], xo[u], 0, 0, 0);
#pragma unroll
        for (int u = 0; u < 2; ++u) xs[u][i] = xo[u];
    }
    {
        const int ct0 = lw * 2;
#pragma unroll
        for (int u = 0; u < 2; ++u) {
            const int col = 16 * ((ct0 + u) & 3) + fr;
            bf16_t* srow = (lw < 2 ? sX1T : sUT) + col * 72;
            bf16_t* gdst = (lw < 2 ? aA : aW) + (size_t)t0 * 512 + cb + col;
#pragma unroll
            for (int i = 0; i < 4; ++i) {
                const unsigned p0 = pack2(xs[u][i][0], xs[u][i][1]), p1 = pack2(xs[u][i][2], xs[u][i][3]);
                const int tr0 = 16 * i + 4 * fq;
                *(u32x2*)(srow + tr0) = (u32x2){p0, p1};
                gdst[(size_t)tr0 * 512] = (bf16_t)(p0 & 0xffffu); gdst[(size_t)(tr0 + 1) * 512] = (bf16_t)(p0 >> 16);
                gdst[(size_t)(tr0 + 2) * 512] = (bf16_t)(p1 & 0xffffu); gdst[(size_t)(tr0 + 3) * 512] = (bf16_t)(p1 >> 16);
            }
        }
    }
    __syncthreads();
    {
        float* Mg = (float*)(p.ws + WS_PRW) + (size_t)unit * 4096; float* Ng = (float*)(p.ws + WS_XB) + (size_t)unit * 4096;
        f32x4 am[1][4]; accz(am);
        mma_lds<1, 4, 2>(am, sBtT + lw * 16 * 72, 72, sX1T, 72);
        const float wcj = sWC[tr];
#pragma unroll
        for (int n = 0; n < 4; ++n) {
            const int j0 = n * 16 + fq * 4;
            f32x4 o;
#pragma unroll
            for (int xx = 0; xx < 4; ++xx) {
                const float mv = am[0][n][xx] * wcj;
                if ((j0 + xx) == tr) { Mg[2048 + tr] = mv + wcj; o[xx] = 0.f; } else o[xx] = mv;
            }
            st_bf4((bf16_t*)Mg + tr * 64 + j0, o);
        }
        f32x4 an[1][4]; accz(an);
        mma_lds<1, 4, 2>(an, sUT + lw * 16 * 72, 72, sBtT, 72);
        mma_lds<1, 4, 2>(an, sVT + lw * 16 * 72, 72, sKtT, 72);
#pragma unroll
        for (int n = 0; n < 4; ++n) {
            const int j0 = n * 16 + fq * 4;
            const f32x4 w4 = *(const f32x4*)(sWC + j0);
            *(f32x4*)(Ng + tr * 64 + j0) = an[0][n] * w4;
        }
    }
}
DEVI void rwkv_r2(const Params& p, unsigned char* smem, int grp) {
    const int tid = tidx(), lane = tid & 63, jb = tid >> 6, q = lane >> 4, cl = lane & 15;
    const int bh = grp >> 2, ib = grp & 3;
    f32x4* zb = (f32x4*)smem;
    if (jb >= 4) {
        bf16_t* Zs = (bf16_t*)((float*)(p.ws + WS_XB) + (size_t)bh * 64 * 4096) + (ib * 16 + cl) * 64 + (jb - 4) * 16 + 4 * q;
        for (int c = 0; c < 64; ++c) {
            __builtin_amdgcn_s_barrier(); asm volatile("" ::: "memory");
            const f32x4 v = zb[((c & 1) * 4 + (jb - 4)) * 64 + lane];
            u32x2 o; o[0] = pack2(v[0], v[1]); o[1] = pack2(v[2], v[3]);
            *(u32x2*)(Zs + (size_t)c * 8192) = o;
            asm volatile("s_waitcnt lgkmcnt(0)" ::: "memory");
        }
        return;
    }
    const float* Mu = (const float*)(p.ws + WS_PRW) + (size_t)bh * 64 * 4096;
    const bf16_t* Mb = (const bf16_t*)Mu + (jb * 16 + cl) * 64 + 4 * q;
    const float* Db = Mu + 2048 + jb * 16 + cl;
    const bool ondiag = ((cl >> 2) == q);
    float* Nb = (float*)(p.ws + WS_XB) + (size_t)bh * 64 * 4096 + (ib * 16 + cl) * 64 + jb * 16 + 4 * q;
    f32x4 z[4];
#pragma unroll
    for (int kb = 0; kb < 4; ++kb) z[kb] = (f32x4){0.f, 0.f, 0.f, 0.f};
    u32x2 mq[8][4]; float dq[8]; f32x4 nq[8];
#pragma unroll
    for (int i = 0; i < 8; ++i) {
#pragma unroll
        for (int kb = 0; kb < 4; ++kb) mq[i][kb] = *(const u32x2*)(Mb + (size_t)i * 8192 + kb * 16);
        dq[i] = Db[(size_t)i * 4096];
        nq[i] = *(const f32x4*)(Nb + (size_t)i * 4096);
    }
#define R2_STEP(I, C) do { \
        f32x4 acc = nq[I], acc2 = (f32x4){0.f, 0.f, 0.f, 0.f}; f32x4 mf[4]; \
        _Pragma("unroll") for (int kb = 0; kb < 4; ++kb) { mf[kb][0] = __uint_as_float(mq[I][kb][0] << 16); mf[kb][1] = __uint_as_float(mq[I][kb][0] & 0xffff0000u); mf[kb][2] = __uint_as_float(mq[I][kb][1] << 16); mf[kb][3] = __uint_as_float(mq[I][kb][1] & 0xffff0000u); } \
        if (ondiag) { _Pragma("unroll") for (int kb = 0; kb < 4; ++kb) _Pragma("unroll") for (int ks = 0; ks < 4; ++ks) if (kb == jb && ks == (cl & 3)) mf[kb][ks] = dq[I]; } \
        _Pragma("unroll") for (int ks = 0; ks < 4; ++ks) { \
            acc = __builtin_amdgcn_mfma_f32_16x16x4f32(mf[0][ks], z[0][ks], acc, 0, 0, 0); acc2 = __builtin_amdgcn_mfma_f32_16x16x4f32(mf[1][ks], z[1][ks], acc2, 0, 0, 0); \
            acc = __builtin_amdgcn_mfma_f32_16x16x4f32(mf[2][ks], z[2][ks], acc, 0, 0, 0); acc2 = __builtin_amdgcn_mfma_f32_16x16x4f32(mf[3][ks], z[3][ks], acc2, 0, 0, 0); } \
        acc += acc2; \
        const int cn = (C) + 8 < 64 ? (C) + 8 : 63; \
        _Pragma("unroll") for (int kb = 0; kb < 4; ++kb) mq[I][kb] = *(const u32x2*)(Mb + (size_t)cn * 8192 + kb * 16); \
        dq[I] = Db[(size_t)cn * 4096]; \
        nq[I] = *(const f32x4*)(Nb + (size_t)cn * 4096); \
        zb[(((C) & 1) * 4 + jb) * 64 + lane] = acc; \
        asm volatile("s_waitcnt lgkmcnt(0)" ::: "memory"); __builtin_amdgcn_s_barrier(); asm volatile("" ::: "memory");     \
        _Pragma("unroll") for (int kb = 0; kb < 4; ++kb) z[kb] = zb[(((C) & 1) * 4 + kb) * 64 + lane]; \
    } while (0)
    for (int c = 0; c < 64; c += 8) { R2_STEP(0, c); R2_STEP(1, c + 1); R2_STEP(2, c + 2); R2_STEP(3, c + 3); R2_STEP(4, c + 4); R2_STEP(5, c + 5); R2_STEP(6, c + 6); R2_STEP(7, c + 7); }
#undef R2_STEP
}
constexpr int R3_LDS = 6 * 64 * 72 * 2;
DEVI void rwkv_r3(const Params& p, unsigned char* smem, int unit0) {
    const int tid = tidx(), hb = tid >> 8, lt = tid & 255, lw = lt >> 6, lane = tid & 63, fr = lane & 15, fq = lane >> 4;
    const int unit = unit0 + hb;
    const int c = unit & 63, bh = unit >> 6, h = bh & 7, b = bh >> 3, t0 = b * SEQ + c * 64, cb = h * 64;
    const bf16_t* aR = prep_arr(p, 0); const bf16_t* aK = prep_arr(p, 1); const bf16_t* aV = prep_arr(p, 2); const bf16_t* aU = prep_arr(p, 3);
    const bf16_t* aB = prep_arr(p, 4); const bf16_t* aX = prep_arr(p, 5); const bf16_t* aG = prep_arr(p, 6);
    bf16_t* sRt = (bf16_t*)(smem + hb * R3_LDS); bf16_t* sKt = sRt + 64 * 72; bf16_t* sVT = sKt + 64 * 72; bf16_t* sBt = sVT + 64 * 72; bf16_t* sX1 = sBt + 64 * 72; bf16_t* sZ0 = sX1 + 64 * 72;
    bf16_t* sUT = sBt; bf16_t* sArb = sX1; bf16_t* sArk = sZ0;
    float* sY = (float*)sBt;
    __syncthreads();
#pragma unroll
    for (int i = 0; i < 2; ++i) {
        const int idx = lt + 256 * i, t = idx >> 3, ch = idx & 7; const size_t o = (size_t)(t0 + t) * 512 + cb + ch * 8; const int lo = t * 72 + ch * 8;
        *(u32x4*)(sRt + lo) = *(const u32x4*)(aR + o);
        *(u32x4*)(sBt + lo) = *(const u32x4*)(aB + o);
        *(u32x4*)(sKt + lo) = *(const u32x4*)(aK + o);
        *(u32x4*)(sX1 + lo) = *(const u32x4*)(aX + o);
        const u32x4 vv = *(const u32x4*)(aV + o);
#pragma unroll
        for (int k = 0; k < 8; ++k) {
            const int j = (k + ch) & 7; const unsigned w = (j & 2) ? ((j & 4) ? vv[3] : vv[1]) : ((j & 4) ? vv[2] : vv[0]);
            sVT[(ch * 8 + j) * 72 + t] = (bf16_t)((j & 1) ? (w >> 16) : (w & 0xffffu));
        }
        u32x4 zz = (u32x4){0u, 0u, 0u, 0u};
        if (c > 0) zz = *(const u32x4*)((const bf16_t*)((const float*)(p.ws + WS_XB) + (size_t)(unit - 1) * 4096) + t * 64 + ch * 8);
        *(u32x4*)(sZ0 + lo) = zz;
    }
    __syncthreads();
    const int tr = lw * 16 + fr;
    f32x4 ay[1][4], au[1][4], a1[1][4], a2[1][4]; accz(ay); accz(au); accz(a1); accz(a2);
    mma_lds<1, 4, 2>(au, sX1 + lw * 16 * 72, 72, sZ0, 72);
    mma_lds<1, 4, 2>(a1, sRt + lw * 16 * 72, 72, sBt, 72);
    mma_lds<1, 4, 2>(a2, sRt + lw * 16 * 72, 72, sKt, 72);
    mma_lds<1, 4, 2>(ay, sRt + lw * 16 * 72, 72, sZ0, 72);
    __syncthreads();
    u32x2 ulr[4];
#pragma unroll
    for (int n = 0; n < 4; ++n) ulr[n] = *(const u32x2*)(aU + (size_t)(t0 + tr) * 512 + cb + n * 16 + fq * 4);
#pragma unroll
    for (int n = 0; n < 4; ++n) {
        const int i0 = n * 16 + fq * 4;
        f32x4 ul; ul[0] = __uint_as_float(ulr[n][0] << 16); ul[1] = __uint_as_float(ulr[n][0] & 0xffff0000u); ul[2] = __uint_as_float(ulr[n][1] << 16); ul[3] = __uint_as_float(ulr[n][1] & 0xffff0000u);
#pragma unroll
        for (int x = 0; x < 4; ++x) sUT[(i0 + x) * 72 + tr] = f2bf(au[0][n][x] + ul[x]);
        f32x4 m1, m2;
#pragma unroll
        for (int x = 0; x < 4; ++x) { const bool keep = (i0 + x) <= tr; m1[x] = keep ? a1[0][n][x] : 0.f; m2[x] = keep ? a2[0][n][x] : 0.f; }
        st_bf4(sArb + tr * 72 + i0, m1); st_bf4(sArk + tr * 72 + i0, m2);
    }
    __syncthreads();
    mma_lds<1, 4, 2>(ay, sArb + lw * 16 * 72, 72, sUT, 72);
    mma_lds<1, 4, 2>(ay, sArk + lw * 16 * 72, 72, sVT, 72);
    __syncthreads();
#pragma unroll
    for (int n = 0; n < 4; ++n) *(f32x4*)(sY + tr * 68 + n * 16 + fq * 4) = ay[0][n];
    __syncthreads();
    {
        const int te = lt >> 2, i0 = (lt & 3) * 16;
        float s = 0.f, bon = 0.f;
        f32x4 y4[4];
        const float* rk = p.in[11] + cb + i0;
#pragma unroll
        for (int k = 0; k < 4; ++k) { y4[k] = *(const f32x4*)(sY + te * 68 + i0 + k * 4); s += y4[k][0] + y4[k][1] + y4[k][2] + y4[k][3]; }
#pragma unroll
        for (int k = 0; k < 16; ++k) bon += bf2f(sRt[te * 72 + i0 + k]) * bf2f(sKt[te * 72 + i0 + k]) * rk[k];
        s += __shfl_xor(s, 1, 64); s += __shfl_xor(s, 2, 64);
        bon += __shfl_xor(bon, 1, 64); bon += __shfl_xor(bon, 2, 64);
        const float mean = s * (1.f / 64.f);
        float s2 = 0.f;
#pragma unroll
        for (int k = 0; k < 16; ++k) { const float d = y4[k >> 2][k & 3] - mean; s2 += d * d; }
        s2 += __shfl_xor(s2, 1, 64); s2 += __shfl_xor(s2, 2, 64);
        const float rstd = rsqrtf(s2 * (1.f / 64.f) + GN_EPS);
        const size_t o = (size_t)(t0 + te) * 512 + cb + i0;
        const float* gw = p.in[12] + cb + i0; const float* gb = p.in[13] + cb + i0;
#pragma unroll
        for (int hh = 0; hh < 2; ++hh) {
            const u32x4 gg = *(const u32x4*)(aG + o + hh * 8);
            float r[8];
#pragma unroll
            for (int k = 0; k < 8; ++k) {
                const int kk = hh * 8 + k;
                const float g = (k & 1) ? __uint_as_float(gg[k >> 1] & 0xffff0000u) : __uint_as_float(gg[k >> 1] << 16);
                const float v = bf2f(sVT[(i0 + kk) * 72 + te]);
                r[k] = ((y4[kk >> 2][kk & 3] - mean) * rstd * gw[kk] + gb[kk] + bon * v) * g;
            }
            u32x4 ov; ov[0] = pack2(r[0], r[1]); ov[1] = pack2(r[2], r[3]); ov[2] = pack2(r[4], r[5]); ov[3] = pack2(r[6], r[7]);
            *(u32x4*)((bf16_t*)(p.ws + WS_YAB) + (size_t)(t0 + te) * 1024 + cb + i0 + hh * 8) = ov;
        }
    }
}

DEVI void phase_scans_naive(const Params& p, unsigned char* smem) {
    if (blockIdx.x < 4) scan_rwkv_naive(p, smem, blockIdx.x);
    else if (blockIdx.x < 8) scan_hgrn_naive(p, smem, blockIdx.x - 4);
}
DEVI void phase_3a(const Params& p, unsigned char* smem) {
    u32x4 pre[12];
    int u = blockIdx.x;
    if (u < 1536) { if (u < 1024) r1_issue(p, u, pre); else h1_issue(p, u - 1024, pre); }
    for (; u < 1536; u += gridDim.x) {
        const int un = u + gridDim.x, nkind = un < 1536 ? (un < 1024 ? 1 : 2) : 0, npair = un < 1024 ? un : un - 1024;
        if (u < 1024) rwkv_r1(p, smem, u, pre, nkind, npair); else hgrn_h1(p, smem, u - 1024, pre, nkind, npair);
    }
}
#define XB_TMO      128
#define XB_XCNT(j)  (256  + 64 * (j))
#define XB_XSUB(j)  (1280 + 64 * (j))
#define XB_XGEN(j)  (2304 + 64 * (j))
#define XB_TOP      3328
#define XB_TOPGEN   3392
#define XCD_BAR_WORDS 3456
#define XB_SPIN_CAP (1u << 22)
#define LAS __attribute__((address_space(3)))
DEVI unsigned xb_ld(unsigned* p) { return __hip_atomic_load(p, __ATOMIC_RELAXED, __HIP_MEMORY_SCOPE_AGENT); }
DEVI unsigned xb_add(unsigned* p, unsigned v) { return __hip_atomic_fetch_add(p, v, __ATOMIC_RELAXED, __HIP_MEMORY_SCOPE_AGENT); }
DEVI unsigned xb_xcc_id() { return (unsigned)__builtin_amdgcn_s_getreg((3 << 11) | 20) & 0xFu; }
#define XB_SPIN(cond, bar) do { unsigned _sp = 0; while (cond) { __builtin_amdgcn_s_sleep(1); \
    if ((++_sp & 255u) == 0u) { if (xb_ld(&(bar)[XB_TMO])) break; if (_sp > XB_SPIN_CAP) { atomicAdd(&(bar)[XB_TMO], 1u); break; } } } } while (0)
struct XcdBarrier { unsigned* bar; unsigned x; volatile LAS unsigned* st; };
DEVI XcdBarrier xcd_barrier_post(unsigned* bar, volatile LAS unsigned* st) {
    XcdBarrier b; b.bar = bar; b.x = xb_xcc_id(); b.st = st;
    if (tidx() == 0) (void)xb_add(&bar[XB_XCNT(b.x)], 1u);
    return b;
}
DEVI void xcd_barrier_complete(unsigned* bar, unsigned x, unsigned& nloc, unsigned& nx) {
    const unsigned G = gridDim.x * gridDim.y * gridDim.z;
    unsigned sum, cnt, mine, sp = 0u;
    for (;;) {
        sum = 0u; cnt = 0u; mine = 0u;
#pragma unroll
        for (unsigned j = 0; j < 16; ++j) { const unsigned c = xb_ld(&bar[XB_XCNT(j)]); sum += c; cnt += (c > 0u) ? 1u : 0u; mine = (j == x) ? c : mine; }
        if (sum == G) break;
        __builtin_amdgcn_s_sleep(1);
        if ((++sp & 255u) == 0u) { if (xb_ld(&bar[XB_TMO])) break; if (sp > XB_SPIN_CAP) { atomicAdd(&bar[XB_TMO], 1u); break; } }
    }
    nloc = mine > 0u ? mine : 1u; nx = cnt > 0u ? cnt : 1u;
}
DEVI void xcd_barrier(const XcdBarrier& b) {
    asm volatile("s_waitcnt vmcnt(0)" ::: "memory");
    __syncthreads();
    if (tidx() == 0) {
        unsigned* bar = b.bar;
        __builtin_amdgcn_s_waitcnt(0);
        unsigned nloc = b.st[0], nx = b.st[1];
        if (nloc == 0u) { xcd_barrier_complete(bar, b.x, nloc, nx); b.st[0] = nloc; b.st[1] = nx; }
        const unsigned old = xb_add(&bar[XB_XSUB(b.x)], 1u);
        const unsigned gen = old / nloc;
        if (old + 1u == (gen + 1u) * nloc) {
            __builtin_amdgcn_fence(__ATOMIC_RELEASE, "agent");
            asm volatile("s_waitcnt vmcnt(0)" ::: "memory");
            const unsigned og = xb_add(&bar[XB_TOP], 1u);
            const unsigned tg = og / nx;
            if (og + 1u == (tg + 1u) * nx) xb_add(&bar[XB_TOPGEN], 1u);
            else XB_SPIN(xb_ld(&bar[XB_TOPGEN]) == tg, bar);
            __builtin_amdgcn_fence(__ATOMIC_ACQUIRE, "agent");
            xb_add(&bar[XB_XGEN(b.x)], 1u);
            asm volatile("s_waitcnt vmcnt(0)" ::: "memory");
        } else {
            XB_SPIN(xb_ld(&bar[XB_XGEN(b.x)]) == gen, bar);
            __builtin_amdgcn_fence(__ATOMIC_ACQUIRE, "agent");
            asm volatile("s_waitcnt vmcnt(0)" ::: "memory");
        }
    }
    __syncthreads();
}

DEVI unsigned* h2_counter(const Params& p, int bh) { return (unsigned*)(p.ws + WS_BAR) + XCD_BAR_WORDS + bh * 16; }
DEVI int h3b_count() { return blockIdx.x < 128 ? 1 : 7; }
DEVI int h3b_chunk(int i) { return blockIdx.x < 128 ? 56 + (blockIdx.x & 7) : (blockIdx.x & 7) + 8 * i; }
DEVI void phase_3b(const Params& p, unsigned char* smem) {
    const int bh = (blockIdx.x & 127) >> 3;
    unsigned* bar = (unsigned*)(p.ws + WS_BAR); unsigned* ctr = h2_counter(p, bh);
    if (blockIdx.x < 128) { const int x = blockIdx.x & 7, k = blockIdx.x >> 3; rwkv_r2(p, smem, ((x + 8 * (k >> 2)) << 2) | (k & 3)); }
    else hgrn_h2(p, smem, blockIdx.x - 128);
    const int n = h3b_count();
    if (n == 0) return;
    asm volatile("s_waitcnt vmcnt(0)" ::: "memory");
    __syncthreads();
    if (tidx() == 0) {
        if (blockIdx.x >= 128) (void)xb_add(ctr, 1u);
        XB_SPIN(xb_ld(ctr) < 8u, bar);
        __builtin_amdgcn_fence(__ATOMIC_ACQUIRE, "agent");
        asm volatile("s_waitcnt vmcnt(0)" ::: "memory");
    }
    __syncthreads();
    u32x4 pre[10];
    h3_issue(p, bh * 64 + h3b_chunk(0), pre);
    for (int i = 0; i < n; ++i) hgrn_h3(p, smem, bh * 64 + h3b_chunk(i), pre, i + 1 < n ? bh * 64 + h3b_chunk(i + 1) : -1, (bf16_t*)(p.ws + WS_PHG) + H_I, NHG);
}
DEVI void phase_3c(const Params& p, unsigned char* smem) {
    {
        const int bh = (blockIdx.x & 127) >> 3, h = bh & 3, b = bh >> 2, tid = tidx(), n = h3b_count();
        const bf16_t* phg = (const bf16_t*)(p.ws + WS_PHG); bf16_t* yab = (bf16_t*)(p.ws + WS_YAB);
        for (int i0 = 0; i0 < n; i0 += 2) {
            u32x4 v[2][2];
#pragma unroll
            for (int i = 0; i < 2; ++i)
#pragma unroll
                for (int q = 0; q < 2; ++q) { const int idx = tid + 512 * q, ii = i0 + i < n ? i0 + i : i0, t = b * SEQ + h3b_chunk(ii) * 64 + (idx >> 4); v[i][q] = *(const u32x4*)(phg + (size_t)t * NHG + H_I + h * 128 + (idx & 15) * 8); }
#pragma unroll
            for (int i = 0; i < 2; ++i)
#pragma unroll
                for (int q = 0; q < 2; ++q) { const int idx = tid + 512 * q, ii = i0 + i < n ? i0 + i : i0, t = b * SEQ + h3b_chunk(ii) * 64 + (idx >> 4); *(u32x4*)(yab + (size_t)t * 1024 + 512 + h * 128 + (idx & 15) * 8) = v[i][q]; }
        }
    }
    for (int u = blockIdx.x; u < 1024; u += gridDim.x) rwkv_r3(p, smem, u * 2);
}

struct EpiMerge {
    static constexpr bool PERM = true, MID = true; const bf16_t* pgt; bf16_t* merged;
    DEVI void mid(f32x4 (&acc)[2][2][4][2], const PUnit& u, int wr, int wc, int fr, int fq) const {
        unsigned off0 = ((unsigned)(u.pm * 256 + wr * 64 + fr) * NHG + u.pn * 256 + wc * 32 + 8 * fq) * 2u;
        asm volatile("" : "+v"(off0));
#pragma unroll
        for (int ai = 0; ai < 2; ++ai)
#pragma unroll
            for (int bj = 0; bj < 2; ++bj)
#pragma unroll
                for (int mh = 0; mh < 2; ++mh) {
                    u32x4 ga[2], gb[2];
#pragma unroll
                    for (int mm = 0; mm < 2; ++mm) { const char* gp = (const char*)pgt + (off0 + (unsigned)(((ai * 128 + (mh * 2 + mm) * 16) * NHG + bj * 128) * 2)); ga[mm] = *(const u32x4*)gp; gb[mm] = *(const u32x4*)(gp + 2048); }
#pragma unroll
                    for (int mm = 0; mm < 2; ++mm)
#pragma unroll
                        for (int w = 0; w < 4; ++w) {
                            const float a0 = __uint_as_float(ga[mm][w] << 16), a1 = __uint_as_float(ga[mm][w] & 0xffff0000u);
                            const float b0 = fmaxf(__uint_as_float(gb[mm][w] << 16), -60.f), b1 = fmaxf(__uint_as_float(gb[mm][w] & 0xffff0000u), -60.f);
                            acc[ai][bj][mh * 2 + mm][w >> 1][(w & 1) * 2] *= sigm(a0) * (1.f + __expf(-b0));
                            acc[ai][bj][mh * 2 + mm][w >> 1][(w & 1) * 2 + 1] *= sigm(a1) * (1.f + __expf(-b1));
                        }
                    asm volatile("" ::: "memory");
                }
    }
    DEVI void operator()(const f32x4 (&acc)[2][2][4][2], const PUnit& u, int wr, int wc, int fr, int fq) const {
        const int row0 = u.pm * 256 + wr * 64 + fr, col0 = u.pn * 256 + wc * 32 + 8 * fq;
#pragma unroll
        for (int ai = 0; ai < 2; ++ai)
#pragma unroll
            for (int bj = 0; bj < 2; ++bj) {
                u32x4 gb[4];
#pragma unroll
                for (int m = 0; m < 4; ++m) gb[m] = *(const u32x4*)(pgt + (size_t)(row0 + ai * 128 + m * 16) * NHG + 1024 + col0 + bj * 128);
#pragma unroll
                for (int m = 0; m < 4; ++m) {
                    f32x4 o[2];
#pragma unroll
                    for (int w = 0; w < 4; ++w) {
                        const float b0 = fmaxf(__uint_as_float(gb[m][w] << 16), -60.f), b1 = fmaxf(__uint_as_float(gb[m][w] & 0xffff0000u), -60.f);
                        o[w >> 1][(w & 1) * 2] = acc[ai][bj][m][w >> 1][(w & 1) * 2] * sigm(b0);
                        o[w >> 1][(w & 1) * 2 + 1] = acc[ai][bj][m][w >> 1][(w & 1) * 2 + 1] * sigm(b1);
                    }
                    *(u32x4*)(merged + (size_t)(row0 + ai * 128 + m * 16) * 1024 + col0 + bj * 128) = pk8(o[0], o[1]);
                }
            }
    }
};
DEVI void phase_merge(const Params& p, unsigned char* smem) {
    TileOrder S; S.init((const bf16_t*)(p.ws + WS_YAB), 1024, (const bf16_t*)(p.ws + WS_WCAT), 1024, NTOK, 1024);
    pgemm((PG_LAS unsigned char*)smem, 1024, 1024, S, EpiMerge{(const bf16_t*)(p.ws + WS_PGT), (bf16_t*)(p.ws + WS_MERGED)});
}

struct EpiWo {
    static constexpr bool PERM = false, MID = false; const float* x; float* x1pre;
    DEVI void operator()(const f32x4 (&acc)[2][2][4][2], const PUnit& u, int wr, int wc, int fr, int fq) const {
        const int row0 = u.pm * 256 + wr * 64 + fr, col0 = u.pn * 256 + wc * 32 + 4 * fq;
#pragma unroll
        for (int ai = 0; ai < 2; ++ai)
#pragma unroll
            for (int mh = 0; mh < 2; ++mh) {
                f32x4 xv[2][2][2];
#pragma unroll
                for (int mm = 0; mm < 2; ++mm)
#pragma unroll
                    for (int bj = 0; bj < 2; ++bj)
#pragma unroll
                        for (int n = 0; n < 2; ++n) xv[mm][bj][n] = *(const f32x4*)(x + (size_t)(row0 + ai * 128 + (mh * 2 + mm) * 16) * 1024 + col0 + bj * 128 + n * 16);
#pragma unroll
                for (int mm = 0; mm < 2; ++mm)
#pragma unroll
                    for (int bj = 0; bj < 2; ++bj)
#pragma unroll
                        for (int n = 0; n < 2; ++n) {
                            const size_t o = (size_t)(row0 + ai * 128 + (mh * 2 + mm) * 16) * 1024 + col0 + bj * 128 + n * 16;
                            *(f32x4*)(x1pre + o) = xv[mm][bj][n] * ALPHA + acc[ai][bj][mh * 2 + mm][n];
                        }
            }
    }
};
DEVI void phase_wo(const Params& p, unsigned char* smem) {
    {
        TileOrder S; S.init((const bf16_t*)(p.ws + WS_MERGED), 1024, (const bf16_t*)(p.ws + WS_WOT), 1024, NTOK, 1024);
        pgemm((PG_LAS unsigned char*)smem, 1024, 1024, S, EpiWo{p.in[0], p.out});
    }
    constexpr int T_W = 1024;
    struct Job { const float* src; bf16_t* dst; int C, dld, kb, nb, w13; };
    auto job = [&](int t) {
        Job j; const int which = t / T_W, u = t - which * T_W, e = u >> 5, tt = u & 31;
        if (which < 2) { j.kb = tt >> 1; j.nb = tt & 1; j.C = 512; j.dld = 1024; j.w13 = 1;
            j.src = p.in[25 + which] + (size_t)e * 1024 * 512; j.dst = (bf16_t*)(p.ws + WS_W1T) + (size_t)e * 1024 * 1024 + (size_t)which * 128 * 1024; }
        else { j.kb = tt >> 2; j.nb = tt & 3; j.C = 1024; j.dld = 512; j.w13 = 0;
            j.src = p.in[27] + (size_t)e * 512 * 1024; j.dst = (bf16_t*)(p.ws + WS_W2T) + (size_t)e * 1024 * 512; }
        return j;
    };
    auto wload = [&](f32x4 (&v)[8], const Job& j) {
        const int tid = tidx();
#pragma unroll
        for (int i = 0; i < 8; ++i) v[i] = __builtin_nontemporal_load((const f32x4*)(j.src + (size_t)(j.kb * 64 + (tid >> 6) + 8 * i) * j.C + j.nb * 256 + (tid & 63) * 4));
    };
    auto wfinish = [&](const f32x4 (&v)[8], const Job& j) {
        float* sm = (float*)smem; const int tid = tidx();
        asm volatile("s_waitcnt lgkmcnt(0)" ::: "memory"); __builtin_amdgcn_s_barrier(); asm volatile("" ::: "memory");
#pragma unroll
        for (int i = 0; i < 8; ++i) *(f32x4*)(sm + ((tid >> 6) + 8 * i) * 260 + (tid & 63) * 4) = v[i];
        asm volatile("s_waitcnt lgkmcnt(0)" ::: "memory"); __builtin_amdgcn_s_barrier(); asm volatile("" ::: "memory");
        const int n = tid >> 1, k32 = (tid & 1) * 32, ng = j.nb * 256 + n;
        const int drow = j.w13 ? ((ng >> 7) * 256 + (ng & 127)) : ng;
#pragma unroll
        for (int q = 0; q < 4; ++q) {
            float w[8];
#pragma unroll
            for (int k = 0; k < 8; ++k) w[k] = sm[(k32 + q * 8 + k) * 260 + n];
            u32x4 o; o[0] = pack2(w[0], w[1]); o[1] = pack2(w[2], w[3]); o[2] = pack2(w[4], w[5]); o[3] = pack2(w[6], w[7]);
            *(u32x4*)(j.dst + (size_t)drow * j.dld + j.kb * 64 + k32 + q * 8) = o;
        }
    };
    int t = blockIdx.x;
    if (t < 3 * T_W) {
        f32x4 va[8], vb[8];
        Job ja = job(t); wload(va, ja);
        for (;;) {
            const int tn = t + gridDim.x; const bool more = tn < 3 * T_W;
            Job jb = ja; if (more) { jb = job(tn); wload(vb, jb); }
            wfinish(va, ja);
            if (!more) break;
            t = tn + gridDim.x; const bool more2 = t < 3 * T_W;
            if (more2) { ja = job(t); wload(va, ja); }
            wfinish(vb, jb);
            if (!more2) break;
        }
    }
}

DEVI void phase_ln1_route(const Params& p, unsigned char* smem) {
    const float* x1pre = p.out; bf16_t* x1b = (bf16_t*)(p.ws + WS_X1B);
    const float* g = p.in[19]; const float* bta = p.in[20];
    const float* bg = p.in[22]; const float* be = p.in[24];
    int* cnt = (int*)(p.ws + WS_CNT); int* slot = (int*)(p.ws + WS_SLOT); float* tw = (float*)(p.ws + WS_TW); int* list = (int*)(p.ws + WS_LIST);
    constexpr int XLD = 1028;
    float* sX = (float*)smem;
    f32x4* sPart = (f32x4*)(smem + 65792);
    f32x4* sLog = (f32x4*)(smem + 65792 + 24576);
    int* sLcnt = (int*)(smem + 65792 + 24576 + 9216); int* sLbase = sLcnt + 32; int* sTok = sLbase + 32;
    for (int blk = blockIdx.x; blk < NTOK / 64; blk += gridDim.x) {
        int tid = tidx();
        const int lane = tid & 63, wid = tid >> 6, jt = lane >> 3, cg = lane & 7, fc = lane & 15, fg = lane >> 4;
        bf16x8 Wf[3][4][2];
#pragma unroll
        for (int t = 0; t < 3; ++t)
#pragma unroll
            for (int ks = 0; ks < 4; ++ks)
#pragma unroll
                for (int hl = 0; hl < 2; ++hl) Wf[t][ks][hl] = ((const bf16x8*)(p.ws + WS_WR))[((((wid * 3 + t) * 4 + ks) * 2 + hl) * 64 + lane)];
        __syncthreads();
        if (tid < 32) sLcnt[tid] = 0;
        f32x4 xn[2][4];
#pragma unroll
        for (int j = 0; j < 2; ++j)
#pragma unroll
            for (int i = 0; i < 4; ++i) xn[j][i] = __builtin_nontemporal_load((const f32x4*)(x1pre + (size_t)(blk * 64 + wid * 2 + j) * 1024 + i * 256 + lane * 4));
#pragma unroll 1
        for (int g16 = 0; g16 < 4; ++g16) {
            f32x4 xv[2][4]; float s[2];
#pragma unroll
            for (int j = 0; j < 2; ++j) {
                s[j] = 0.f;
#pragma unroll
                for (int i = 0; i < 4; ++i) { xv[j][i] = xn[j][i]; s[j] += xv[j][i][0] + xv[j][i][1] + xv[j][i][2] + xv[j][i][3]; }
            }
            if (g16 < 3) {
#pragma unroll
                for (int j = 0; j < 2; ++j)
#pragma unroll
                    for (int i = 0; i < 4; ++i) xn[j][i] = __builtin_nontemporal_load((const f32x4*)(x1pre + (size_t)(blk * 64 + (g16 + 1) * 16 + wid * 2 + j) * 1024 + i * 256 + lane * 4));
            }
            float mean[2], rstd[2];
#pragma unroll
            for (int j = 0; j < 2; ++j) mean[j] = wave_sum(s[j]) * (1.f / 1024.f);
#pragma unroll
            for (int j = 0; j < 2; ++j) {
                float s2 = 0.f;
#pragma unroll
                for (int i = 0; i < 4; ++i)
#pragma unroll
                    for (int q = 0; q < 4; ++q) { const float d = xv[j][i][q] - mean[j]; s2 += d * d; }
                rstd[j] = s2;
            }
#pragma unroll
            for (int j = 0; j < 2; ++j) rstd[j] = rsqrtf(wave_sum(rstd[j]) * (1.f / 1024.f) + LN_EPS);
#pragma unroll
            for (int i = 0; i < 4; ++i) {
                const int col = i * 256 + lane * 4;
                const f32x4 g4 = *(const f32x4*)(g + col), b4 = *(const f32x4*)(bta + col);
#pragma unroll
                for (int j = 0; j < 2; ++j) {
#pragma unroll
                    for (int q = 0; q < 4; ++q) xv[j][i][q] = (xv[j][i][q] - mean[j]) * rstd[j] * g4[q] + b4[q];
                    *(f32x4*)(sX + (wid * 2 + j) * XLD + col) = xv[j][i];
                    st_bf4(x1b + (size_t)(blk * 64 + g16 * 16 + wid * 2 + j) * 1024 + col, xv[j][i]);
                }
            }
            asm volatile("s_waitcnt lgkmcnt(0)" ::: "memory"); __builtin_amdgcn_s_barrier(); asm volatile("" ::: "memory");
            f32x4 acc[3];
#pragma unroll
            for (int t = 0; t < 3; ++t) acc[t] = (f32x4){0.f, 0.f, 0.f, 0.f};
#pragma unroll
            for (int ks = 0; ks < 4; ++ks) {
                const float* xp = sX + fc * XLD + wid * 128 + ks * 32 + fg * 8;
                const f32x4 x0 = *(const f32x4*)xp, x1 = *(const f32x4*)(xp + 4);
                u32x4 h, l;
                h[0] = pack2(x0[0], x0[1]); h[1] = pack2(x0[2], x0[3]); h[2] = pack2(x1[0], x1[1]); h[3] = pack2(x1[2], x1[3]);
                l[0] = pack2(x0[0] - __uint_as_float(h[0] << 16), x0[1] - __uint_as_float(h[0] & 0xffff0000u)); l[1] = pack2(x0[2] - __uint_as_float(h[1] << 16), x0[3] - __uint_as_float(h[1] & 0xffff0000u));
                l[2] = pack2(x1[0] - __uint_as_float(h[2] << 16), x1[1] - __uint_as_float(h[2] & 0xffff0000u)); l[3] = pack2(x1[2] - __uint_as_float(h[3] << 16), x1[3] - __uint_as_float(h[3] & 0xffff0000u));
                const bf16x8 xh = __builtin_bit_cast(bf16x8, h), xl = __builtin_bit_cast(bf16x8, l);
#pragma unroll
                for (int t = 0; t < 3; ++t) {
                    acc[t] = __builtin_amdgcn_mfma_f32_16x16x32_bf16(Wf[t][ks][1], xh, acc[t], 0, 0, 0);
                    acc[t] = __builtin_amdgcn_mfma_f32_16x16x32_bf16(Wf[t][ks][0], xl, acc[t], 0, 0, 0);
                    acc[t] = __builtin_amdgcn_mfma_f32_16x16x32_bf16(Wf[t][ks][0], xh, acc[t], 0, 0, 0);
                }
            }
#pragma unroll
            for (int t = 0; t < 3; ++t) sPart[(wid * 16 + fc) * 12 + t * 4 + fg] = acc[t];
            asm volatile("s_waitcnt lgkmcnt(0)" ::: "memory"); __builtin_amdgcn_s_barrier(); asm volatile("" ::: "memory");
            if (tid < 144) {
                const int tok = tid / 9, u = tid - tok * 9;
                f32x4 sum = sPart[tok * 12 + u];
#pragma unroll
                for (int w = 1; w < 8; ++w) sum += sPart[(w * 16 + tok) * 12 + u];
                sLog[(g16 * 16 + tok) * 9 + u] = sum;
            }
        }
        __syncthreads();
        if (cg == 0) {
            float lg[36];
#pragma unroll
            for (int u = 0; u < 9; ++u) { const f32x4 t4 = sLog[(wid * 8 + jt) * 9 + u]; lg[u * 4] = t4[0]; lg[u * 4 + 1] = t4[1]; lg[u * 4 + 2] = t4[2]; lg[u * 4 + 3] = t4[3]; }
            float gl[4];
#pragma unroll
            for (int q = 0; q < 4; ++q) gl[q] = lg[q] + bg[q];
            int gs = 0; float gm = gl[0];
#pragma unroll
            for (int q = 1; q < 4; ++q) if (gl[q] > gm) { gm = gl[q]; gs = q; }
            float gden = 0.f;
#pragma unroll
            for (int q = 0; q < 4; ++q) gden += __expf(gl[q] - gm);
            const float pg = 1.f / gden;
            float el[8];
#pragma unroll
            for (int jj = 0; jj < 8; ++jj) {
                const float v0 = lg[4 + jj] + be[jj], v1 = lg[12 + jj] + be[8 + jj], v2 = lg[20 + jj] + be[16 + jj], v3 = lg[28 + jj] + be[24 + jj];
                el[jj] = gs == 0 ? v0 : (gs == 1 ? v1 : (gs == 2 ? v2 : v3));
            }
            int i1 = 0; float m1 = el[0];
#pragma unroll
            for (int jj = 1; jj < 8; ++jj) if (el[jj] > m1) { m1 = el[jj]; i1 = jj; }
            int i2 = -1; float m2 = -3.0e38f;
#pragma unroll
            for (int jj = 0; jj < 8; ++jj) if (jj != i1 && el[jj] > m2) { m2 = el[jj]; i2 = jj; }
            const float ex = __expf(m2 - m1);
            const float p1 = 1.f / (1.f + ex), p2 = ex / (1.f + ex);
            const int e1 = gs * 8 + i1, e2 = gs * 8 + i2;
            const int r1 = atomicAdd(sLcnt + e1, 1), r2 = atomicAdd(sLcnt + e2, 1);
            int* rec = sTok + (wid * 8 + jt) * 4;
            rec[0] = (e1 << 16) | r1; rec[1] = (e2 << 16) | r2; rec[2] = __float_as_int(pg * p1); rec[3] = __float_as_int(pg * p2);
        }
        __syncthreads();
        if (tid < 32) { const int n = sLcnt[tid]; sLbase[tid] = n ? atomicAdd(cnt + tid * CNT_STRIDE, n) : 0; }
        __syncthreads();
        if (tid < 64) {
            const int tk = blk * 64 + tid; const int* rec = sTok + tid * 4;
            const int e1 = rec[0] >> 16, e2 = rec[1] >> 16;
            const int pos1 = sLbase[e1] + (rec[0] & 0xffff), pos2 = sLbase[e2] + (rec[1] & 0xffff);
            list[(size_t)e1 * NTOK + pos1] = tk; list[(size_t)e2 * NTOK + pos2] = tk;
            slot[tk * 2] = (e1 << 16) | pos1; slot[tk * 2 + 1] = (e2 << 16) | pos2;
            tw[tk * 2] = __int_as_float(rec[2]); tw[tk * 2 + 1] = __int_as_float(rec[3]);
        }
    }
}

DEVI void moe_find(const int* cnt, int rti, int& e, int& rt, int& rowbase, int& nrows) {
    int rt0 = 0; rowbase = 0; e = 0;
    for (; e < NEXP - 1; ++e) { const int nt = (cnt[e * CNT_STRIDE] + 255) >> 8; if (rti < rt0 + nt) break; rt0 += nt; rowbase += nt * 256; }
    rt = rti - rt0; nrows = cnt[e * CNT_STRIDE] - rt * 256; nrows = nrows > 256 ? 256 : nrows;
    e = __builtin_amdgcn_readfirstlane(e); rt = __builtin_amdgcn_readfirstlane(rt); rowbase = __builtin_amdgcn_readfirstlane(rowbase); nrows = __builtin_amdgcn_readfirstlane(nrows);
}
DEVI int moe_total_rt(const int* cnt) { int s = 0; for (int e = 0; e < NEXP; ++e) s += (cnt[e * CNT_STRIDE] + 255) >> 8; return __builtin_amdgcn_readfirstlane(s); }
constexpr int MOE_TAB_MAX = 192;
constexpr int MOE_TAB_OFF = 131072 + 1024;
struct MoeTab { int e, rt, rowbase, nrows; };
DEVI const MoeTab* moe_build_table(const int* cnt, unsigned char* smem) {
    int* sCnt = (int*)(smem + 131072); MoeTab* tab = (MoeTab*)(smem + MOE_TAB_OFF);
    const int tid = tidx();
    __syncthreads();
    if (tid < NEXP) sCnt[tid] = cnt[tid * CNT_STRIDE];
    __syncthreads();
    if (tid <= MOE_TAB_MAX) {
        int e = 0, rt0 = 0, rowbase = 0, total = 0;
        for (int i = 0; i < NEXP; ++i) total += (sCnt[i] + 255) >> 8;
        if (tid == MOE_TAB_MAX) { tab[tid].e = total; tab[tid].rt = 0; tab[tid].rowbase = 0; tab[tid].nrows = 0; }
        else {
            for (; e < NEXP - 1; ++e) { const int nt = (sCnt[e] + 255) >> 8; if (tid < rt0 + nt) break; rt0 += nt; rowbase += nt * 256; }
            int nrows = sCnt[e] - (tid - rt0) * 256; nrows = nrows > 256 ? 256 : nrows;
            tab[tid].e = e; tab[tid].rt = tid - rt0; tab[tid].rowbase = rowbase; tab[tid].nrows = nrows;
        }
    }
    __syncthreads();
    return tab;
}
DEVI void moe_lookup(const MoeTab* tab, int rti, int& e, int& rt, int& rowbase, int& nrows) {
    const MoeTab t = tab[rti];
    e = __builtin_amdgcn_readfirstlane(t.e); rt = __builtin_amdgcn_readfirstlane(t.rt); rowbase = __builtin_amdgcn_readfirstlane(t.rowbase); nrows = __builtin_amdgcn_readfirstlane(t.nrows);
}
struct EpiFinal {
    static constexpr bool PERM = false, MID = false; const bf16_t* x2b; bf16_t* pe; float* out; int pass;
    DEVI void operator()(const f32x4 (&acc)[2][2][4][2], const PUnit& u, int wr, int wc, int fr, int fq) const {
        const int row0 = u.pm * 256 + wr * 64 + fr, col0 = u.pn * 256 + wc * 32 + 4 * fq;
#pragma unroll
        for (int ai = 0; ai < 2; ++ai)
#pragma unroll
            for (int mh = 0; mh < 2; ++mh) {
                u32x2 pv[2][2][2], xv[2][2][2];
#pragma unroll
                for (int mm = 0; mm < 2; ++mm)
#pragma unroll
                    for (int bj = 0; bj < 2; ++bj)
#pragma unroll
                        for (int n = 0; n < 2; ++n) {
                            const size_t o = (size_t)(row0 + ai * 128 + (mh * 2 + mm) * 16) * 1024 + col0 + bj * 128 + n * 16;
                            pv[mm][bj][n] = *(const u32x2*)(pe + o); xv[mm][bj][n] = *(const u32x2*)(x2b + o);
                        }
#pragma unroll
                for (int mm = 0; mm < 2; ++mm)
#pragma unroll
                    for (int bj = 0; bj < 2; ++bj)
#pragma unroll
                        for (int n = 0; n < 2; ++n) {
                            const size_t o = (size_t)(row0 + ai * 128 + (mh * 2 + mm) * 16) * 1024 + col0 + bj * 128 + n * 16;
                            const f32x4 a = acc[ai][bj][mh * 2 + mm][n];
                            f32x4 r;
                            r[0] = __uint_as_float(xv[mm][bj][n][0] << 16) + sigm(a[0]) * __uint_as_float(pv[mm][bj][n][0] << 16);
                            r[1] = __uint_as_float(xv[mm][bj][n][0] & 0xffff0000u) + sigm(a[1]) * __uint_as_float(pv[mm][bj][n][0] & 0xffff0000u);
                            r[2] = __uint_as_float(xv[mm][bj][n][1] << 16) + sigm(a[2]) * __uint_as_float(pv[mm][bj][n][1] << 16);
                            r[3] = __uint_as_float(xv[mm][bj][n][1] & 0xffff0000u) + sigm(a[3]) * __uint_as_float(pv[mm][bj][n][1] & 0xffff0000u);
                            *(f32x4*)(out + o) = r;
                        }
            }
    }
};
struct EpiPe {
    static constexpr bool PERM = true, MID = false; bf16_t* pe;
    DEVI void operator()(const f32x4 (&acc)[2][2][4][2], const PUnit& u, int wr, int wc, int fr, int fq) const {
#pragma unroll
        for (int ai = 0; ai < 2; ++ai)
#pragma unroll
            for (int m = 0; m < 4; ++m) {
                bf16_t* rowp = pe + (size_t)(u.pm * 256 + ai * 128 + wr * 64 + m * 16 + fr) * 1024 + u.pn * 256 + wc * 32 + 8 * fq;
#pragma unroll
                for (int bj = 0; bj < 2; ++bj) *(u32x4*)(rowp + bj * 128) = pk8(acc[ai][bj][m][0], acc[ai][bj][m][1]);
            }
    }
};
struct PeOrder {
    static constexpr bool GATHER = false, DEP = false;
    const bf16_t* pb; const bf16_t* WpeT; int nbusy, G, c;
    DEVI bool next(int i, PUnit& u) const {
        if (c < nbusy) return false;
        const int t = i * (G - nbusy) + (c - nbusy); if (t >= 256) return false;
        u.pm = t >> 2; u.pn = t & 3; u.A = (const char*)(pb + (size_t)u.pm * 256 * 256); u.lda = 256; u.rows = nullptr; u.nrows = 256;
        u.Bt = (const char*)(WpeT + (size_t)u.pn * 256 * 256); u.x0 = 0; u.x1 = 0;
        return true;
    }
};
struct Moe1Order {
    static constexpr bool GATHER = true, DEP = false;
    const MoeTab* tab; const int* list; const bf16_t* x1b; const bf16_t* W13; int total, G, c;
    DEVI bool next(int i, PUnit& u) const {
        const int t = i * G + c; if (t >= total) return false;
        int e, rt, rowbase, nrows; moe_lookup(tab, t >> 2, e, rt, rowbase, nrows);
        u.pm = 0; u.pn = t & 3; u.A = (const char*)x1b; u.lda = 1024; u.rows = list + (size_t)e * NTOK + rt * 256; u.nrows = nrows;
        u.Bt = (const char*)(W13 + ((size_t)e * 1024 + (t & 3) * 256) * 1024); u.x0 = rowbase + rt * 256; u.x1 = e;
        return true;
    }
};
struct EpiMoe1 {
    static constexpr bool PERM = true, MID = false; bf16_t* hbuf;
    DEVI void operator()(const f32x4 (&acc)[2][2][4][2], const PUnit& u, int wr, int wc, int fr, int fq) const {
#pragma unroll
        for (int ai = 0; ai < 2; ++ai)
#pragma unroll
            for (int m = 0; m < 4; ++m) {
                f32x4 o0, o1;
#pragma unroll
                for (int q = 0; q < 4; ++q) {
                    const float a0 = acc[ai][0][m][0][q], a1 = acc[ai][0][m][1][q];
                    o0[q] = a0 * sigm(a0) * acc[ai][1][m][0][q]; o1[q] = a1 * sigm(a1) * acc[ai][1][m][1][q];
                }
                st_wt(hbuf + (size_t)(u.x0 + ai * 128 + wr * 64 + m * 16 + fr) * 512 + u.pn * 128 + wc * 32 + 8 * fq, pk8(o0, o1));
            }
    }
};
struct Moe2Order {
    static constexpr bool GATHER = false, DEP = false;
    const MoeTab* tab; const bf16_t* hbuf; const bf16_t* W2T; int total, G, c;
    DEVI bool next(int i, PUnit& u) const {
        const int t = i * G + c; if (t >= total) return false;
        int e, rt, rowbase, nrows; moe_lookup(tab, t >> 2, e, rt, rowbase, nrows);
        u.pm = 0; u.pn = t & 3; u.A = (const char*)(hbuf + (size_t)(rowbase + rt * 256) * 512); u.lda = 512; u.rows = nullptr; u.nrows = 256;
        u.Bt = (const char*)(W2T + ((size_t)e * 1024 + (t & 3) * 256) * 512); u.x0 = rowbase + rt * 256; u.x1 = e;
        return true;
    }
};
struct EpiMoe2 {
    static constexpr bool PERM = true, MID = false; bf16_t* y;
    DEVI void operator()(const f32x4 (&acc)[2][2][4][2], const PUnit& u, int wr, int wc, int fr, int fq) const {
#pragma unroll
        for (int ai = 0; ai < 2; ++ai)
#pragma unroll
            for (int m = 0; m < 4; ++m) {
                bf16_t* rowp = y + (size_t)(u.x0 + ai * 128 + wr * 64 + m * 16 + fr) * 1024 + u.pn * 256 + wc * 32 + 8 * fq;
#pragma unroll
                for (int bj = 0; bj < 2; ++bj) *(u32x4*)(rowp + bj * 128) = pk8(acc[ai][bj][m][0], acc[ai][bj][m][1]);
            }
    }
};
DEVI unsigned* moe_rt_counter(const Params& p, int rti) { return (unsigned*)(p.ws + WS_BAR + 16384) + rti * 16; }
DEVI unsigned* moe_all_counter(const Params& p) { return (unsigned*)(p.ws + WS_BAR + 16384 + 12288); }
struct Moe2DepOrder {
    static constexpr bool GATHER = false, DEP = true;
    const MoeTab* tab; const bf16_t* hbuf; const bf16_t* W2T; unsigned* rtc; unsigned* allc; unsigned* bar; int q, c; mutable int all_seen;
    DEVI int unit_of(int i) const {
        const int n3 = 4 * q;
        if (c >= n3) {
            if (i < 2) { const int e = (c - n3) + i * (256 - n3), et = e >> 2, w = 64 - q; return (64 * (et / w) + q + et % w) * 4 + (e & 3); }
            i -= 2;
        }
        const int l = c + 256 * i;
        if (l < 12 * q) { const int lt = l >> 2; return (64 * (lt / q) + lt % q) * 4 + (l & 3); }
        return -1;
    }
    DEVI bool next(int i, PUnit& u) const {
        const int t = unit_of(i); if (t < 0) return false;
        int e, rt, rowbase, nrows; moe_lookup(tab, t >> 2, e, rt, rowbase, nrows);
        u.pm = t >> 2; u.pn = t & 3; u.A = (const char*)(hbuf + (size_t)(rowbase + rt * 256) * 512); u.lda = 512; u.rows = nullptr; u.nrows = 256;
        u.Bt = (const char*)(W2T + ((size_t)e * 1024 + (t & 3) * 256) * 512); u.x0 = rowbase + rt * 256; u.x1 = e;
        return true;
    }
    DEVI void a_ready(const PUnit& u, int tid) const {
        if (tid < 64 && !all_seen) {
            unsigned* ctr = rtc + u.pm * 16;
            XB_SPIN((unsigned)__builtin_amdgcn_readfirstlane(xb_ld(ctr)) < 4u, bar);
            const unsigned na = (unsigned)__builtin_amdgcn_readfirstlane(xb_ld(allc));
            if (na >= gridDim.x) all_seen = 1;
        }
        asm volatile("" ::: "memory"); __builtin_amdgcn_s_barrier(); asm volatile("" ::: "memory");
    }
};
struct PeListOrder {
    static constexpr bool GATHER = false, DEP = false;
    const bf16_t* pb; const bf16_t* WpeT; int start, n;
    DEVI bool next(int i, PUnit& u) const {
        if (i >= n) return false;
        const int t = start + i;
        u.pm = t >> 2; u.pn = t & 3; u.A = (const char*)(pb + (size_t)u.pm * 256 * 256); u.lda = 256; u.rows = nullptr; u.nrows = 256;
        u.Bt = (const char*)(WpeT + (size_t)u.pn * 256 * 256); u.x0 = 0; u.x1 = 0;
        return true;
    }
};
DEVI void phase_moe(const Params& p, unsigned char* smem) {
    const MoeTab* tab = moe_build_table((const int*)(p.ws + WS_CNT), smem);
    const int nrt = __builtin_amdgcn_readfirstlane(tab[MOE_TAB_MAX].e), total = nrt * 4, G = (int)gridDim.x, c = (int)blockIdx.x;
    {
        Moe1Order S{tab, (const int*)(p.ws + WS_LIST), (const bf16_t*)(p.ws + WS_X1B), (const bf16_t*)(p.ws + WS_W1T), total, G, c};
        pgemm((PG_LAS unsigned char*)smem, 1024, 1024, S, EpiMoe1{(bf16_t*)p.out});
    }
    asm volatile("s_waitcnt vmcnt(0)" ::: "memory");
    __syncthreads();
    if (tidx() == 0) {
        for (int t = c; t < total; t += G) (void)xb_add(moe_rt_counter(p, t >> 2), 1u);
        (void)xb_add(moe_all_counter(p), 1u);
    }
    const int q = nrt - 128;
    {
        Moe2DepOrder S{tab, (const bf16_t*)p.out, (const bf16_t*)(p.ws + WS_W2T), moe_rt_counter(p, 0), moe_all_counter(p), (unsigned*)(p.ws + WS_BAR), q, c, 0};
        pgemm((PG_LAS unsigned char*)smem, 512, 512, S, EpiMoe2{(bf16_t*)(p.ws + WS_Y)});
    }
    {
        int* sLoad = (int*)(smem + 139264); int* sSum = sLoad + 256; int* sRes = sSum + 256;
        const int tid = tidx();
        __syncthreads();
        if (tid < 256) { int nl = 0; for (int l = tid; l < 12 * q; l += 256) ++nl; sLoad[tid] = (tid < 4 * q ? 81 : 94) + 20 * nl; }
        __syncthreads();
        if (tid < 256) { const int lam = 80 + tid; int sum = 0; for (int k = 0; k < 256; ++k) { const int d = lam - sLoad[k]; sum += d > 0 ? d >> 3 : 0; } sSum[tid] = sum; }
        __syncthreads();
        if (tid < 256 && sSum[tid] >= 256 && (tid == 0 || sSum[tid - 1] < 256)) sRes[0] = 80 + tid;
        __syncthreads();
        if (tid == 0) {
            const int lam = sRes[0]; int start = 0;
            for (int k = 0; k < c; ++k) { const int d = lam - sLoad[k]; start += d > 0 ? d >> 3 : 0; }
            const int d = lam - sLoad[c]; int n = d > 0 ? d >> 3 : 0;
            if (start > 256) start = 256;
            if (start + n > 256) n = 256 - start;
            sRes[1] = start; sRes[2] = n;
        }
        __syncthreads();
        PeListOrder P{(const bf16_t*)(p.ws + WS_PB), (const bf16_t*)(p.ws + WS_WPET), __builtin_amdgcn_readfirstlane(sRes[1]), __builtin_amdgcn_readfirstlane(sRes[2])};
        pgemm((PG_LAS unsigned char*)smem, 256, 256, P, EpiPe{(bf16_t*)(p.ws + WS_PE)});
    }
}

DEVI void phase_ln2(const Params& p, unsigned char* smem) {
    bf16_t* x2b = (bf16_t*)(p.ws + WS_X1B);
    const bf16_t* y = (const bf16_t*)(p.ws + WS_Y);
    const int* cnt = (const int*)(p.ws + WS_CNT); const int* slot = (const int*)(p.ws + WS_SLOT); const float* tw = (const float*)(p.ws + WS_TW);
    const float* g = p.in[28]; const float* bta = p.in[29];
    const int lane = tidx() & 63, wid = tidx() >> 6;
    int* sRB = (int*)smem;
    __syncthreads();
    int* sC = sRB + 64;
    if (tidx() < NEXP) sC[tidx()] = cnt[tidx() * CNT_STRIDE];
    __syncthreads();
    if (tidx() < NEXP) { int rb = 0; for (int e = 0; e < NEXP; ++e) { if (e < (int)tidx()) rb += ((sC[e] + 255) >> 8) << 8; } sRB[tidx()] = rb; }
    __syncthreads();
    constexpr int NIT = NTOK / (256 * 16);
    const int tk0 = (blockIdx.x * 8 + wid) * 2;
    int sl[NIT][4]; float wv[NIT][4];
#pragma unroll
    for (int it = 0; it < NIT; ++it) {
        const int tk = tk0 + it * 4096;
        const u32x4 a = *(const u32x4*)(slot + tk * 2); const f32x4 b = *(const f32x4*)(tw + tk * 2);
#pragma unroll
        for (int k = 0; k < 4; ++k) { sl[it][k] = (int)a[k]; wv[it][k] = b[k]; }
    }
    u32x2 xr[2][2][4], ya[2][2][4], yb[2][2][4];
    auto issue = [&](int it, int s_) {
        const int tk = tk0 + it * 4096;
#pragma unroll
        for (int j = 0; j < 2; ++j) {
            const size_t r0 = (size_t)(sRB[sl[it][2 * j] >> 16] + (sl[it][2 * j] & 0xffff)), r1 = (size_t)(sRB[sl[it][2 * j + 1] >> 16] + (sl[it][2 * j + 1] & 0xffff));
#pragma unroll
            for (int i = 0; i < 4; ++i) {
                const int col = i * 256 + lane * 4;
                xr[s_][j][i] = *(const u32x2*)(x2b + (size_t)(tk + j) * 1024 + col);
                ya[s_][j][i] = *(const u32x2*)(y + r0 * 1024 + col); yb[s_][j][i] = *(const u32x2*)(y + r1 * 1024 + col);
            }
        }
    };
    auto finish = [&](int it, int s_) {
        const int tk = tk0 + it * 4096;
#pragma unroll
        for (int j = 0; j < 2; ++j) {
            f32x4 xv[4]; float s = 0.f;
#pragma unroll
            for (int i = 0; i < 4; ++i) {
                f32x4 x0, y0, y1;
                x0[0] = __uint_as_float(xr[s_][j][i][0] << 16); x0[1] = __uint_as_float(xr[s_][j][i][0] & 0xffff0000u); x0[2] = __uint_as_float(xr[s_][j][i][1] << 16); x0[3] = __uint_as_float(xr[s_][j][i][1] & 0xffff0000u);
                y0[0] = __uint_as_float(ya[s_][j][i][0] << 16); y0[1] = __uint_as_float(ya[s_][j][i][0] & 0xffff0000u); y0[2] = __uint_as_float(ya[s_][j][i][1] << 16); y0[3] = __uint_as_float(ya[s_][j][i][1] & 0xffff0000u);
                y1[0] = __uint_as_float(yb[s_][j][i][0] << 16); y1[1] = __uint_as_float(yb[s_][j][i][0] & 0xffff0000u); y1[2] = __uint_as_float(yb[s_][j][i][1] << 16); y1[3] = __uint_as_float(yb[s_][j][i][1] & 0xffff0000u);
                xv[i] = x0 * ALPHA + y0 * wv[it][2 * j] + y1 * wv[it][2 * j + 1];
                s += xv[i][0] + xv[i][1] + xv[i][2] + xv[i][3];
            }
            const float mean = wave_sum(s) * (1.f / 1024.f);
            float s2 = 0.f;
#pragma unroll
            for (int i = 0; i < 4; ++i)
#pragma unroll
                for (int q = 0; q < 4; ++q) { const float d = xv[i][q] - mean; s2 += d * d; }
            const float rstd = rsqrtf(wave_sum(s2) * (1.f / 1024.f) + LN_EPS);
#pragma unroll
            for (int i = 0; i < 4; ++i) {
                const int col = i * 256 + lane * 4;
                const f32x4 g4 = *(const f32x4*)(g + col), b4 = *(const f32x4*)(bta + col);
                f32x4 o;
#pragma unroll
                for (int q = 0; q < 4; ++q) o[q] = (xv[i][q] - mean) * rstd * g4[q] + b4[q];
                st_bf4(x2b + (size_t)(tk + j) * 1024 + col, o);
            }
        }
    };
    issue(0, 0); issue(1, 1);
#pragma unroll
    for (int it = 0; it < NIT; ++it) {
        finish(it, it & 1);
        if (it + 2 < NIT) issue(it + 2, it & 1);
    }
}

DEVI void phase_final(const Params& p, unsigned char* smem) {
    const bf16_t* x2b = (const bf16_t*)(p.ws + WS_X1B); bf16_t* pe = (bf16_t*)(p.ws + WS_PE);
    TileOrder S; S.init(x2b, 1024, (const bf16_t*)(p.ws + WS_WPGT), 1024, NTOK, 1024);
    pgemm((PG_LAS unsigned char*)smem, 1024, 1024, S, EpiFinal{x2b, pe, p.out, 1});
}

extern __shared__ __attribute__((aligned(16))) unsigned char dyn_smem[];
#ifndef PROBE_PHASE
#define PROBE_PHASE -1
#endif
#define STAMP(k) do { if (PROBE_PHASE >= 0 && blockIdx.x == 0 && tidx() == 0) ts[k] = __builtin_amdgcn_s_memrealtime(); } while (0)
__global__ void __launch_bounds__(NT) k_mega(Params p) {
    volatile LAS unsigned* st = (volatile LAS unsigned*)(dyn_smem + LDS_BYTES - 16);
    if (tidx() == 0) { st[0] = 0u; st[1] = 0u; st[2] = 0u; st[3] = 0u; }
    __syncthreads();
    const XcdBarrier gb = xcd_barrier_post((unsigned*)(p.ws + WS_BAR), st);
    unsigned long long* ts = (unsigned long long*)(p.ws + WS_BAR + 32768);
#if PROBE_PHASE >= 0
    xcd_barrier(gb); STAMP(0);
#endif
    phase_prep(p, dyn_smem); xcd_barrier(gb); STAMP(1);
    phase_inproj(p, dyn_smem); xcd_barrier(gb); STAMP(2);
    phase_rwkv_prep(p, dyn_smem); xcd_barrier(gb); STAMP(3);
    phase_3a(p, dyn_smem); xcd_barrier(gb); STAMP(4);
    phase_3b(p, dyn_smem); xcd_barrier(gb); STAMP(5);
    phase_3c(p, dyn_smem); xcd_barrier(gb); STAMP(6);
    phase_merge(p, dyn_smem); xcd_barrier(gb); STAMP(7);
    phase_wo(p, dyn_smem); xcd_barrier(gb); STAMP(8);
    phase_ln1_route(p, dyn_smem); xcd_barrier(gb); STAMP(9);
    phase_moe(p, dyn_smem); xcd_barrier(gb); STAMP(10); STAMP(11);
    phase_ln2(p, dyn_smem); xcd_barrier(gb); STAMP(12);
    phase_final(p, dyn_smem);
#if PROBE_PHASE >= 0
    xcd_barrier(gb); STAMP(13);
    if (blockIdx.x == 0 && tidx() == 0) {
        const unsigned long long d = (ts[PROBE_PHASE + 1] - ts[PROBE_PHASE]) * 4ull, t0 = __builtin_amdgcn_s_memrealtime();
        while (__builtin_amdgcn_s_memrealtime() - t0 < d) __builtin_amdgcn_s_sleep(8);
    }
#endif
}

extern "C" void kernel_launch(void* const* d_in, const int* in_sizes, int n_in, void* d_out, int out_size, void* d_ws, size_t ws_size, hipStream_t stream) {
    static int grid = 0;
    if (grid == 0) {
        if (n_in != 32 || out_size != NTOK * DM || ws_size < WS_END) { fprintf(stderr, "kernel_launch: unexpected shapes (n_in %d out %d ws %zu, need %zu)\n", n_in, out_size, ws_size, (size_t)WS_END); grid = -1; return; }
        int dev = 0, cus = 0, per_cu = 0;
        hipGetDevice(&dev); hipDeviceGetAttribute(&cus, hipDeviceAttributeMultiprocessorCount, dev);
        hipFuncSetAttribute((const void*)k_mega, hipFuncAttributeMaxDynamicSharedMemorySize, LDS_BYTES);
        hipOccupancyMaxActiveBlocksPerMultiprocessor(&per_cu, (const void*)k_mega, NT, LDS_BYTES);
        if (per_cu < 1) { fprintf(stderr, "kernel_launch: occupancy query says %d blocks per CU\n", per_cu); grid = -1; return; }
        if (cus < 256) { fprintf(stderr, "kernel_launch: %d CUs reported; this kernel's phase maps are built for a 256-workgroup grid (one per CU of a 256-CU device)\n", cus); grid = -1; return; }
        grid = 256;
        (void)hipGetLastError();
    }
    if (grid < 0) return;
    Params p{};
    for (int i = 0; i < 32; ++i) p.in[i] = (const float*)d_in[i];
    p.out = (float*)d_out; p.ws = (unsigned char*)d_ws;
    (void)hipMemsetAsync((char*)d_ws + WS_BAR, 0, 32768, stream);
    void* args[] = {&p};
    hipError_t e = hipLaunchCooperativeKernel((const void*)k_mega, dim3(grid), dim3(NT), args, LDS_BYTES, stream);
    if (e != hipSuccess) fprintf(stderr, "cooperative launch failed: %s (grid %d)\n", hipGetErrorString(e), grid);
}
```
